# Optimizing an MI355X kernel written in HIP

```python
import math
import jax, jax.numpy as jnp
from jax import lax
import numpy as np

D_MODEL = 1024
BATCH = 16
SEQ = 256
DEPTH = 2
DEC_BATCH = 8
DEC_SEQ = 1024
PAST_LEN = 512

GRID_W = 64
N_MIXERS = 2
N_HY_LAYERS = (DEPTH + 1) // 2
N_S5_LAYERS = DEPTH // 2
D_FF = -(-8 * D_MODEL // (3 * 256)) * 256
EPS = 1e-6
POS_BASE = 10000.0
HY_ORDER = 2
HY_EMB = 33
HY_BANDS = (HY_EMB - 1) // 2
HY_FO = 64
HY_SHORT = 3
HY_TARGET = 1e-2
HY_FAST = 0.3
HY_SLOW = 1.5
S5_GROUP = 16
S5_G = D_MODEL // S5_GROUP
S5_P = 64

kernel_name = 'hyena_s5_prefix_diffusion_step'


def _rmsnorm(x, g):
    xf = x.astype(jnp.float32)
    ms = jnp.mean(xf * xf, axis=-1, keepdims=True)
    return (xf * lax.rsqrt(ms + EPS) * g.astype(jnp.float32)).astype(x.dtype)


def _modulate(h, shift, scale):
    return h * (1 + scale[:, None]) + shift[:, None]


def _swiglu(h, w13, w2):
    a, b = jnp.split(h @ w13, 2, axis=-1)
    return (jax.nn.silu(a) * b) @ w2


def _grid_pos_embed(rows):
    quarter = D_MODEL // 4
    omega = 1.0 / (POS_BASE ** (jnp.arange(quarter, dtype=jnp.float32) / quarter))

    def axis_embed(n):
        ang = jnp.arange(n, dtype=jnp.float32)[:, None] * omega[None]
        return jnp.concatenate([jnp.sin(ang), jnp.cos(ang)], axis=-1)

    er = jnp.broadcast_to(axis_embed(rows)[:, None], (rows, GRID_W, D_MODEL // 2))
    ec = jnp.broadcast_to(axis_embed(GRID_W)[None], (rows, GRID_W, D_MODEL // 2))
    return jnp.concatenate([er, ec], axis=-1).reshape(rows * GRID_W, D_MODEL)


def _short_conv(x, w, b):
    L = x.shape[1]
    xp = jnp.pad(x, ((0, 0), (1, 1), (0, 0)))
    return xp[:, :L] * w[0] + xp[:, 1:L + 1] * w[1] + xp[:, 2:] * w[2] + b


def _hyena_filter_spectrum(L, w1, b1, w2, b2, w3, freq):
    f32 = jnp.float32
    t = jnp.linspace(0.0, 1.0, L, dtype=f32)[:, None]
    w = 2.0 * math.pi * jnp.arange(L, dtype=f32)[:, None] / L
    bands = jnp.linspace(1e-4, HY_BANDS - 1, HY_BANDS, dtype=f32)[None, :]
    z = jnp.concatenate([t, jnp.cos(bands * w), -jnp.sin(bands * w)], axis=-1)
    fr = freq.astype(f32)
    h = jnp.sin(fr * (z @ w1.astype(f32) + b1.astype(f32)))
    h = jnp.sin(fr * (h @ w2.astype(f32) + b2.astype(f32)))
    h = (h @ w3.astype(f32)).reshape(L, HY_ORDER, 2, D_MODEL)
    max_decay = math.log(HY_TARGET) / HY_FAST
    min_decay = math.log(HY_TARGET) / HY_SLOW
    deltas = jnp.abs(jnp.linspace(min_decay, max_decay, D_MODEL, dtype=f32))
    decay = jnp.exp(-t * deltas[None, :])
    h = h * decay[:, None, None, :]
    h = h / (jnp.sum(jnp.abs(h), axis=(0, 2), keepdims=True) + EPS)
    fwd = h[:, :, 0]
    bwd = h[:, :, 1]
    k = jnp.concatenate([fwd, jnp.zeros((1, HY_ORDER, D_MODEL), f32), bwd[:0:-1]], axis=0)
    return jnp.fft.rfft(k, axis=0)


def _fft_longconv(v, k_f, bias):
    L = v.shape[1]
    vf = v.astype(jnp.float32)
    v_f = jnp.fft.rfft(vf, n=2 * L, axis=1)
    y = jnp.fft.irfft(v_f * k_f[None], n=2 * L, axis=1)[:, :L]
    return y + vf * bias.astype(jnp.float32)


def _hyena_mixer(u, j, p):
    L = u.shape[1]
    z = u @ p['hy_in_w'][j] + p['hy_in_b'][j]
    z = _short_conv(z, p['hy_conv_w'][j], p['hy_conv_b'][j])
    v, x1, x2 = jnp.split(z, 3, axis=-1)
    k_f = _hyena_filter_spectrum(L, p['hy_pe_w1'][j], p['hy_pe_b1'][j], p['hy_pe_w2'][j],
                                 p['hy_pe_b2'][j], p['hy_pe_w3'][j], p['hy_freq'][j])
    fb = p['hy_fbias'][j]
    v = _fft_longconv(v, k_f[:, 0], fb[0]) * x1.astype(jnp.float32)
    v = _fft_longconv(v, k_f[:, 1], fb[1]) * x2.astype(jnp.float32)
    return (v @ p['hy_out_w'][j].astype(jnp.float32) + p['hy_out_b'][j].astype(jnp.float32)).astype(u.dtype)


def _s5_discretize(a_re, a_im, log_dt, b_re, b_im):
    f32 = jnp.float32
    a_re = a_re.astype(f32)
    a_im = a_im.astype(f32)
    b_re = b_re.astype(f32)
    b_im = b_im.astype(f32)
    dt = jnp.exp(log_dt.astype(f32))[:, None]
    mag = jnp.exp(dt * a_re)
    ph = dt * a_im
    ab_re = mag * jnp.cos(ph)
    ab_im = mag * jnp.sin(ph)
    nr = ab_re - 1.0
    ni = ab_im
    den = a_re * a_re + a_im * a_im
    co_re = ((nr * a_re + ni * a_im) / den)[..., None]
    co_im = ((ni * a_re - nr * a_im) / den)[..., None]
    bb_re = co_re * b_re - co_im * b_im
    bb_im = co_re * b_im + co_im * b_re
    return ab_re, ab_im, bb_re, bb_im


def _cmul_combine(e1, e2):
    a1r, a1i, b1r, b1i = e1
    a2r, a2i, b2r, b2i = e2
    return (a2r * a1r - a2i * a1i, a2r * a1i + a2i * a1r,
            a2r * b1r - a2i * b1i + b2r, a2r * b1i + a2i * b1r + b2i)


def _s5_scan(ug, ab_re, ab_im, bb_re, bb_im, init):
    L = ug.shape[1]
    bu_re = jnp.einsum('blgh,gph->blgp', ug, bb_re)
    bu_im = jnp.einsum('blgh,gph->blgp', ug, bb_im)
    a_re = jnp.broadcast_to(ab_re[None, None], (1, L) + ab_re.shape)
    a_im = jnp.broadcast_to(ab_im[None, None], (1, L) + ab_im.shape)
    pr, pi, hr, hi = lax.associative_scan(_cmul_combine, (a_re, a_im, bu_re, bu_im), axis=1)
    if init is not None:
        h0r = init[0][:, None]
        h0i = init[1][:, None]
        hr = hr + pr * h0r - pi * h0i
        hi = hi + pr * h0i + pi * h0r
    return hr, hi


def _s5_mixer(u, j, p, h0):
    f32 = jnp.float32
    bsz, L, _ = u.shape
    uf = u.astype(f32)
    ug = uf.reshape(bsz, L, S5_G, S5_GROUP)
    y = uf * p['s5_D'][j].astype(f32)
    finals = []
    for d in range(2):
        ab_re, ab_im, bb_re, bb_im = _s5_discretize(p['s5_A_re'][j, d], p['s5_A_im'][j, d], p['s5_log_dt'][j, d],
                                                    p['s5_B_re'][j, d], p['s5_B_im'][j, d])
        src = ug if d == 0 else jnp.flip(ug, axis=1)
        init = None if h0 is None else (h0[:, d, 0].astype(f32), h0[:, d, 1].astype(f32))
        hr, hi = _s5_scan(src, ab_re, ab_im, bb_re, bb_im, init)
        yd = (jnp.einsum('ghp,blgp->blgh', p['s5_C_re'][j, d].astype(f32), hr)
              - jnp.einsum('ghp,blgp->blgh', p['s5_C_im'][j, d].astype(f32), hi))
        if d == 1:
            yd = jnp.flip(yd, axis=1)
        y = y + yd.reshape(bsz, L, D_MODEL)
        if h0 is None:
            finals.append(jnp.stack([hr[:, -1], hi[:, -1]], axis=1))
    y = jax.nn.gelu(y)
    a, g = jnp.split(y @ p['s5_glu_w'][j].astype(f32) + p['s5_glu_b'][j].astype(f32), 2, axis=-1)
    out = (a * jax.nn.sigmoid(g)).astype(u.dtype)
    fin = jnp.stack(finals, axis=1) if h0 is None else None
    return out, fin


def _trunk(x, cond, s5_state, p):
    finals = []
    for i in range(DEPTH):
        j = i // N_MIXERS
        mod = jax.nn.silu(cond) @ p['ada_w'][i] + p['ada_b'][i]
        sh1, sc1, g1, sh2, sc2, g2 = jnp.split(mod.astype(x.dtype), 6, axis=-1)
        h = _modulate(_rmsnorm(x, p['norm1_g'][i]), sh1, sc1)
        if i % N_MIXERS == 0:
            m = _hyena_mixer(h, j, p)
        else:
            h0 = None if s5_state is None else s5_state[:, j]
            m, fin = _s5_mixer(h, j, p, h0)
            if s5_state is None:
                finals.append(fin)
        x = x + g1[:, None] * m
        h = _modulate(_rmsnorm(x, p['norm2_g'][i]), sh2, sc2)
        x = x + g2[:, None] * _swiglu(h, p['ffn_w13'][i], p['ffn_w2'][i])
    y = _rmsnorm(x, p['final_g'])
    new_state = jnp.stack(finals, axis=1) if s5_state is None else None
    return y, new_state


def setup_inputs(seed: int = 0) -> dict:
    key = jax.random.key(seed)
    ks = list(jax.random.split(key, 40))
    f32 = jnp.float32

    def nrm(k, shape, s):
        return jax.random.normal(k, shape, f32) * s

    D, F, NH, NS = D_MODEL, D_FF, N_HY_LAYERS, N_S5_LAYERS
    G, P, H = S5_G, S5_P, S5_GROUP
    n_idx = jnp.arange(P, dtype=f32)
    return {
        'x_prompt': nrm(ks[0], (BATCH, SEQ, D), 1.0),
        'x_sample': nrm(ks[1], (DEC_BATCH, DEC_SEQ, D), 1.0),
        'state_s5': nrm(ks[2], (DEC_BATCH, NS, 2, 2, G, P), 0.1),
        'c': nrm(ks[3], (DEC_BATCH, D), 1.0),
        'c_ctx': nrm(ks[4], (D,), 1.0),
        'norm1_g': 1.0 + nrm(ks[5], (DEPTH, D), 0.01),
        'norm2_g': 1.0 + nrm(ks[6], (DEPTH, D), 0.01),
        'final_g': 1.0 + nrm(ks[7], (D,), 0.01),
        'ada_w': nrm(ks[8], (DEPTH, D, 6 * D), 0.5 * D ** -0.5),
        'ada_b': nrm(ks[9], (DEPTH, 6 * D), 0.01),
        'ffn_w13': nrm(ks[10], (DEPTH, D, 2 * F), D ** -0.5),
        'ffn_w2': nrm(ks[11], (DEPTH, F, D), F ** -0.5),
        'hy_in_w': nrm(ks[12], (NH, D, 3 * D), D ** -0.5),
        'hy_in_b': nrm(ks[13], (NH, 3 * D), 0.01),
        'hy_conv_w': nrm(ks[14], (NH, HY_SHORT, 3 * D), HY_SHORT ** -0.5),
        'hy_conv_b': nrm(ks[15], (NH, 3 * D), 0.01),
        'hy_pe_w1': nrm(ks[16], (NH, HY_EMB, HY_FO), HY_EMB ** -0.5),
        'hy_pe_b1': nrm(ks[17], (NH, HY_FO), 0.1),
        'hy_pe_w2': nrm(ks[18], (NH, HY_FO, HY_FO), HY_FO ** -0.5),
        'hy_pe_b2': nrm(ks[19], (NH, HY_FO), 0.1),
        'hy_pe_w3': nrm(ks[20], (NH, HY_FO, HY_ORDER * 2 * D), HY_FO ** -0.5),
        'hy_freq': 1.0 + nrm(ks[21], (NH, HY_FO), 0.1),
        'hy_fbias': nrm(ks[22], (NH, HY_ORDER, D), 0.5),
        'hy_out_w': nrm(ks[23], (NH, D, D), D ** -0.5),
        'hy_out_b': nrm(ks[24], (NH, D), 0.01),
        's5_A_re': -0.5 + nrm(ks[25], (NS, 2, G, P), 0.01),
        's5_A_im': math.pi * n_idx + nrm(ks[26], (NS, 2, G, P), 0.01),
        's5_log_dt': jax.random.uniform(ks[27], (NS, 2, G), f32, math.log(1e-3), math.log(1e-1)),
        's5_B_re': nrm(ks[28], (NS, 2, G, P, H), (2 * H) ** -0.5),
        's5_B_im': nrm(ks[29], (NS, 2, G, P, H), (2 * H) ** -0.5),
        's5_C_re': nrm(ks[30], (NS, 2, G, H, P), P ** -0.5),
        's5_C_im': nrm(ks[31], (NS, 2, G, H, P), P ** -0.5),
        's5_D': nrm(ks[32], (NS, D), 1.0),
        's5_glu_w': nrm(ks[33], (NS, D, 2 * D), D ** -0.5),
        's5_glu_b': nrm(ks[34], (NS, 2 * D), 0.01),
    }


def reference(x_prompt, x_sample, state_s5, c, c_ctx, norm1_g, norm2_g, final_g, ada_w, ada_b,
              ffn_w13, ffn_w2, hy_in_w, hy_in_b, hy_conv_w, hy_conv_b, hy_pe_w1, hy_pe_b1,
              hy_pe_w2, hy_pe_b2, hy_pe_w3, hy_freq, hy_fbias, hy_out_w, hy_out_b,
              s5_A_re, s5_A_im, s5_log_dt, s5_B_re, s5_B_im, s5_C_re, s5_C_im, s5_D,
              s5_glu_w, s5_glu_b):
    p = dict(norm1_g=norm1_g, norm2_g=norm2_g, final_g=final_g, ada_w=ada_w, ada_b=ada_b,
             ffn_w13=ffn_w13, ffn_w2=ffn_w2, hy_in_w=hy_in_w, hy_in_b=hy_in_b,
             hy_conv_w=hy_conv_w, hy_conv_b=hy_conv_b, hy_pe_w1=hy_pe_w1, hy_pe_b1=hy_pe_b1,
             hy_pe_w2=hy_pe_w2, hy_pe_b2=hy_pe_b2, hy_pe_w3=hy_pe_w3, hy_freq=hy_freq,
             hy_fbias=hy_fbias, hy_out_w=hy_out_w, hy_out_b=hy_out_b, s5_A_re=s5_A_re,
             s5_A_im=s5_A_im, s5_log_dt=s5_log_dt, s5_B_re=s5_B_re, s5_B_im=s5_B_im,
             s5_C_re=s5_C_re, s5_C_im=s5_C_im, s5_D=s5_D, s5_glu_w=s5_glu_w, s5_glu_b=s5_glu_b)
    y_prompt, new_state_s5 = _trunk(x_prompt, c_ctx[None], None, p)
    rows = x_sample.shape[1] // GRID_W
    lat = x_sample + _grid_pos_embed(rows).astype(x_sample.dtype)[None]
    y_sample, _ = _trunk(lat, c, state_s5, p)
    return (y_prompt, y_sample, new_state_s5)
```

```cpp
#include <hip/hip_runtime.h>
#include <math.h>
#include <string.h>
#include <stdio.h>

#ifndef MK_LAUNCHES
#define MK_LAUNCHES 1
#endif
constexpr int D = 1024, NCTX = 4096, NLAT = 8192, T = 12288, F = 2816, NPH = 12;
constexpr size_t MiB = 1u << 20;
typedef _Float16 f16h;
constexpr size_t WS_CTL = 0, CTL_ZERO_BYTES = 2 * MiB;
constexpr size_t CTL_BAR = 16384;
constexpr size_t WS_MOD = 65536;
constexpr size_t WS_SSQ = 524288;
constexpr size_t WS_NORM = 720896;
constexpr size_t WS_BIAS2 = 786432;
constexpr size_t WS_H2 = 2 * MiB;
constexpr size_t WS_POST = 2 * MiB + 512 * 1024;
constexpr size_t WS_S5PW = 2 * MiB + 768 * 1024;
constexpr size_t WS_S5BB = 3 * MiB;
constexpr size_t WS_FILT = 4 * MiB;
constexpr size_t WS_WIN = 24 * MiB, WS_WOUT = 30 * MiB, WS_W13 = 32 * MiB  , WS_W2 = 54 * MiB  , WS_WGLU = 65 * MiB;
constexpr size_t WS_XA = 70 * MiB;
constexpr size_t WS_V2 = 94 * MiB;
constexpr size_t WS_ZT = 118 * MiB;
constexpr size_t WS_YB = 190 * MiB;
constexpr size_t WS_END = 238 * MiB;
constexpr int LDS_BYTES = 135168;
constexpr int LDS_MISC = 133120;

__device__ __forceinline__ int row_ci(int row) { return row < NCTX ? 0 : 1 + ((row - NCTX) >> 10); }
__device__ __forceinline__ float siluf(float v) { return v / (1.f + __expf(-v)); }
__device__ __forceinline__ float sigmf(float v) { return 1.f / (1.f + __expf(-v)); }
__device__ __forceinline__ unsigned pkh(float a, float b) { typedef _Float16 h2 __attribute__((ext_vector_type(2))); h2 v; v.x = (_Float16)a; v.y = (_Float16)b; return __builtin_bit_cast(unsigned, v); }

__device__ __forceinline__ void atomic_add_done(float* p, float v) { const float old = atomicAdd(p, v); asm volatile("" :: "v"(old)); }
struct Params { const float* in[35]; float* out; unsigned char* ws; int ph_lo, ph_hi; };
namespace g8 {
#define G8_LAS __attribute__((address_space(3)))
typedef _Float16 h8 __attribute__((ext_vector_type(8)));
typedef float f32x4 __attribute__((ext_vector_type(4)));
typedef unsigned u32x4 __attribute__((ext_vector_type(4)));
typedef unsigned u32x2 __attribute__((ext_vector_type(2)));
constexpr int BM = 256, BK = 64, HALF = 128, HTB = HALF * BK * 2, STAGE_BYTES = 8 * HTB, NXCD = 8, WGM = 8;
__host__ __device__ __forceinline__ int lds_byte(int r, int c) { const int st = (r >> 4) * 2 + (c >> 5), rr = r & 15, cc = c & 31, ob = rr * 64 + cc * 2; return st * 1024 + (ob ^ (((ob >> 9) & 1) << 5)); }
__host__ __device__ __forceinline__ void stage_rc(int b, int& R, int& C) { const int st = b / 1024, sb = b % 1024, swz = sb ^ (((sb >> 9) & 1) << 5); R = (st >> 1) * 16 + swz / 64; C = (st & 1) * 32 + (swz % 64) / 2; }
struct Unit { int pm, pn; };
struct Gemm { const void* A; const void* Bt; int K; unsigned a_row, a_k8; int b_tile_rows, b_half_rows; int nM, nN; int pad; };
struct StaticOrder {
    int nM, nN, nwg, G, c;
    __device__ void init(int nM_, int nN_, int G_, int c_) { nM = nM_; nN = nN_; nwg = nM * nN; G = G_; c = c_; }
    __device__ bool next(int i, Unit& u) const {
        const long L = (long)i * G + c; if (L >= nwg) return false;
        int wgid = (int)L; { const int q = nwg / NXCD, r = nwg % NXCD, xcd = wgid % NXCD, off = wgid / NXCD; wgid = (xcd < r ? xcd * (q + 1) : r * (q + 1) + (xcd - r) * q) + off; }
        const int nig = WGM * nN, gid = wgid / nig, fm = gid * WGM, gsz = (nM - fm) < WGM ? (nM - fm) : WGM;
        u.pm = fm + ((wgid % nig) % gsz); u.pn = (wgid % nig) / gsz; return true;
    }
};
template <class Epi>
__device__ __forceinline__ void gemm_phase(G8_LAS unsigned char* lds, const Gemm g, const StaticOrder& S, const Epi& E) {
    const int tid = threadIdx.x, wid = __builtin_amdgcn_readfirstlane(tid >> 6), lane = tid & 63, wr = wid >> 2, wc = wid & 3, fr = lane & 15, fq = lane >> 4;
    const int K = g.K, nt = K / BK;
    unsigned voffA[2], voffB[2];
#pragma unroll
    for (int i = 0; i < 2; ++i) { int R, C; stage_rc(tid * 16 + i * 8192, R, C);
        voffA[i] = (unsigned)R * g.a_row + (unsigned)(C >> 3) * g.a_k8; voffB[i] = (unsigned)(R * K + C) * 2u; }
    const size_t kstepA = (size_t)8 * g.a_k8, kstepB = (size_t)(BK * 2);
    const size_t hstepA = (size_t)HALF * g.a_row, tstepA = 2 * hstepA;
    const size_t hstepB = (size_t)g.b_half_rows * K * 2, tstepB = (size_t)g.b_tile_rows * K * 2;
    const unsigned ldsw = (unsigned)wid * 1024u;
    const int aoff = lds_byte(wr * 64 + fr, fq * 8), boff = lds_byte(wc * 32 + fr, fq * 8);
#define G8_SA(b, h) (((b) * 2 + (h)) * HTB)
#define G8_SB(b, h) ((4 + (b) * 2 + (h)) * HTB)
#define G8_STAGE(bufoff, gbase, voff) do { _Pragma("unroll") for (int _i = 0; _i < 2; ++_i) \
        __builtin_amdgcn_global_load_lds((const unsigned*)((const char*)(gbase) + (voff)[_i]), (G8_LAS unsigned*)(lds + (bufoff) + ldsw + _i * 8192), 16, 0, 0); } while (0)
#define G8_LDA(dst, b, h) do { _Pragma("unroll") for (int m = 0; m < 4; ++m) _Pragma("unroll") for (int k = 0; k < 2; ++k) dst[m][k] = *(const G8_LAS h8*)(lds + G8_SA(b, h) + aoff + m * 2048 + k * 1024); } while (0)
#define G8_LDB(dst, b, h) do { _Pragma("unroll") for (int n = 0; n < 2; ++n) _Pragma("unroll") for (int k = 0; k < 2; ++k) dst[n][k] = *(const G8_LAS h8*)(lds + G8_SB(b, h) + boff + n * 2048 + k * 1024); } while (0)
#define G8_MMA(ai, bj, At, Bt) do { __builtin_amdgcn_s_setprio(1); _Pragma("unroll") for (int m = 0; m < 4; ++m) _Pragma("unroll") for (int n = 0; n < 2; ++n) _Pragma("unroll") for (int k = 0; k < 2; ++k) \
        acc[ai][bj][m][n] = __builtin_amdgcn_mfma_f32_16x16x32_f16(Bt[n][k], At[m][k], acc[ai][bj][m][n], 0, 0, 0); __builtin_amdgcn_s_setprio(0); } while (0)
#define G8_WAIT_V(n) asm volatile("s_waitcnt vmcnt(" #n ")" ::: "memory")
#define G8_WAIT_L(n) asm volatile("s_waitcnt lgkmcnt(" #n ")" ::: "memory")
#define G8_BAR __builtin_amdgcn_s_barrier()
#define G8_SCHED __builtin_amdgcn_sched_barrier(0)
    Unit cur, nxt; int ui = 0;
    if (!S.next(0, cur)) return;
    f32x4 acc[2][2][4][2];
#pragma unroll
    for (int a = 0; a < 2; ++a)
#pragma unroll
        for (int b = 0; b < 2; ++b)
#pragma unroll
            for (int m = 0; m < 4; ++m)
#pragma unroll
                for (int n = 0; n < 2; ++n) acc[a][b][m][n] = (f32x4){0.f, 0.f, 0.f, 0.f};
    h8 At[4][2], B0[2][2], B1[2][2];
    const char* cA = (const char*)g.A + (size_t)cur.pm * tstepA; const char* cB = (const char*)g.Bt + (size_t)cur.pn * tstepB;
    G8_STAGE(G8_SB(0, 0), cB, voffB); G8_STAGE(G8_SA(0, 0), cA, voffA); G8_STAGE(G8_SB(0, 1), cB + hstepB, voffB); G8_STAGE(G8_SA(0, 1), cA + hstepA, voffA);
    if (wr == 1) G8_BAR;
    G8_WAIT_V(4); G8_BAR;
    G8_STAGE(G8_SB(1, 0), cB + kstepB, voffB); G8_STAGE(G8_SA(1, 0), cA + kstepA, voffA); G8_STAGE(G8_SB(1, 1), cB + hstepB + kstepB, voffB);
    G8_WAIT_V(6); G8_BAR;
    for (;;) {
        const bool has_next = S.next(ui + 1, nxt);
        const char* nA = has_next ? (const char*)g.A + (size_t)nxt.pm * tstepA : cA; const char* nB = has_next ? (const char*)g.Bt + (size_t)nxt.pn * tstepB : cB;
        for (int t = 0; t < nt; t += 2) {
            const bool last = (t == nt - 2);
            const char* a1 = cA + (size_t)(t + 1) * kstepA;
            const char* a2 = last ? nA : cA + (size_t)(t + 2) * kstepA; const char* b2 = last ? nB : cB + (size_t)(t + 2) * kstepB;
            const char* a3 = a2 + kstepA; const char* b3 = b2 + kstepB;
            G8_LDB(B0, 0, 0); G8_SCHED; G8_LDA(At, 0, 0); G8_STAGE(G8_SA(1, 1), a1 + hstepA, voffA);
            G8_WAIT_L(8); G8_BAR; G8_WAIT_L(0); G8_MMA(0, 0, At, B0); G8_BAR; G8_SCHED;
            G8_LDB(B1, 0, 1); G8_STAGE(G8_SB(0, 0), b2, voffB);
            G8_BAR; G8_WAIT_L(0); G8_MMA(0, 1, At, B1); G8_BAR;
            G8_LDA(At, 0, 1); G8_STAGE(G8_SA(0, 0), a2, voffA);
            G8_BAR; G8_WAIT_L(0); G8_MMA(1, 0, At, B0); G8_BAR; G8_SCHED;
            G8_STAGE(G8_SB(0, 1), b2 + hstepB, voffB);
            G8_WAIT_V(6); G8_BAR; G8_MMA(1, 1, At, B1); G8_BAR;
            G8_LDB(B0, 1, 0); G8_SCHED; G8_LDA(At, 1, 0); G8_STAGE(G8_SA(0, 1), a2 + hstepA, voffA);
            G8_WAIT_L(8); G8_BAR; G8_WAIT_L(0); G8_MMA(0, 0, At, B0); G8_BAR; G8_SCHED;
            G8_LDB(B1, 1, 1); G8_STAGE(G8_SB(1, 0), b3, voffB);
            G8_BAR; G8_WAIT_L(0); G8_MMA(0, 1, At, B1); G8_BAR;
            G8_LDA(At, 1, 1); G8_STAGE(G8_SA(1, 0), a3, voffA);
            G8_BAR; G8_WAIT_L(0); G8_MMA(1, 0, At, B0); G8_BAR; G8_SCHED;
            G8_STAGE(G8_SB(1, 1), b3 + hstepB, voffB);
            G8_WAIT_V(6); G8_BAR; G8_MMA(1, 1, At, B1); G8_BAR;
        }
        E(acc, cur, wr, wc, fr, fq);
        if (!has_next) break;
#pragma unroll
        for (int a = 0; a < 2; ++a)
#pragma unroll
            for (int b = 0; b < 2; ++b)
#pragma unroll
                for (int m = 0; m < 4; ++m)
#pragma unroll
                    for (int n = 0; n < 2; ++n) acc[a][b][m][n] = (f32x4){0.f, 0.f, 0.f, 0.f};
        cur = nxt; cA = nA; cB = nB; ++ui;
    }
    G8_WAIT_V(0);
    if (wr == 0) G8_BAR;
    G8_BAR;
#undef G8_SA
#undef G8_SB
#undef G8_STAGE
#undef G8_LDA
#undef G8_LDB
#undef G8_MMA
#undef G8_WAIT_V
#undef G8_WAIT_L
#undef G8_BAR
#undef G8_SCHED
}
}
namespace cv {
#define CV_LAS __attribute__((address_space(3)))
typedef _Float16 h8 __attribute__((ext_vector_type(8)));
typedef _Float16 h4 __attribute__((ext_vector_type(4)));
typedef float f32x16 __attribute__((ext_vector_type(16)));
typedef unsigned u4 __attribute__((ext_vector_type(4)));
typedef unsigned u2 __attribute__((ext_vector_type(2)));
constexpr int WAVE_LDS = 16640, V_OFF = 0, FA_OFF = 8320, FB_OFF = 12480;
constexpr float FSCALE = 64.f;
struct Args { const _Float16* zT; const _Float16* FILT; const float* conv_w; const float* conv_b; const float* fbias; _Float16* V2; };
__host__ __device__ __forceinline__ size_t filt_off(int lv, int o, int ch) { return lv ? (size_t)2 * 1024 * 512 + (size_t)(o * 1024 + ch) * 2048 : (size_t)(o * 1024 + ch) * 512; }
template <int LV> __device__ __forceinline__ void conv_unit(CV_LAS unsigned char* lds, const Args& P, int c, int bh) {
    constexpr int L = LV ? 1024 : 256, NBu = LV ? 4 : 8, T1 = L / 32, T1L = LV ? 8 : 4, NCT = T1 / T1L, PV = L * 2 + 16;
    const int tid = threadIdx.x, w = __builtin_amdgcn_readfirstlane(tid >> 6), lane = tid & 63;
    const int ch = 8 * c + w;
    const int row_base = LV ? 4096 + (4 * bh) * 1024 : (8 * bh) * 256;
    CV_LAS unsigned char* wl = lds + w * WAVE_LDS;
    {
        const _Float16* zrow = P.zT + (size_t)ch * 12288 + row_base;
        const float w0 = P.conv_w[ch], w1 = P.conv_w[3072 + ch], w2 = P.conv_w[6144 + ch], cb = P.conv_b[ch];
        for (int piece = lane; piece < NBu * L / 8; piece += 64) {
            const int bl = piece / (L / 8), t0 = (piece % (L / 8)) * 8;
            const h8 raw = *(const h8*)(zrow + bl * L + t0);
            float z[10];
            z[0] = t0 > 0 ? (float)zrow[bl * L + t0 - 1] : 0.f; z[9] = t0 + 8 < L ? (float)zrow[bl * L + t0 + 8] : 0.f;
#pragma unroll
            for (int i = 0; i < 8; ++i) z[i + 1] = (float)raw[i];
            h8 o;
#pragma unroll
            for (int i = 0; i < 8; ++i) o[i] = (_Float16)(w0 * z[i] + w1 * z[i + 1] + w2 * z[i + 2] + cb);
            *(CV_LAS h8*)(wl + V_OFF + bl * PV + t0 * 2) = o;
        }
    }
    const int t2 = lane & 31, hi = lane >> 5, col = lane & 31, bl = col / T1L, t1l = col % T1L;
    const int abase = (t2 & 1) ? FA_OFF + 2 * ((L - 1) - t2 + 8 * hi) : FB_OFF + 2 * ((L - 1) - t2 + 8 * hi - 1);
    const int vbase = V_OFF + bl * PV + 16 * hi;
#pragma unroll 1
    for (int o = 0; o < 2; ++o) {
        {
            const u4* Fg = (const u4*)(P.FILT + filt_off(LV, o, ch));
            for (int piece = lane; piece < 2 * L / 8; piece += 64) {
                const u4 a = Fg[piece]; const unsigned e0 = piece + 1 < 2 * L / 8 ? ((const unsigned*)(Fg + piece + 1))[0] : 0u;
                u4 b; b.x = (a.x >> 16) | (a.y << 16); b.y = (a.y >> 16) | (a.z << 16); b.z = (a.z >> 16) | (a.w << 16); b.w = (a.w >> 16) | (e0 << 16);
                *(CV_LAS u4*)(wl + FA_OFF + piece * 16) = a;
                *(CV_LAS u4*)(wl + FB_OFF + piece * 16) = b;
            }
        }
        f32x16 acc[NCT];
#pragma unroll
        for (int ct = 0; ct < NCT; ++ct)
#pragma unroll
            for (int r = 0; r < 16; ++r) acc[ct][r] = 0.f;
#pragma unroll 1
        for (int d = -(T1 - 1); d <= T1 - 1; ++d) {
            const CV_LAS unsigned* ap = (const CV_LAS unsigned*)(wl + abase - 64 * d);
            u4 a0, a1;
            a0.x = ap[0]; a0.y = ap[1]; a0.z = ap[2]; a0.w = ap[3];
            a1.x = ap[8]; a1.y = ap[9]; a1.z = ap[10]; a1.w = ap[11];
            const h8 A0 = __builtin_bit_cast(h8, a0), A1 = __builtin_bit_cast(h8, a1);
#pragma unroll
            for (int ct = 0; ct < NCT; ++ct) {
                const int lo = ct * T1L - d;
                if (lo + T1L - 1 < 0 || lo > T1 - 1) continue;
                const int s1 = lo + t1l; const bool valid = (unsigned)s1 < (unsigned)T1; const int s1c = valid ? s1 : 0;
                h8 b0 = *(const CV_LAS h8*)(wl + vbase + s1c * 64), b1 = *(const CV_LAS h8*)(wl + vbase + s1c * 64 + 32);
                if (!valid) {
#pragma unroll
                    for (int i = 0; i < 8; ++i) { b0[i] = (_Float16)0.f; b1[i] = (_Float16)0.f; } }
                acc[ct] = __builtin_amdgcn_mfma_f32_32x32x16_f16(A0, b0, acc[ct], 0, 0, 0);
                acc[ct] = __builtin_amdgcn_mfma_f32_32x32x16_f16(A1, b1, acc[ct], 0, 0, 0);
            }
        }
        {
            const int gch = (o + 1) * 1024 + ch;
            const _Float16* xrow = P.zT + (size_t)gch * 12288 + row_base + bl * L;
            const float g0 = P.conv_w[gch], g1 = P.conv_w[3072 + gch], g2 = P.conv_w[6144 + gch], gcb = P.conv_b[gch], fbv = P.fbias[o * 1024 + ch];
#pragma unroll
            for (int ct = 0; ct < NCT; ++ct)
#pragma unroll
                for (int g = 0; g < 4; ++g) {
                    const int t = 32 * (ct * T1L + t1l) + 8 * g + 4 * hi;
                    const h4 zz = *(const h4*)(xrow + t);
                    float z[6]; z[0] = t > 0 ? (float)xrow[t - 1] : 0.f; z[5] = t + 4 < L ? (float)xrow[t + 4] : 0.f;
#pragma unroll
                    for (int i = 0; i < 4; ++i) z[i + 1] = (float)zz[i];
                    CV_LAS h4* vp = (CV_LAS h4*)(wl + V_OFF + bl * PV + t * 2);
                    const h4 vin = *vp; h4 vo;
#pragma unroll
                    for (int i = 0; i < 4; ++i) { const float gate = g0 * z[i] + g1 * z[i + 1] + g2 * z[i + 2] + gcb;
                        vo[i] = (_Float16)((acc[ct][4 * g + i] * (1.f / FSCALE) + (float)vin[i] * fbv) * gate); }
                    *vp = vo;
                }
        }
    }
    __syncthreads();
    for (int idx = tid; idx < NBu * L; idx += 512) {
        const int b2 = idx / L, t = idx % L; h8 o;
#pragma unroll
        for (int ww = 0; ww < 8; ++ww) o[ww] = *(const CV_LAS _Float16*)(lds + ww * WAVE_LDS + V_OFF + b2 * PV + t * 2);
        *(h8*)(P.V2 + ((size_t)c * 12288 + row_base + b2 * L + t) * 8) = o;
    }
    __syncthreads();
}
__device__ __forceinline__ void conv_phase(CV_LAS unsigned char* lds, const Args& P, int G, int bid) {
    for (int u = bid; u < 256; u += G) conv_unit<1>(lds, P, u >> 1, u & 1);
    for (int u = bid; u < 256; u += G) conv_unit<0>(lds, P, u >> 1, u & 1);
}
}
namespace s5 {
#define S5_LAS __attribute__((address_space(3)))
typedef _Float16 h8 __attribute__((ext_vector_type(8)));
typedef _Float16 h4 __attribute__((ext_vector_type(4)));
typedef _Float16 h2 __attribute__((ext_vector_type(2)));
typedef float f32x16 __attribute__((ext_vector_type(16)));
typedef float f32x4 __attribute__((ext_vector_type(4)));
constexpr int IMG_PITCH = 288, WAVE_LDS = 32 * IMG_PITCH;
constexpr int TT = 12288;
struct Args { const _Float16* UP; const float* ssq; const float* MOD; const float* PW; const _Float16* BB;
              const float* C_re; const float* C_im; const float* Dv; const float* state_in; float* YB; _Float16* Y2; float* new_state; };
__device__ __forceinline__ float gelu_fast(float x) { const float u = 1.5957691216057308f * (x + 0.044715f * x * x * x); return x / (1.f + __expf(-u)); }
__device__ __forceinline__ void s5_table(int ix, const float* A_re, const float* A_im, const float* log_dt, const float* B_re, const float* B_im, float* PW, _Float16* BB) {
    const double are = A_re[ix], aim = A_im[ix], dt = exp((double)log_dt[ix >> 6]);
    const double mag = exp(dt * are), ph = dt * aim, abr = mag * cos(ph), abi = mag * sin(ph);
    const double nr = abr - 1.0, ni = abi, den = are * are + aim * aim, cor = (nr * are + ni * aim) / den, coi = (ni * are - nr * aim) / den;
    double pr = abr, pi = abi;
    for (int k = 0; k < 4; ++k) { PW[(size_t)ix * 8 + 2 * k] = (float)pr; PW[(size_t)ix * 8 + 2 * k + 1] = (float)pi; const double tr = pr * abr - pi * abi; pi = pr * abi + pi * abr; pr = tr; }
    for (int h = 0; h < 16; ++h) { const double br = B_re[(size_t)ix * 16 + h], bi = B_im[(size_t)ix * 16 + h];
        BB[(size_t)ix * 32 + h] = (_Float16)(float)(cor * br - coi * bi); BB[(size_t)ix * 32 + 16 + h] = (_Float16)(float)(cor * bi + coi * br); }
}
__device__ __forceinline__ void s5_unit(S5_LAS unsigned char* img, const Args& P, int seq, int g) {
    const int lane = threadIdx.x & 63, n = lane & 31, hi = lane >> 5, tq = lane & 15, q4 = lane >> 4;
    const bool ctx = seq < 16;
    const int L = ctx ? 256 : 1024, base = ctx ? seq * 256 : 4096 + (seq - 16) * 1024, ci = ctx ? 0 : 1 + (seq - 16);
    const float* mod = P.MOD + (ci * 2 + 1) * 6144;
    float shA[8], shO[4], dvO[4];
#pragma unroll
    for (int j = 0; j < 8; ++j) shA[j] = mod[16 * g + 8 * hi + j];
#pragma unroll
    for (int j = 0; j < 4; ++j) { shO[j] = mod[16 * g + 4 * q4 + j]; dvO[j] = P.Dv[16 * g + 4 * q4 + j]; }
    const _Float16* up = P.UP + (size_t)g * TT * 16;
    float* yb = P.YB + (size_t)g * TT * 16;
#pragma unroll 1
    for (int pass = 0; pass < 2; ++pass) {
        const int dir = 1 - pass;
        float pw[2][4][2];
        h8 Bf[2][2];
        float cr[2], cim[2];
#pragma unroll
        for (int half = 0; half < 2; ++half) {
            const int p = n + 32 * half, ix = (dir * 64 + g) * 64 + p;
            const f32x4 q0 = *(const f32x4*)(P.PW + (size_t)ix * 8), q1 = *(const f32x4*)(P.PW + (size_t)ix * 8 + 4);
            pw[half][0][0] = q0[0]; pw[half][0][1] = q0[1]; pw[half][1][0] = q0[2]; pw[half][1][1] = q0[3]; pw[half][2][0] = q1[0]; pw[half][2][1] = q1[1]; pw[half][3][0] = q1[2]; pw[half][3][1] = q1[3];
            Bf[half][0] = *(const h8*)(P.BB + (size_t)ix * 32 + 8 * hi); Bf[half][1] = *(const h8*)(P.BB + (size_t)ix * 32 + 16 + 8 * hi);
            if (ctx) { cr[half] = 0.f; cim[half] = 0.f; }
            else { const int b = seq - 16; cr[half] = P.state_in[((b * 2 + dir) * 2 + 0) * 4096 + g * 64 + p]; cim[half] = P.state_in[((b * 2 + dir) * 2 + 1) * 4096 + g * 64 + p]; }
        }
        h8 Cf[4];
#pragma unroll
        for (int kk = 0; kk < 4; ++kk)
#pragma unroll
            for (int j = 0; j < 8; ++j) { const int k = 32 * kk + 8 * q4 + j, p = k >> 1; const size_t cx = ((size_t)(dir * 64 + g) * 16 + tq) * 64 + p;
                Cf[kk][j] = (_Float16)((k & 1) ? -P.C_im[cx] : P.C_re[cx]); }
#pragma unroll 1
        for (int jt = 0; jt < L / 32; ++jt) {
            const int tA = dir ? L - 1 - (32 * jt + n) : 32 * jt + n, rowA = base + tA;
            const h8 ur = *(const h8*)(up + (size_t)rowA * 16 + 8 * hi);
            const float rsA = 1.0f / sqrtf(P.ssq[rowA] * (1.f / 1024.f) + 1e-6f);
            h8 Au;
#pragma unroll
            for (int j = 0; j < 8; ++j) Au[j] = (_Float16)(rsA * (float)ur[j] + shA[j]);
            const f32x16 zero = {0.f, 0.f, 0.f, 0.f, 0.f, 0.f, 0.f, 0.f, 0.f, 0.f, 0.f, 0.f, 0.f, 0.f, 0.f, 0.f};
#pragma unroll
            for (int half = 0; half < 2; ++half) {
                f32x16 xr = __builtin_amdgcn_mfma_f32_32x32x16_f16(Au, Bf[half][0], zero, 0, 0, 0);
                f32x16 xi = __builtin_amdgcn_mfma_f32_32x32x16_f16(Au, Bf[half][1], zero, 0, 0, 0);
                const float a1r = pw[half][0][0], a1i = pw[half][0][1], a4r = pw[half][3][0], a4i = pw[half][3][1];
#pragma unroll
                for (int q = 0; q < 4; ++q)
#pragma unroll
                    for (int j = 1; j < 4; ++j) { const int r = 4 * q + j; const float pr = xr[r - 1], pi = xi[r - 1];
                        xr[r] = a1r * pr - a1i * pi + xr[r]; xi[r] = a1r * pi + a1i * pr + xi[r]; }
                float er[4], ei[4], per[4], pei[4];
#pragma unroll
                for (int q = 0; q < 4; ++q) { er[q] = xr[4 * q + 3]; ei[q] = xi[4 * q + 3]; per[q] = __shfl_xor(er[q], 32); pei[q] = __shfl_xor(ei[q], 32); }
                float sr = cr[half], si = cim[half], inr[4], ini[4];
#pragma unroll
                for (int i = 0; i < 8; ++i) { const int q = i >> 1; const bool own = ((i & 1) == hi);
                    if ((i & 1) == 0) { inr[q] = sr; ini[q] = si; } else { inr[q] = hi ? sr : inr[q]; ini[q] = hi ? si : ini[q]; }
                    const float evr = own ? er[q] : per[q], evi = own ? ei[q] : pei[q];
                    const float tr = a4r * sr - a4i * si + evr; si = a4r * si + a4i * sr + evi; sr = tr; }
                cr[half] = sr; cim[half] = si;
#pragma unroll
                for (int q = 0; q < 4; ++q)
#pragma unroll
                    for (int j = 0; j < 4; ++j) { const int r = 4 * q + j; const float hr = xr[r] + pw[half][j][0] * inr[q] - pw[half][j][1] * ini[q], hm = xi[r] + pw[half][j][0] * ini[q] + pw[half][j][1] * inr[q];
                        const int tau = (r & 3) + 8 * (r >> 2) + 4 * hi; h2 v; v.x = (_Float16)hr; v.y = (_Float16)hm;
                        *(S5_LAS h2*)(img + tau * IMG_PITCH + (n + 32 * half) * 4) = v; }
            }
#pragma unroll
            for (int nt = 0; nt < 2; ++nt) {
                f32x4 acc = {0.f, 0.f, 0.f, 0.f};
#pragma unroll
                for (int kk = 0; kk < 4; ++kk) { const h8 hb = *(const S5_LAS h8*)(img + (tq + 16 * nt) * IMG_PITCH + (32 * kk + 8 * q4) * 2);
                    acc = __builtin_amdgcn_mfma_f32_16x16x32_f16(Cf[kk], hb, acc, 0, 0, 0); }
                const int s = 32 * jt + tq + 16 * nt, t = dir ? L - 1 - s : s, row = base + t;
                if (pass == 0) *(f32x4*)(yb + (size_t)row * 16 + 4 * q4) = acc;
                else {
                    const f32x4 ybv = *(const f32x4*)(yb + (size_t)row * 16 + 4 * q4);
                    const h4 u4 = *(const h4*)(up + (size_t)row * 16 + 4 * q4);
                    const float rs = 1.0f / sqrtf(P.ssq[row] * (1.f / 1024.f) + 1e-6f);
                    h4 o;
#pragma unroll
                    for (int j = 0; j < 4; ++j) { const float u = rs * (float)u4[j] + shO[j]; o[j] = (_Float16)gelu_fast(u * dvO[j] + acc[j] + ybv[j]); }
                    *(h4*)(P.Y2 + ((size_t)(2 * g + (q4 >> 1)) * TT + row) * 8 + 4 * (q4 & 1)) = o;
                }
            }
        }
        if (ctx && hi == 0) {
#pragma unroll
            for (int half = 0; half < 2; ++half) { const int p = n + 32 * half;
                P.new_state[((seq * 2 + dir) * 2 + 0) * 4096 + g * 64 + p] = cr[half]; P.new_state[((seq * 2 + dir) * 2 + 1) * 4096 + g * 64 + p] = cim[half]; }
        }
    }
}
__device__ __forceinline__ void s5_phase(S5_LAS unsigned char* lds, const Args& P, int G, int bid) {
    const int w = __builtin_amdgcn_readfirstlane(threadIdx.x >> 6);
    for (int u = w * G + bid; u < 1536; u += 8 * G) {
        const int seq = u < 512 ? 16 + (u >> 6) : ((u - 512) >> 6), g = u & 63;
        s5_unit(lds + w * WAVE_LDS, P, seq, g);
    }
}
}
#define LAS __attribute__((address_space(3)))
#define XB_TMO      128
#define XB_XCNT(j)  (256  + 64 * (j))
#define XB_XSUB(j)  (1280 + 64 * (j))
#define XB_XGEN(j)  (2304 + 64 * (j))
#define XB_TOP      3328
#define XB_TOPGEN   3392
#define XCD_BAR_WORDS 3456
#define XB_SPIN_CAP (1u << 18)
__device__ __forceinline__ unsigned xb_ld(unsigned* p)              { return __hip_atomic_load(p, __ATOMIC_RELAXED, __HIP_MEMORY_SCOPE_AGENT); }
__device__ __forceinline__ unsigned xb_add(unsigned* p, unsigned v) { return __hip_atomic_fetch_add(p, v, __ATOMIC_RELAXED, __HIP_MEMORY_SCOPE_AGENT); }
__device__ __forceinline__ unsigned xb_xcc_id() { return (unsigned)__builtin_amdgcn_s_getreg((3 << 11) | 20) & 0xFu; }
#define XB_SPIN(cond, bar) do { unsigned _sp = 0; while (cond) { __builtin_amdgcn_s_sleep(1); \
    if ((++_sp & 255u) == 0u) { if (xb_ld(&(bar)[XB_TMO])) break; if (_sp > XB_SPIN_CAP) { atomicAdd(&(bar)[XB_TMO], 1u); break; } } } } while (0)
struct XcdBarrier { unsigned* bar; unsigned x; volatile LAS unsigned* st; };
__device__ __forceinline__ XcdBarrier xcd_barrier_post(unsigned* bar, volatile LAS unsigned* st) {
    XcdBarrier b; b.bar = bar; b.x = xb_xcc_id(); b.st = st;
    if (threadIdx.x == 0) (void)xb_add(&bar[XB_XCNT(b.x)], 1u);
    return b;
}
__device__ __forceinline__ void xcd_barrier_complete(unsigned* bar, unsigned x, unsigned& nloc, unsigned& nx) {
    const unsigned G = gridDim.x * gridDim.y * gridDim.z;
    unsigned sum, cnt, mine, sp = 0u;
    for (;;) {
        sum = 0u; cnt = 0u; mine = 0u;
#pragma unroll
        for (unsigned j = 0; j < 16; ++j) { const unsigned c = xb_ld(&bar[XB_XCNT(j)]); sum += c; cnt += (c > 0u) ? 1u : 0u; mine = (j == x) ? c : mine; }
        if (sum == G) break;
        __builtin_amdgcn_s_sleep(1);
        if ((++sp & 255u) == 0u) { if (xb_ld(&bar[XB_TMO])) break; if (sp > XB_SPIN_CAP) { atomicAdd(&bar[XB_TMO], 1u); break; } }
    }
    nloc = mine > 0u ? mine : 1u; nx = cnt > 0u ? cnt : 1u;
}
__device__ __forceinline__ void xcd_barrier(const XcdBarrier& b) {
    asm volatile("s_waitcnt vmcnt(0)" ::: "memory");
    __syncthreads();
    if (threadIdx.x == 0) {
        unsigned* bar = b.bar;
        __builtin_amdgcn_s_waitcnt(0);
        unsigned nloc = b.st[0], nx = b.st[1];
        if (nloc == 0u) { xcd_barrier_complete(bar, b.x, nloc, nx); b.st[0] = nloc; b.st[1] = nx; }
        const unsigned old = xb_add(&bar[XB_XSUB(b.x)], 1u);
        const unsigned gen = old / nloc;
        if (old + 1u == (gen + 1u) * nloc) {
            __builtin_amdgcn_fence(__ATOMIC_RELEASE, "agent");
            asm volatile("s_waitcnt vmcnt(0)" ::: "memory");
            const unsigned og = xb_add(&bar[XB_TOP], 1u);
            const unsigned tg = og / nx;
            if (og + 1u == (tg + 1u) * nx) xb_add(&bar[XB_TOPGEN], 1u);
            else XB_SPIN(xb_ld(&bar[XB_TOPGEN]) == tg, bar);
            __builtin_amdgcn_fence(__ATOMIC_ACQUIRE, "agent");
            xb_add(&bar[XB_XGEN(b.x)], 1u);
            asm volatile("s_waitcnt vmcnt(0)" ::: "memory");
        } else {
            XB_SPIN(xb_ld(&bar[XB_XGEN(b.x)]) == gen, bar);
            __builtin_amdgcn_fence(__ATOMIC_ACQUIRE, "agent");
            asm volatile("s_waitcnt vmcnt(0)" ::: "memory");
        }
    }
    __syncthreads();
}

struct EpiZT { f16h* zT; const float* bias;
    __device__ __forceinline__ void operator()(const g8::f32x4 (&acc)[2][2][4][2], const g8::Unit& u, int wr, int wc, int fr, int fq) const {
        const int row0 = u.pm * 256 + wr * 64 + fr, col0 = u.pn * 256 + wc * 32 + 4 * fq;
#pragma unroll
        for (int ai = 0; ai < 2; ++ai)
#pragma unroll
            for (int m = 0; m < 4; ++m) { const int row = row0 + ai * 128 + m * 16; const float bv = bias[row];
#pragma unroll
                for (int bj = 0; bj < 2; ++bj)
#pragma unroll
                    for (int n = 0; n < 2; ++n) { const g8::f32x4 a = acc[ai][bj][m][n]; g8::u32x2 w; w.x = pkh(a[0] + bv, a[1] + bv); w.y = pkh(a[2] + bv, a[3] + bv);
                        *(g8::u32x2*)(zT + (size_t)row * 12288 + col0 + bj * 128 + n * 16) = w; } }
    } };
struct ResOut { float* X; f16h* XA; const float* ng; float* ssq; const float* xp; const float* xs; const float* post; int xa_mode; int pad; };
template <bool XIN> __device__ __forceinline__ void res_store(const ResOut& R, const float* gate, const float* sc, int row, int c, g8::f32x4 val, float& sq) {
    float* p = R.X + (size_t)row * 1024 + c; g8::f32x4 x;
    if (XIN) {
        if (row < NCTX) x = *(const g8::f32x4*)(R.xp + (size_t)row * 1024 + c);
        else { const int r = row - NCTX, t = r & 1023; x = *(const g8::f32x4*)(R.xs + (size_t)r * 1024 + c);
            x += *(const g8::f32x4*)(c < 512 ? R.post + (t >> 6) * 512 + c : R.post + 16 * 512 + (t & 63) * 512 + (c - 512)); }
    } else x = *(g8::f32x4*)p;
    x += *(const g8::f32x4*)(gate + c) * val; *(g8::f32x4*)p = x;
    sq += (x[0] * x[0] + x[1] * x[1]) + (x[2] * x[2] + x[3] * x[3]);
    if (R.XA) { const g8::f32x4 ng = *(const g8::f32x4*)(R.ng + c), s = *(const g8::f32x4*)(sc + c); g8::u32x2 w;
        w.x = pkh(x[0] * ng[0] * (1.f + s[0]), x[1] * ng[1] * (1.f + s[1])); w.y = pkh(x[2] * ng[2] * (1.f + s[2]), x[3] * ng[3] * (1.f + s[3]));
        f16h* q = R.xa_mode == 0 ? R.XA + (size_t)row * 1024 + c : R.XA + ((size_t)(c >> 4) * T + row) * 16 + (c & 15);
        *(g8::u32x2*)q = w; }
}
template <bool XIN> struct EpiRes2 { ResOut R; const float* bias; const float* MOD; int gateoff, scoff;
    __device__ __forceinline__ void operator()(const g8::f32x4 (&acc)[2][2][4][2], const g8::Unit& u, int wr, int wc, int fr, int fq) const {
        const int row0 = u.pm * 256 + wr * 64 + fr, col0 = u.pn * 256 + wc * 32 + 4 * fq;
        const float* mb = MOD + (row_ci(u.pm * 256) * 2) * 6144; const float* gate = mb + gateoff; const float* sc = mb + scoff;
#pragma unroll
        for (int ai = 0; ai < 2; ++ai)
#pragma unroll
            for (int m = 0; m < 4; ++m) { const int row = row0 + ai * 128 + m * 16; float sq = 0.f;
#pragma unroll
                for (int bj = 0; bj < 2; ++bj)
#pragma unroll
                    for (int n = 0; n < 2; ++n) { const int c = col0 + bj * 128 + n * 16; g8::f32x4 v = acc[ai][bj][m][n]; if (bias) v += *(const g8::f32x4*)(bias + c); res_store<XIN>(R, gate, sc, row, c, v, sq); }
                if (R.ssq) { sq += __shfl_xor(sq, 16); sq += __shfl_xor(sq, 32); if (fq == 0) atomic_add_done(R.ssq + row, sq); } }
    } };
struct EpiGlu2 { ResOut R; const float* bias; const float* MOD; int gateoff, scoff;
    __device__ __forceinline__ void operator()(const g8::f32x4 (&acc)[2][2][4][2], const g8::Unit& u, int wr, int wc, int fr, int fq) const {
        const int row0 = u.pm * 256 + wr * 64 + fr, col0 = u.pn * 128 + wc * 32 + 4 * fq;
        const float* mb = MOD + (row_ci(u.pm * 256) * 2) * 6144; const float* gate = mb + gateoff; const float* sc = mb + scoff;
#pragma unroll
        for (int ai = 0; ai < 2; ++ai)
#pragma unroll
            for (int m = 0; m < 4; ++m) { const int row = row0 + ai * 128 + m * 16; float sq = 0.f;
#pragma unroll
                for (int n = 0; n < 2; ++n) { const int c = col0 + n * 16; const g8::f32x4 a = acc[ai][0][m][n] + *(const g8::f32x4*)(bias + c), g = acc[ai][1][m][n] + *(const g8::f32x4*)(bias + 1024 + c);
                    g8::f32x4 v;
#pragma unroll
                    for (int j = 0; j < 4; ++j) v[j] = a[j] * sigmf(g[j]);
                    res_store<false>(R, gate, sc, row, c, v, sq); }
                if (R.ssq) { sq += __shfl_xor(sq, 16); sq += __shfl_xor(sq, 32); if (fq == 0) atomic_add_done(R.ssq + row, sq); } }
    } };
struct EpiSwiglu2 { f16h* hid; const float* ssq; const float* bias2;
    __device__ __forceinline__ void operator()(const g8::f32x4 (&acc)[2][2][4][2], const g8::Unit& u, int wr, int wc, int fr, int fq) const {
        const int row0 = u.pm * 256 + wr * 64 + fr, col0 = u.pn * 128 + wc * 32 + 4 * fq;
        const float* b2 = bias2 + row_ci(u.pm * 256) * 5632;
#pragma unroll
        for (int n = 0; n < 2; ++n) { const g8::f32x4 ba = *(const g8::f32x4*)(b2 + col0 + n * 16), bb = *(const g8::f32x4*)(b2 + 2816 + col0 + n * 16);
#pragma unroll
            for (int ai = 0; ai < 2; ++ai)
#pragma unroll
                for (int m = 0; m < 4; ++m) { const int row = row0 + ai * 128 + m * 16; const float rstd = 1.0f / sqrtf(ssq[row] * (1.f / 1024.f) + 1e-6f);
                    const g8::f32x4 a = acc[ai][0][m][n] * rstd + ba, b = acc[ai][1][m][n] * rstd + bb; g8::u32x2 w;
                    w.x = pkh(siluf(a[0]) * b[0], siluf(a[1]) * b[1]); w.y = pkh(siluf(a[2]) * b[2], siluf(a[3]) * b[3]);
                    *(g8::u32x2*)(hid + (size_t)row * 2816 + col0 + n * 16) = w; } }
    } };

typedef const __attribute__((address_space(4))) Params* KP;
struct Frame { LAS unsigned char* lds; int tid, lane, wave, G, bid; };
__device__ __forceinline__ float wave_sum(float v) {
#pragma unroll
    for (int o = 1; o < 64; o <<= 1) v += __shfl_xor(v, o);
    return v;
}
__device__ __forceinline__ void transpose_item(const float* W, int K, int N, f16h* WT, LAS float* scr, int item, int lane) {
    const int nblk = N / 32, kb = item / nblk, nb = item % nblk, k0 = 64 * kb, n0 = 32 * nb;
#pragma unroll 8
    for (int i = 0; i < 32; ++i) { const int kk = 2 * i + (lane >> 5); scr[kk * 33 + (lane & 31)] = W[(size_t)(k0 + kk) * N + n0 + (lane & 31)]; }
    asm volatile("s_waitcnt lgkmcnt(0)" ::: "memory");
    const int c = lane & 7;
#pragma unroll
    for (int j = 0; j < 4; ++j) { const int n = (lane >> 3) + 8 * j; const LAS float* s = scr + (8 * c) * 33 + n;
        g8::u32x4 o; o.x = pkh(s[0 * 33], s[1 * 33]); o.y = pkh(s[2 * 33], s[3 * 33]); o.z = pkh(s[4 * 33], s[5 * 33]); o.w = pkh(s[6 * 33], s[7 * 33]);
        *(g8::u32x4*)(WT + (size_t)(n0 + n) * K + k0 + 8 * c) = o; }
    asm volatile("s_waitcnt lgkmcnt(0)" ::: "memory");
}
__device__ __forceinline__ void gemv9_item(const float* W, int ldw, int col0, int kq, const LAS float* tab, float* out, int ostride, const float* bias, int lane) {
    const int col = col0 + lane; float acc[9];
#pragma unroll
    for (int ci = 0; ci < 9; ++ci) acc[ci] = 0.f;
    const float* w = W + (size_t)(kq * 256) * ldw + col;
#pragma unroll 2
    for (int k4 = 0; k4 < 64; ++k4) {
        const float w0 = w[(size_t)(4 * k4) * ldw], w1 = w[(size_t)(4 * k4 + 1) * ldw], w2 = w[(size_t)(4 * k4 + 2) * ldw], w3 = w[(size_t)(4 * k4 + 3) * ldw];
#pragma unroll
        for (int ci = 0; ci < 9; ++ci) { const g8::f32x4 s = *(const LAS g8::f32x4*)(tab + ci * 1024 + kq * 256 + 4 * k4); acc[ci] += s[0] * w0 + s[1] * w1 + s[2] * w2 + s[3] * w3; }
    }
#pragma unroll
    for (int ci = 0; ci < 9; ++ci) atomic_add_done(out + (size_t)ci * ostride + col, acc[ci] + ((bias && kq == 0) ? bias[col] : 0.f));
}
__device__ __forceinline__ void filt_item(const float* H2, const float* w3, float* NORM, f16h* FILT, int lv, int o, int mr, int d0, int lane, bool pass2) {
    const int L = lv ? 1024 : 256, d = d0 + lane, m0 = 32 * mr, dir = m0 >= L ? 1 : 0;
    float w[64];
#pragma unroll
    for (int m = 0; m < 64; ++m) w[m] = w3[m * 4096 + o * 2048 + dir * 1024 + d];
    const double maxd = log(1e-2) / 0.3, mind = log(1e-2) / 1.5;
    const float delta = fabsf((float)(mind + (double)d * (maxd - mind) / 1023.0));
    const float tstep = (float)(1.0 / (double)(L - 1));
    const float* h2 = H2 + (lv ? 256 : 0) * 64;
    float inv = 0.f; if (pass2) inv = cv::FSCALE / (NORM[(lv * 2 + o) * 1024 + d] + 1e-6f);
    float sabs = 0.f; f16h taps[32];
    const int extra = (!pass2 && m0 == L) ? 1 : 0;
#pragma unroll 1
    for (int mm = -extra; mm < 32; ++mm) {
        const int m = m0 + mm, j = (L - 1) - m, i = j < 0 ? -j : j;
        float a = 0.f;
        if (i < L) {
            const float* hr = h2 + i * 64;
#pragma unroll
            for (int q = 0; q < 64; ++q) a += hr[q] * w[q];
            a *= __expf(-(float)i * tstep * delta);
        }
        sabs += fabsf(a);
        if (mm >= 0) {
#pragma unroll
            for (int q = 0; q < 32; ++q) if (q == mm) taps[q] = (f16h)(a * inv);
        }
    }
    if (!pass2) atomic_add_done(&NORM[(lv * 2 + o) * 1024 + d], sabs);
    else {
        f16h* dst = FILT + (lv ? (size_t)2 * 1024 * 512 + (size_t)(o * 1024 + d) * 2048 : (size_t)(o * 1024 + d) * 512) + m0;
#pragma unroll
        for (int q = 0; q < 4; ++q) { cv::h8 v;
#pragma unroll
            for (int e = 0; e < 8; ++e) v[e] = taps[8 * q + e];
            *(cv::h8*)(dst + 8 * q) = v; }
    }
}
__device__ __forceinline__ void filt_items(Frame& F, KP P, int first_block, int nblocks, bool pass2) {
    const float* H2 = (const float*)(P->ws + WS_H2); float* NORM = (float*)(P->ws + WS_NORM); f16h* FILT = (f16h*)(P->ws + WS_FILT);
    if (F.bid < first_block) return;
    const int gw = (F.bid - first_block) * 8 + F.wave, NGW = nblocks * 8;
    for (int it = gw; it < 2560; it += NGW) {
        int lv, r = it; if (r < 512) lv = 0; else { lv = 1; r -= 512; }
        const int nr = lv ? 64 : 16, db = r & 15, mr = (r >> 4) % nr, o = (r >> 4) / nr;
        filt_item(H2, P->in[20], NORM, FILT, lv, o, mr, db * 64, F.lane, pass2);
    }
}
__device__ __forceinline__ void phase0(Frame& F, KP P) {
    LAS float* tab = (LAS float*)F.lds;
    LAS float* scr = (LAS float*)(F.lds + 36864 + F.wave * 8448);
    for (int i = F.tid; i < 9 * 1024; i += 512) { const int ci = i >> 10, k = i & 1023; const float v = ci == 0 ? P->in[4][k] : P->in[3][(ci - 1) * 1024 + k]; tab[i] = v / (1.f + expf(-v)); }
    __syncthreads();
    const int gw = F.bid * 8 + F.wave, NGW = F.G * 8;
    float* MOD = (float*)(P->ws + WS_MOD);
    for (int it = gw; it < 768; it += NGW) { const int kq = it & 3, cb = (it >> 2) % 96, l = (it >> 2) / 96;
        gemv9_item(P->in[8] + (size_t)l * 1024 * 6144, 6144, cb * 64, kq, tab, MOD + l * 6144, 2 * 6144, P->in[9] + l * 6144, F.lane); }
    for (int pos = gw; pos < 1280; pos += NGW) {
        const int L = pos < 256 ? 256 : 1024, i = pos < 256 ? pos : pos - 256, lane = F.lane;
        if (lane < 33) { float z;
            if (lane == 0) z = (float)((double)i / (double)(L - 1));
            else { const int m = (lane - 1) & 15; const double band = 1e-4 + (double)m * ((15.0 - 1e-4) / 15.0), w = 2.0 * 3.14159265358979323846 * (double)i / (double)L;
                z = lane <= 16 ? (float)cos(band * w) : (float)(-sin(band * w)); }
            scr[lane] = z; }
        asm volatile("s_waitcnt lgkmcnt(0)" ::: "memory");
        float a = P->in[17][lane];
        for (int k = 0; k < 33; ++k) a += scr[k] * P->in[16][k * 64 + lane];
        scr[64 + lane] = sinf(P->in[21][lane] * a);
        asm volatile("s_waitcnt lgkmcnt(0)" ::: "memory");
        float a2 = P->in[19][lane];
        for (int k = 0; k < 64; ++k) a2 += scr[64 + k] * P->in[18][k * 64 + lane];
        ((float*)(P->ws + WS_H2))[pos * 64 + lane] = sinf(P->in[21][lane] * a2);
        asm volatile("s_waitcnt lgkmcnt(0)" ::: "memory");
    }
    { float* post = (float*)(P->ws + WS_POST);
      for (int i = F.bid * 512 + F.tid; i < 80 * 512; i += F.G * 512) { const int n = i >> 9, d = i & 511, nn = n < 16 ? n : n - 16;
          const double om = exp(-log(10000.0) * (double)(d & 255) / 256.0), ang = (double)nn * om; post[i] = (float)(d < 256 ? sin(ang) : cos(ang)); } }
    for (int ix = F.bid * 512 + F.tid; ix < 8192; ix += F.G * 512) s5::s5_table(ix, P->in[25], P->in[26], P->in[27], P->in[28], P->in[29], (float*)(P->ws + WS_S5PW), (f16h*)(P->ws + WS_S5BB));
    { constexpr int I_IN = 16 * 96, I_OUT = 16 * 32, I_13 = 16 * 176, I_2 = 44 * 32, I_GLU = 16 * 64, NIT = I_IN + I_OUT + 2 * I_13 + 2 * I_2 + I_GLU;
      for (int it = gw; it < NIT; it += NGW) { int r = it;
          if (r < I_IN) { transpose_item(P->in[12], 1024, 3072, (f16h*)(P->ws + WS_WIN), scr, r, F.lane); continue; } r -= I_IN;
          if (r < I_OUT) { transpose_item(P->in[23], 1024, 1024, (f16h*)(P->ws + WS_WOUT), scr, r, F.lane); continue; } r -= I_OUT;
          if (r < 2 * I_13) { const int l = r / I_13; transpose_item(P->in[10] + (size_t)l * 1024 * 5632, 1024, 5632, (f16h*)(P->ws + WS_W13) + (size_t)l * 5632 * 1024, scr, r % I_13, F.lane); continue; } r -= 2 * I_13;
          if (r < 2 * I_2) { const int l = r / I_2; transpose_item(P->in[11] + (size_t)l * 2816 * 1024, 2816, 1024, (f16h*)(P->ws + WS_W2) + (size_t)l * 1024 * 2816, scr, r % I_2, F.lane); continue; } r -= 2 * I_2;
          transpose_item(P->in[33], 1024, 2048, (f16h*)(P->ws + WS_WGLU), scr, r, F.lane); } }
}
__device__ __forceinline__ void phase1(Frame& F, KP P) {
    const float* MOD = (const float*)(P->ws + WS_MOD);
    const int gw = F.bid * 8 + F.wave, NGW = F.G * 8;
    LAS float* tab = (LAS float*)F.lds;
    for (int i = F.tid; i < 2 * 9 * 1024; i += 512) { const int l = i / 9216, r = i % 9216, ci = r >> 10, k = r & 1023; tab[i] = MOD[(ci * 2 + l) * 6144 + 3072 + k]; }
    __syncthreads();
    float* BIAS2 = (float*)(P->ws + WS_BIAS2);
    for (int it = gw; it < 704; it += NGW) { const int kq = it & 3, cb = (it >> 2) % 88, l = (it >> 2) / 88;
        gemv9_item(P->in[10] + (size_t)l * 1024 * 5632, 5632, cb * 64, kq, tab + l * 9216, BIAS2 + (size_t)l * 9 * 5632, 5632, nullptr, F.lane); }
    { f16h* XA = (f16h*)(P->ws + WS_XA); const float* post = (const float*)(P->ws + WS_POST); const float* ng = P->in[5];
      for (int row = gw; row < T; row += NGW) {
          const float* mb = MOD + (row_ci(row) * 2) * 6144; g8::f32x4 v[4]; float s = 0.f;
#pragma unroll
          for (int j = 0; j < 4; ++j) { const int c = 4 * F.lane + 256 * j;
              if (row < NCTX) v[j] = *(const g8::f32x4*)(P->in[0] + (size_t)row * 1024 + c);
              else { const int r = row - NCTX, t = r & 1023; v[j] = *(const g8::f32x4*)(P->in[1] + (size_t)r * 1024 + c);
                  v[j] += *(const g8::f32x4*)(c < 512 ? post + (t >> 6) * 512 + c : post + 16 * 512 + (t & 63) * 512 + (c - 512)); }
              s += (v[j][0] * v[j][0] + v[j][1] * v[j][1]) + (v[j][2] * v[j][2] + v[j][3] * v[j][3]); }
          const float rstd = 1.0f / sqrtf(wave_sum(s) * (1.f / 1024.f) + 1e-6f);
#pragma unroll
          for (int j = 0; j < 4; ++j) { const int c = 4 * F.lane + 256 * j; const g8::f32x4 g = *(const g8::f32x4*)(ng + c), sh = *(const g8::f32x4*)(mb + c), sc = *(const g8::f32x4*)(mb + 1024 + c);
              g8::u32x2 w; w.x = pkh(v[j][0] * rstd * g[0] * (1.f + sc[0]) + sh[0], v[j][1] * rstd * g[1] * (1.f + sc[1]) + sh[1]);
              w.y = pkh(v[j][2] * rstd * g[2] * (1.f + sc[2]) + sh[2], v[j][3] * rstd * g[3] * (1.f + sc[3]) + sh[3]);
              *(g8::u32x2*)(XA + (size_t)row * 1024 + c) = w; } } }
    filt_items(F, P, 0, F.G, false);
}
__device__ __forceinline__ void phase_final(Frame& F, KP P) {
    const float* ssq = (const float*)(P->ws + WS_SSQ) + 3 * T; const float* fg = P->in[7];
    const int gw = F.bid * 8 + F.wave, NGW = F.G * 8;
    for (int row = gw; row < T; row += NGW) { const float rstd = 1.0f / sqrtf(ssq[row] * (1.f / 1024.f) + 1e-6f); float* x = P->out + (size_t)row * 1024;
#pragma unroll
        for (int j = 0; j < 4; ++j) { const int c = 4 * F.lane + 256 * j; g8::f32x4 v = *(g8::f32x4*)(x + c); const g8::f32x4 g = *(const g8::f32x4*)(fg + c);
            v[0] *= rstd * g[0]; v[1] *= rstd * g[1]; v[2] *= rstd * g[2]; v[3] *= rstd * g[3]; *(g8::f32x4*)(x + c) = v; } }
}

#define LAUNDER(p) asm volatile("" : "+s"(p))
__global__ void __launch_bounds__(512, 2) mk_fwd(Params prm_unused) {
    extern __shared__ __attribute__((aligned(16))) unsigned char lds_raw[];
    KP kp = (KP)__builtin_amdgcn_kernarg_segment_ptr();
    Frame F; F.lds = (LAS unsigned char*)lds_raw; F.tid = threadIdx.x; F.lane = F.tid & 63; F.wave = __builtin_amdgcn_readfirstlane(F.tid >> 6); F.G = gridDim.x; F.bid = blockIdx.x;
    volatile LAS unsigned* MISC = (volatile LAS unsigned*)(F.lds + LDS_MISC);
    if (F.tid < 32) MISC[F.tid] = 0u;
    __syncthreads();
    XcdBarrier bar; bar.bar = (unsigned*)(kp->ws + CTL_BAR); bar.x = 0; bar.st = nullptr;
    if (MK_LAUNCHES == 1) bar = xcd_barrier_post((unsigned*)(kp->ws + CTL_BAR), MISC + 8);
    const int lo = kp->ph_lo, hi = kp->ph_hi;
#define IN(k) (lo <= (k) && (k) < hi)
#define SEAM(k) do { if (IN(k) && IN((k) + 1)) xcd_barrier(bar); } while (0)
#define WSP(T_, off) ((T_*)(ws + (off)))
    if (IN(0)) { LAUNDER(kp); phase0(F, kp); }
    SEAM(0);
    if (IN(1)) { LAUNDER(kp); phase1(F, kp); }
    SEAM(1);
    if (IN(2)) {
        LAUNDER(kp); unsigned char* ws = kp->ws;
        g8::Gemm g{ws + WS_WIN, ws + WS_XA, 1024, 2048u, 16u, 256, 128, 12, 48, 0}; g8::StaticOrder S; S.init(12, 48, F.G, F.bid);
        EpiZT E{WSP(f16h, WS_ZT), kp->in[13]}; g8::gemm_phase<EpiZT>(F.lds, g, S, E);
        filt_items(F, kp, 64, F.G - 64, true);
    }
    SEAM(2);
    if (IN(3)) { LAUNDER(kp); unsigned char* ws = kp->ws; cv::Args A{WSP(f16h, WS_ZT), WSP(const f16h, WS_FILT), kp->in[14], kp->in[15], kp->in[22], WSP(f16h, WS_V2)}; cv::conv_phase(F.lds, A, F.G, F.bid); }
    SEAM(3);
    if (IN(4)) {
        LAUNDER(kp); unsigned char* ws = kp->ws;
        g8::Gemm g{ws + WS_V2, ws + WS_WOUT, 1024, 16u, 16u * 12288u, 256, 128, 48, 4, 0}; g8::StaticOrder S; S.init(48, 4, F.G, F.bid);
        EpiRes2<true> E{ResOut{kp->out, WSP(f16h, WS_XA), kp->in[6], WSP(float, WS_SSQ), kp->in[0], kp->in[1], WSP(const float, WS_POST), 0, 0}, kp->in[24], WSP(const float, WS_MOD), 2048, 4096};
        g8::gemm_phase<EpiRes2<true>>(F.lds, g, S, E);
    }
    SEAM(4);
    if (IN(5)) { LAUNDER(kp); unsigned char* ws = kp->ws;
        g8::Gemm g{ws + WS_XA, ws + WS_W13, 1024, 2048u, 16u, 128, 2816, 48, 22, 0}; g8::StaticOrder S; S.init(48, 22, F.G, F.bid);
        EpiSwiglu2 E{WSP(f16h, WS_ZT), WSP(const float, WS_SSQ), WSP(const float, WS_BIAS2)}; g8::gemm_phase<EpiSwiglu2>(F.lds, g, S, E); }
    SEAM(5);
    if (IN(6)) { LAUNDER(kp); unsigned char* ws = kp->ws;
        g8::Gemm g{ws + WS_ZT, ws + WS_W2, 2816, 5632u, 16u, 256, 128, 48, 4, 0}; g8::StaticOrder S; S.init(48, 4, F.G, F.bid);
        EpiRes2<false> E{ResOut{kp->out, WSP(f16h, WS_XA), kp->in[5] + D, WSP(float, WS_SSQ) + T, nullptr, nullptr, nullptr, 1, 0}, nullptr, WSP(const float, WS_MOD), 5120, 6144 + 1024};
        g8::gemm_phase<EpiRes2<false>>(F.lds, g, S, E); }
    SEAM(6);
    if (IN(7)) { LAUNDER(kp); unsigned char* ws = kp->ws;
        s5::Args A{WSP(const f16h, WS_XA), WSP(const float, WS_SSQ) + T, WSP(const float, WS_MOD), WSP(const float, WS_S5PW), WSP(const f16h, WS_S5BB), kp->in[30], kp->in[31], kp->in[32], kp->in[2], WSP(float, WS_YB), WSP(f16h, WS_V2), kp->out + (size_t)T * D};
        s5::s5_phase(F.lds, A, F.G, F.bid); }
    SEAM(7);
    if (IN(8)) { LAUNDER(kp); unsigned char* ws = kp->ws;
        g8::Gemm g{ws + WS_V2, ws + WS_WGLU, 1024, 16u, 16u * 12288u, 128, 1024, 48, 8, 0}; g8::StaticOrder S; S.init(48, 8, F.G, F.bid);
        EpiGlu2 E{ResOut{kp->out, WSP(f16h, WS_XA), kp->in[6] + D, WSP(float, WS_SSQ) + 2 * T, nullptr, nullptr, nullptr, 0, 0}, kp->in[34], WSP(const float, WS_MOD), 6144 + 2048, 6144 + 4096};
        g8::gemm_phase<EpiGlu2>(F.lds, g, S, E); }
    SEAM(8);
    if (IN(9)) { LAUNDER(kp); unsigned char* ws = kp->ws;
        g8::Gemm g{ws + WS_XA, ws + WS_W13 + (size_t)5632 * 1024 * 2, 1024, 2048u, 16u, 128, 2816, 48, 22, 0}; g8::StaticOrder S; S.init(48, 22, F.G, F.bid);
        EpiSwiglu2 E{WSP(f16h, WS_ZT), WSP(const float, WS_SSQ) + 2 * T, WSP(const float, WS_BIAS2) + 9 * 5632}; g8::gemm_phase<EpiSwiglu2>(F.lds, g, S, E); }
    SEAM(9);
    if (IN(10)) { LAUNDER(kp); unsigned char* ws = kp->ws;
        g8::Gemm g{ws + WS_ZT, ws + WS_W2 + (size_t)1024 * 2816 * 2, 2816, 5632u, 16u, 256, 128, 48, 4, 0}; g8::StaticOrder S; S.init(48, 4, F.G, F.bid);
        EpiRes2<false> E{ResOut{kp->out, nullptr, nullptr, WSP(float, WS_SSQ) + 3 * T, nullptr, nullptr, nullptr, 0, 0}, nullptr, WSP(const float, WS_MOD), 6144 + 5120, 0};
        g8::gemm_phase<EpiRes2<false>>(F.lds, g, S, E); }
    SEAM(10);
    if (IN(11)) { LAUNDER(kp); phase_final(F, kp); }
#undef IN
#undef SEAM
#undef WSP
}

extern "C" void kernel_launch(void* const* d_in, const int* in_sizes, int n_in, void* d_out, int out_size, void* d_ws, size_t ws_size, hipStream_t stream) {
    static int grid = 0;
    if (grid == 0) {
        if (n_in != 35 || ws_size < WS_END) { fprintf(stderr, "kernel_launch: unexpected n_in %d / ws %zu\n", n_in, ws_size); grid = -1; return; }
        int dev = 0, cus = 0, per_cu = 0;
        if (hipGetDevice(&dev) != hipSuccess || hipDeviceGetAttribute(&cus, hipDeviceAttributeMultiprocessorCount, dev) != hipSuccess) { grid = -1; return; }
        if (hipFuncSetAttribute((const void*)mk_fwd, hipFuncAttributeMaxDynamicSharedMemorySize, LDS_BYTES) != hipSuccess) { fprintf(stderr, "kernel_launch: hipFuncSetAttribute failed\n"); grid = -1; return; }
        if (hipOccupancyMaxActiveBlocksPerMultiprocessor(&per_cu, (const void*)mk_fwd, 512, LDS_BYTES) != hipSuccess || per_cu < 1) { fprintf(stderr, "kernel_launch: occupancy query says %d\n", per_cu); per_cu = 1; }
        (void)hipGetLastError();
        grid = cus;
    }
    if (grid < 0) return;
    (void)hipMemsetAsync((char*)d_ws + WS_CTL, 0, CTL_ZERO_BYTES, stream);
    Params p; memset(&p, 0, sizeof(p));
    for (int i = 0; i < 35; ++i) p.in[i] = (const float*)d_in[i];
    p.out = (float*)d_out; p.ws = (unsigned char*)d_ws;
    if (MK_LAUNCHES == 1) { p.ph_lo = 0; p.ph_hi = NPH; hipLaunchKernelGGL(mk_fwd, dim3(grid), dim3(512), LDS_BYTES, stream, p); }
    else for (int k = 0; k < NPH; ++k) { p.ph_lo = k; p.ph_hi = k + 1; hipLaunchKernelGGL(mk_fwd, dim3(grid), dim3(512), LDS_BYTES, stream, p); }
}
```

```cpp
#include <hip/hip_runtime.h>
#include <math.h>
#include <string.h>
#include <stdio.h>

#ifndef MK_DUP
#define MK_DUP 0
#endif
#ifndef MK_LAUNCHES
#define MK_LAUNCHES 1
#endif
constexpr int D = 1024, NCTX = 4096, NLAT = 8192, T = 12288, F = 2816, NPH = 12;
constexpr size_t MiB = 1u << 20;
typedef _Float16 f16h;
constexpr size_t WS_CTL = 0, CTL_ZERO_BYTES = 2 * MiB;
constexpr size_t CTL_BAR = 16384;
constexpr size_t WS_MOD = 65536;
constexpr size_t WS_SSQ = 524288;
constexpr size_t WS_NORM = 720896;
constexpr size_t WS_BIAS2 = 786432;
constexpr size_t WS_H2 = 2 * MiB;
constexpr size_t WS_POST = 2 * MiB + 512 * 1024;
constexpr size_t WS_S5PW = 2 * MiB + 768 * 1024;
constexpr size_t WS_S5BB = 3 * MiB;
constexpr size_t WS_FILT = 4 * MiB;
constexpr size_t WS_WIN = 24 * MiB, WS_WOUT = 30 * MiB, WS_W13 = 32 * MiB  , WS_W2 = 54 * MiB  , WS_WGLU = 65 * MiB;
constexpr size_t WS_XA = 70 * MiB;
constexpr size_t WS_V2 = 94 * MiB;
constexpr size_t WS_ZT = 118 * MiB;
constexpr size_t WS_YB = 190 * MiB;
constexpr size_t WS_END = 238 * MiB;
constexpr int LDS_BYTES = 135168;
constexpr int LDS_MISC = 133120;

__device__ __forceinline__ int row_ci(int row) { return row < NCTX ? 0 : 1 + ((row - NCTX) >> 10); }
__device__ __forceinline__ float siluf(float v) { return v / (1.f + __expf(-v)); }
__device__ __forceinline__ float sigmf(float v) { return 1.f / (1.f + __expf(-v)); }
__device__ __forceinline__ unsigned pkh(float a, float b) { typedef _Float16 h2 __attribute__((ext_vector_type(2))); h2 v; v.x = (_Float16)a; v.y = (_Float16)b; return __builtin_bit_cast(unsigned, v); }

__device__ __forceinline__ void atomic_add_done(float* p, float v) { const float old = atomicAdd(p, v); asm volatile("" :: "v"(old)); }
struct Params { const float* in[35]; float* out; unsigned char* ws; int ph_lo, ph_hi; };
namespace g8 {
#define G8_LAS __attribute__((address_space(3)))
typedef _Float16 h8 __attribute__((ext_vector_type(8)));
typedef float f32x4 __attribute__((ext_vector_type(4)));
typedef unsigned u32x4 __attribute__((ext_vector_type(4)));
typedef unsigned u32x2 __attribute__((ext_vector_type(2)));
constexpr int BM = 256, BK = 64, HALF = 128, HTB = HALF * BK * 2, STAGE_BYTES = 8 * HTB, NXCD = 8, WGM = 8;
__host__ __device__ __forceinline__ int lds_byte(int r, int c) { const int st = (r >> 4) * 2 + (c >> 5), rr = r & 15, cc = c & 31, ob = rr * 64 + cc * 2; return st * 1024 + (ob ^ (((ob >> 9) & 1) << 5)); }
__host__ __device__ __forceinline__ void stage_rc(int b, int& R, int& C) { const int st = b / 1024, sb = b % 1024, swz = sb ^ (((sb >> 9) & 1) << 5); R = (st >> 1) * 16 + swz / 64; C = (st & 1) * 32 + (swz % 64) / 2; }
struct Unit { int pm, pn; };
struct Gemm { const void* A; const void* Bt; int K; unsigned a_row, a_k8; int b_tile_rows, b_half_rows; int nM, nN; int pad; };
struct StaticOrder {
    int nM, nN, nwg, G, c;
    __device__ void init(int nM_, int nN_, int G_, int c_) { nM = nM_; nN = nN_; nwg = nM * nN; G = G_; c = c_; }
    __device__ bool next(int i, Unit& u) const {
        const long L = (long)i * G + c; if (L >= nwg) return false;
        int wgid = (int)L; { const int q = nwg / NXCD, r = nwg % NXCD, xcd = wgid % NXCD, off = wgid / NXCD; wgid = (xcd < r ? xcd * (q + 1) : r * (q + 1) + (xcd - r) * q) + off; }
        const int nig = WGM * nN, gid = wgid / nig, fm = gid * WGM, gsz = (nM - fm) < WGM ? (nM - fm) : WGM;
        u.pm = fm + ((wgid % nig) % gsz); u.pn = (wgid % nig) / gsz; return true;
    }
};
template <class Epi>
__device__ __forceinline__ void gemm_phase(G8_LAS unsigned char* lds, const Gemm g, const StaticOrder& S, const Epi& E) {
    const int tid = threadIdx.x, wid = __builtin_amdgcn_readfirstlane(tid >> 6), lane = tid & 63, wr = wid >> 2, wc = wid & 3, fr = lane & 15, fq = lane >> 4;
    const int K = g.K, nt = K / BK;
    unsigned voffA[2], voffB[2];
#pragma unroll
    for (int i = 0; i < 2; ++i) { int R, C; stage_rc(tid * 16 + i * 8192, R, C);
        voffA[i] = (unsigned)R * g.a_row + (unsigned)(C >> 3) * g.a_k8; voffB[i] = (unsigned)(R * K + C) * 2u; }
    const size_t kstepA = (size_t)8 * g.a_k8, kstepB = (size_t)(BK * 2);
    const size_t hstepA = (size_t)HALF * g.a_row, tstepA = 2 * hstepA;
    const size_t hstepB = (size_t)g.b_half_rows * K * 2, tstepB = (size_t)g.b_tile_rows * K * 2;
    const unsigned ldsw = (unsigned)wid * 1024u;
    const int aoff = lds_byte(wr * 64 + fr, fq * 8), boff = lds_byte(wc * 32 + fr, fq * 8);
#define G8_SA(b, h) (((b) * 2 + (h)) * HTB)
#define G8_SB(b, h) ((4 + (b) * 2 + (h)) * HTB)
#define G8_STAGE(bufoff, gbase, voff) do { _Pragma("unroll") for (int _i = 0; _i < 2; ++_i) \
        __builtin_amdgcn_global_load_lds((const unsigned*)((const char*)(gbase) + (voff)[_i]), (G8_LAS unsigned*)(lds + (bufoff) + ldsw + _i * 8192), 16, 0, 0); } while (0)
#define G8_LDA(dst, b, h) do { _Pragma("unroll") for (int m = 0; m < 4; ++m) _Pragma("unroll") for (int k = 0; k < 2; ++k) dst[m][k] = *(const G8_LAS h8*)(lds + G8_SA(b, h) + aoff + m * 2048 + k * 1024); } while (0)
#define G8_LDB(dst, b, h) do { _Pragma("unroll") for (int n = 0; n < 2; ++n) _Pragma("unroll") for (int k = 0; k < 2; ++k) dst[n][k] = *(const G8_LAS h8*)(lds + G8_SB(b, h) + boff + n * 2048 + k * 1024); } while (0)
#define G8_MMA(ai, bj, At, Bt) do { __builtin_amdgcn_s_setprio(1); _Pragma("unroll") for (int m = 0; m < 4; ++m) _Pragma("unroll") for (int n = 0; n < 2; ++n) _Pragma("unroll") for (int k = 0; k < 2; ++k) \
        acc[ai][bj][m][n] = __builtin_amdgcn_mfma_f32_16x16x32_f16(Bt[n][k], At[m][k], acc[ai][bj][m][n], 0, 0, 0); __builtin_amdgcn_s_setprio(0); } while (0)
#define G8_WAIT_V(n) asm volatile("s_waitcnt vmcnt(" #n ")" ::: "memory")
#define G8_WAIT_L(n) asm volatile("s_waitcnt lgkmcnt(" #n ")" ::: "memory")
#define G8_BAR __builtin_amdgcn_s_barrier()
#define G8_SCHED __builtin_amdgcn_sched_barrier(0)
    Unit cur, nxt; int ui = 0;
    if (!S.next(0, cur)) return;
    f32x4 acc[2][2][4][2];
#pragma unroll
    for (int a = 0; a < 2; ++a)
#pragma unroll
        for (int b = 0; b < 2; ++b)
#pragma unroll
            for (int m = 0; m < 4; ++m)
#pragma unroll
                for (int n = 0; n < 2; ++n) acc[a][b][m][n] = (f32x4){0.f, 0.f, 0.f, 0.f};
    h8 At[4][2], B0[2][2], B1[2][2];
    const char* cA = (const char*)g.A + (size_t)cur.pm * tstepA; const char* cB = (const char*)g.Bt + (size_t)cur.pn * tstepB;
    G8_STAGE(G8_SB(0, 0), cB, voffB); G8_STAGE(G8_SA(0, 0), cA, voffA); G8_STAGE(G8_SB(0, 1), cB + hstepB, voffB); G8_STAGE(G8_SA(0, 1), cA + hstepA, voffA);
    if (wr == 1) G8_BAR;
    G8_WAIT_V(4); G8_BAR;
    G8_STAGE(G8_SB(1, 0), cB + kstepB, voffB); G8_STAGE(G8_SA(1, 0), cA + kstepA, voffA); G8_STAGE(G8_SB(1, 1), cB + hstepB + kstepB, voffB);
    G8_WAIT_V(6); G8_BAR;
    for (;;) {
        const bool has_next = S.next(ui + 1, nxt);
        const char* nA = has_next ? (const char*)g.A + (size_t)nxt.pm * tstepA : cA; const char* nB = has_next ? (const char*)g.Bt + (size_t)nxt.pn * tstepB : cB;
        for (int t = 0; t < nt; t += 2) {
            const bool last = (t == nt - 2);
            const char* a1 = cA + (size_t)(t + 1) * kstepA;
            const char* a2 = last ? nA : cA + (size_t)(t + 2) * kstepA; const char* b2 = last ? nB : cB + (size_t)(t + 2) * kstepB;
            const char* a3 = a2 + kstepA; const char* b3 = b2 + kstepB;
            G8_LDB(B0, 0, 0); G8_SCHED; G8_LDA(At, 0, 0); G8_STAGE(G8_SA(1, 1), a1 + hstepA, voffA);
            G8_WAIT_L(8); G8_BAR; G8_WAIT_L(0); G8_MMA(0, 0, At, B0); G8_BAR; G8_SCHED;
            G8_LDB(B1, 0, 1); G8_STAGE(G8_SB(0, 0), b2, voffB);
            G8_BAR; G8_WAIT_L(0); G8_MMA(0, 1, At, B1); G8_BAR;
            G8_LDA(At, 0, 1); G8_STAGE(G8_SA(0, 0), a2, voffA);
            G8_BAR; G8_WAIT_L(0); G8_MMA(1, 0, At, B0); G8_BAR; G8_SCHED;
            G8_STAGE(G8_SB(0, 1), b2 + hstepB, voffB);
            G8_WAIT_V(6); G8_BAR; G8_MMA(1, 1, At, B1); G8_BAR;
            G8_LDB(B0, 1, 0); G8_SCHED; G8_LDA(At, 1, 0); G8_STAGE(G8_SA(0, 1), a2 + hstepA, voffA);
            G8_WAIT_L(8); G8_BAR; G8_WAIT_L(0); G8_MMA(0, 0, At, B0); G8_BAR; G8_SCHED;
            G8_LDB(B1, 1, 1); G8_STAGE(G8_SB(1, 0), b3, voffB);
            G8_BAR; G8_WAIT_L(0); G8_MMA(0, 1, At, B1); G8_BAR;
            G8_LDA(At, 1, 1); G8_STAGE(G8_SA(1, 0), a3, voffA);
            G8_BAR; G8_WAIT_L(0); G8_MMA(1, 0, At, B0); G8_BAR; G8_SCHED;
            G8_STAGE(G8_SB(1, 1), b3 + hstepB, voffB);
            G8_WAIT_V(6); G8_BAR; G8_MMA(1, 1, At, B1); G8_BAR;
        }
        E(acc, cur, wr, wc, fr, fq);
        if (!has_next) break;
#pragma unroll
        for (int a = 0; a < 2; ++a)
#pragma unroll
            for (int b = 0; b < 2; ++b)
#pragma unroll
                for (int m = 0; m < 4; ++m)
#pragma unroll
                    for (int n = 0; n < 2; ++n) acc[a][b][m][n] = (f32x4){0.f, 0.f, 0.f, 0.f};
        cur = nxt; cA = nA; cB = nB; ++ui;
    }
    G8_WAIT_V(0);
    if (wr == 0) G8_BAR;
    G8_BAR;
#undef G8_SA
#undef G8_SB
#undef G8_STAGE
#undef G8_LDA
#undef G8_LDB
#undef G8_MMA
#undef G8_WAIT_V
#undef G8_WAIT_L
#undef G8_BAR
#undef G8_SCHED
}
}
namespace cv {
#define CV_LAS __attribute__((address_space(3)))
typedef _Float16 h8 __attribute__((ext_vector_type(8)));
typedef _Float16 h4 __attribute__((ext_vector_type(4)));
typedef float f32x16 __attribute__((ext_vector_type(16)));
typedef unsigned u4 __attribute__((ext_vector_type(4)));
typedef unsigned u2 __attribute__((ext_vector_type(2)));
constexpr int WAVE_LDS = 16640, V_OFF = 0, FA_OFF = 8320, FB_OFF = 12480;
constexpr float FSCALE = 64.f;
struct Args { const _Float16* zT; const _Float16* FILT; const float* conv_w; const float* conv_b; const float* fbias; _Float16* V2; };
__host__ __device__ __forceinline__ size_t filt_off(int lv, int o, int ch) { return lv ? (size_t)2 * 1024 * 512 + (size_t)(o * 1024 + ch) * 2048 : (size_t)(o * 1024 + ch) * 512; }
template <int LV> __device__ __forceinline__ void conv_unit(CV_LAS unsigned char* lds, const Args& P, int c, int bh) {
    constexpr int L = LV ? 1024 : 256, NBu = LV ? 4 : 8, T1 = L / 32, T1L = LV ? 8 : 4, NCT = T1 / T1L, PV = L * 2 + 16;
    const int tid = threadIdx.x, w = __builtin_amdgcn_readfirstlane(tid >> 6), lane = tid & 63;
    const int ch = 8 * c + w;
    const int row_base = LV ? 4096 + (4 * bh) * 1024 : (8 * bh) * 256;
    CV_LAS unsigned char* wl = lds + w * WAVE_LDS;
    {
        const _Float16* zrow = P.zT + (size_t)ch * 12288 + row_base;
        const float w0 = P.conv_w[ch], w1 = P.conv_w[3072 + ch], w2 = P.conv_w[6144 + ch], cb = P.conv_b[ch];
        for (int piece = lane; piece < NBu * L / 8; piece += 64) {
            const int bl = piece / (L / 8), t0 = (piece % (L / 8)) * 8;
            const h8 raw = *(const h8*)(zrow + bl * L + t0);
            float z[10];
            z[0] = t0 > 0 ? (float)zrow[bl * L + t0 - 1] : 0.f; z[9] = t0 + 8 < L ? (float)zrow[bl * L + t0 + 8] : 0.f;
#pragma unroll
            for (int i = 0; i < 8; ++i) z[i + 1] = (float)raw[i];
            h8 o;
#pragma unroll
            for (int i = 0; i < 8; ++i) o[i] = (_Float16)(w0 * z[i] + w1 * z[i + 1] + w2 * z[i + 2] + cb);
            *(CV_LAS h8*)(wl + V_OFF + bl * PV + t0 * 2) = o;
        }
    }
    const int t2 = lane & 31, hi = lane >> 5, col = lane & 31, bl = col / T1L, t1l = col % T1L;
    const int abase = (t2 & 1) ? FA_OFF + 2 * ((L - 1) - t2 + 8 * hi) : FB_OFF + 2 * ((L - 1) - t2 + 8 * hi - 1);
    const int vbase = V_OFF + bl * PV + 16 * hi;
#pragma unroll 1
    for (int o = 0; o < 2; ++o) {
        {
            const u4* Fg = (const u4*)(P.FILT + filt_off(LV, o, ch));
            for (int piece = lane; piece < 2 * L / 8; piece += 64) {
                const u4 a = Fg[piece]; const unsigned e0 = piece + 1 < 2 * L / 8 ? ((const unsigned*)(Fg + piece + 1))[0] : 0u;
                u4 b; b.x = (a.x >> 16) | (a.y << 16); b.y = (a.y >> 16) | (a.z << 16); b.z = (a.z >> 16) | (a.w << 16); b.w = (a.w >> 16) | (e0 << 16);
                *(CV_LAS u4*)(wl + FA_OFF + piece * 16) = a;
                *(CV_LAS u4*)(wl + FB_OFF + piece * 16) = b;
            }
        }
        f32x16 acc[NCT];
#pragma unroll
        for (int ct = 0; ct < NCT; ++ct)
#pragma unroll
            for (int r = 0; r < 16; ++r) acc[ct][r] = 0.f;
#pragma unroll 1
        for (int d = -(T1 - 1); d <= T1 - 1; ++d) {
            const CV_LAS unsigned* ap = (const CV_LAS unsigned*)(wl + abase - 64 * d);
            u4 a0, a1;
            a0.x = ap[0]; a0.y = ap[1]; a0.z = ap[2]; a0.w = ap[3];
            a1.x = ap[8]; a1.y = ap[9]; a1.z = ap[10]; a1.w = ap[11];
            const h8 A0 = __builtin_bit_cast(h8, a0), A1 = __builtin_bit_cast(h8, a1);
#pragma unroll
            for (int ct = 0; ct < NCT; ++ct) {
                const int lo = ct * T1L - d;
                if (lo + T1L - 1 < 0 || lo > T1 - 1) continue;
                const int s1 = lo + t1l; const bool valid = (unsigned)s1 < (unsigned)T1; const int s1c = valid ? s1 : 0;
                h8 b0 = *(const CV_LAS h8*)(wl + vbase + s1c * 64), b1 = *(const CV_LAS h8*)(wl + vbase + s1c * 64 + 32);
                if (!valid) {
#pragma unroll
                    for (int i = 0; i < 8; ++i) { b0[i] = (_Float16)0.f; b1[i] = (_Float16)0.f; } }
                acc[ct] = __builtin_amdgcn_mfma_f32_32x32x16_f16(A0, b0, acc[ct], 0, 0, 0);
                acc[ct] = __builtin_amdgcn_mfma_f32_32x32x16_f16(A1, b1, acc[ct], 0, 0, 0);
            }
        }
        {
            const int gch = (o + 1) * 1024 + ch;
            const _Float16* xrow = P.zT + (size_t)gch * 12288 + row_base + bl * L;
            const float g0 = P.conv_w[gch], g1 = P.conv_w[3072 + gch], g2 = P.conv_w[6144 + gch], gcb = P.conv_b[gch], fbv = P.fbias[o * 1024 + ch];
#pragma unroll
            for (int ct = 0; ct < NCT; ++ct)
#pragma unroll
                for (int g = 0; g < 4; ++g) {
                    const int t = 32 * (ct * T1L + t1l) + 8 * g + 4 * hi;
                    const h4 zz = *(const h4*)(xrow + t);
                    float z[6]; z[0] = t > 0 ? (float)xrow[t - 1] : 0.f; z[5] = t + 4 < L ? (float)xrow[t + 4] : 0.f;
#pragma unroll
                    for (int i = 0; i < 4; ++i) z[i + 1] = (float)zz[i];
                    CV_LAS h4* vp = (CV_LAS h4*)(wl + V_OFF + bl * PV + t * 2);
                    const h4 vin = *vp; h4 vo;
#pragma unroll
                    for (int i = 0; i < 4; ++i) { const float gate = g0 * z[i] + g1 * z[i + 1] + g2 * z[i + 2] + gcb;
                        vo[i] = (_Float16)((acc[ct][4 * g + i] * (1.f / FSCALE) + (float)vin[i] * fbv) * gate); }
                    *vp = vo;
                }
        }
    }
    __syncthreads();
    for (int idx = tid; idx < NBu * L; idx += 512) {
        const int b2 = idx / L, t = idx % L; h8 o;
#pragma unroll
        for (int ww = 0; ww < 8; ++ww) o[ww] = *(const CV_LAS _Float16*)(lds + ww * WAVE_LDS + V_OFF + b2 * PV + t * 2);
        *(h8*)(P.V2 + ((size_t)c * 12288 + row_base + b2 * L + t) * 8) = o;
    }
    __syncthreads();
}
__device__ __forceinline__ void conv_phase(CV_LAS unsigned char* lds, const Args& P, int G, int bid) {
    for (int u = bid; u < 256; u += G) conv_unit<1>(lds, P, u >> 1, u & 1);
    for (int u = bid; u < 256; u += G) conv_unit<0>(lds, P, u >> 1, u & 1);
}
}
namespace s5 {
#define S5_LAS __attribute__((address_space(3)))
typedef _Float16 h8 __attribute__((ext_vector_type(8)));
typedef _Float16 h4 __attribute__((ext_vector_type(4)));
typedef _Float16 h2 __attribute__((ext_vector_type(2)));
typedef float f32x16 __attribute__((ext_vector_type(16)));
typedef float f32x4 __attribute__((ext_vector_type(4)));
constexpr int IMG_PITCH = 288, WAVE_LDS = 32 * IMG_PITCH;
constexpr int TT = 12288;
struct Args { const _Float16* UP; const float* ssq; const float* MOD; const float* PW; const _Float16* BB;
              const float* C_re; const float* C_im; const float* Dv; const float* state_in; float* YB; _Float16* Y2; float* new_state; };
__device__ __forceinline__ float gelu_fast(float x) { const float u = 1.5957691216057308f * (x + 0.044715f * x * x * x); return x / (1.f + __expf(-u)); }
__device__ __forceinline__ void s5_table(int ix, const float* A_re, const float* A_im, const float* log_dt, const float* B_re, const float* B_im, float* PW, _Float16* BB) {
    const double are = A_re[ix], aim = A_im[ix], dt = exp((double)log_dt[ix >> 6]);
    const double mag = exp(dt * are), ph = dt * aim, abr = mag * cos(ph), abi = mag * sin(ph);
    const double nr = abr - 1.0, ni = abi, den = are * are + aim * aim, cor = (nr * are + ni * aim) / den, coi = (ni * are - nr * aim) / den;
    double pr = abr, pi = abi;
    for (int k = 0; k < 4; ++k) { PW[(size_t)ix * 8 + 2 * k] = (float)pr; PW[(size_t)ix * 8 + 2 * k + 1] = (float)pi; const double tr = pr * abr - pi * abi; pi = pr * abi + pi * abr; pr = tr; }
    for (int h = 0; h < 16; ++h) { const double br = B_re[(size_t)ix * 16 + h], bi = B_im[(size_t)ix * 16 + h];
        BB[(size_t)ix * 32 + h] = (_Float16)(float)(cor * br - coi * bi); BB[(size_t)ix * 32 + 16 + h] = (_Float16)(float)(cor * bi + coi * br); }
}
__device__ __forceinline__ void s5_task(S5_LAS unsigned char* img, volatile S5_LAS int* myflag, volatile S5_LAS int* pflag, int epoch, const Args& P, int seq, int g, int dir) {
    const int lane = threadIdx.x & 63, n = lane & 31, hi = lane >> 5, tq = lane & 15, q4 = lane >> 4;
    const bool ctx = seq < 16;
    const int L = ctx ? 256 : 1024, base = ctx ? seq * 256 : 4096 + (seq - 16) * 1024, ci = ctx ? 0 : 1 + (seq - 16), NT = L / 32;
    const float* mod = P.MOD + (ci * 2 + 1) * 6144;
    float shA[8], shO[4], dvO[4];
#pragma unroll
    for (int j = 0; j < 8; ++j) shA[j] = mod[16 * g + 8 * hi + j];
#pragma unroll
    for (int j = 0; j < 4; ++j) { shO[j] = mod[16 * g + 4 * q4 + j]; dvO[j] = P.Dv[16 * g + 4 * q4 + j]; }
    const _Float16* up = P.UP + (size_t)g * TT * 16;
    float* yb = P.YB + (size_t)g * TT * 16;
    float pw[2][4][2]; h8 Bf[2][2]; float cr[2], cim[2];
#pragma unroll
    for (int half = 0; half < 2; ++half) {
        const int p = n + 32 * half, ix = (dir * 64 + g) * 64 + p;
        const f32x4 q0 = *(const f32x4*)(P.PW + (size_t)ix * 8), q1 = *(const f32x4*)(P.PW + (size_t)ix * 8 + 4);
        pw[half][0][0] = q0[0]; pw[half][0][1] = q0[1]; pw[half][1][0] = q0[2]; pw[half][1][1] = q0[3]; pw[half][2][0] = q1[0]; pw[half][2][1] = q1[1]; pw[half][3][0] = q1[2]; pw[half][3][1] = q1[3];
        Bf[half][0] = *(const h8*)(P.BB + (size_t)ix * 32 + 8 * hi); Bf[half][1] = *(const h8*)(P.BB + (size_t)ix * 32 + 16 + 8 * hi);
        if (ctx) { cr[half] = 0.f; cim[half] = 0.f; }
        else { const int b = seq - 16; cr[half] = P.state_in[((b * 2 + dir) * 2 + 0) * 4096 + g * 64 + p]; cim[half] = P.state_in[((b * 2 + dir) * 2 + 1) * 4096 + g * 64 + p]; }
    }
    h8 Cf[4];
#pragma unroll
    for (int kk = 0; kk < 4; ++kk)
#pragma unroll
        for (int j = 0; j < 8; ++j) { const int k = 32 * kk + 8 * q4 + j, p = k >> 1; const size_t cx = ((size_t)(dir * 64 + g) * 16 + tq) * 64 + p;
            Cf[kk][j] = (_Float16)((k & 1) ? -P.C_im[cx] : P.C_re[cx]); }
    int rowA = base + (dir ? L - 1 - n : n);
    h8 ur = *(const h8*)(up + (size_t)rowA * 16 + 8 * hi); float sqA = P.ssq[rowA];
#pragma unroll 1
    for (int jt = 0; jt < NT; ++jt) {
        const bool second = jt >= NT / 2;
        if (jt == NT / 2) {
            asm volatile("s_waitcnt vmcnt(0)" ::: "memory");
            if (lane == 0) *myflag = epoch;
            while (*pflag < epoch) __builtin_amdgcn_s_sleep(8);
            asm volatile("" ::: "memory");
        }
        int rowO[2];
#pragma unroll
        for (int nt = 0; nt < 2; ++nt) { const int s = 32 * jt + tq + 16 * nt; rowO[nt] = base + (dir ? L - 1 - s : s); }
        const float rsA = 1.0f / sqrtf(sqA * (1.f / 1024.f) + 1e-6f);
        h8 Au;
#pragma unroll
        for (int j = 0; j < 8; ++j) Au[j] = (_Float16)(rsA * (float)ur[j] + shA[j]);
        if (jt + 1 < NT) { const int s = 32 * (jt + 1) + n; rowA = base + (dir ? L - 1 - s : s); ur = *(const h8*)(up + (size_t)rowA * 16 + 8 * hi); sqA = P.ssq[rowA]; }
        const f32x16 zero = {0.f, 0.f, 0.f, 0.f, 0.f, 0.f, 0.f, 0.f, 0.f, 0.f, 0.f, 0.f, 0.f, 0.f, 0.f, 0.f};
#pragma unroll
        for (int half = 0; half < 2; ++half) {
            f32x16 xr = __builtin_amdgcn_mfma_f32_32x32x16_f16(Au, Bf[half][0], zero, 0, 0, 0);
            f32x16 xi = __builtin_amdgcn_mfma_f32_32x32x16_f16(Au, Bf[half][1], zero, 0, 0, 0);
            const float a1r = pw[half][0][0], a1i = pw[half][0][1], a4r = pw[half][3][0], a4i = pw[half][3][1];
#pragma unroll
            for (int q = 0; q < 4; ++q)
#pragma unroll
                for (int j = 1; j < 4; ++j) { const int r = 4 * q + j; const float pr = xr[r - 1], pi = xi[r - 1];
                    xr[r] = a1r * pr - a1i * pi + xr[r]; xi[r] = a1r * pi + a1i * pr + xi[r]; }
            float er[4], ei[4], per[4], pei[4];
#pragma unroll
            for (int q = 0; q < 4; ++q) { er[q] = xr[4 * q + 3]; ei[q] = xi[4 * q + 3]; per[q] = __shfl_xor(er[q], 32); pei[q] = __shfl_xor(ei[q], 32); }
            float sr = cr[half], si = cim[half], inr[4], ini[4];
#pragma unroll
            for (int i = 0; i < 8; ++i) { const int q = i >> 1; const bool own = ((i & 1) == hi);
                if ((i & 1) == 0) { inr[q] = sr; ini[q] = si; } else { inr[q] = hi ? sr : inr[q]; ini[q] = hi ? si : ini[q]; }
                const float evr = own ? er[q] : per[q], evi = own ? ei[q] : pei[q];
                const float tr = a4r * sr - a4i * si + evr; si = a4r * si + a4i * sr + evi; sr = tr; }
            cr[half] = sr; cim[half] = si;
#pragma unroll
            for (int q = 0; q < 4; ++q)
#pragma unroll
                for (int j = 0; j < 4; ++j) { const int r = 4 * q + j; const float hr = xr[r] + pw[half][j][0] * inr[q] - pw[half][j][1] * ini[q], hm = xi[r] + pw[half][j][0] * ini[q] + pw[half][j][1] * inr[q];
                    const int tau = (r & 3) + 8 * (r >> 2) + 4 * hi; h2 v; v.x = (_Float16)hr; v.y = (_Float16)hm;
                    *(S5_LAS h2*)(img + tau * IMG_PITCH + (n + 32 * half) * 4) = v; }
        }
        f32x4 ybv[2]; h4 u4[2]; float sqO[2];
        if (second) {
#pragma unroll
            for (int nt = 0; nt < 2; ++nt) { ybv[nt] = *(const f32x4*)(yb + (size_t)rowO[nt] * 16 + 4 * q4); u4[nt] = *(const h4*)(up + (size_t)rowO[nt] * 16 + 4 * q4); sqO[nt] = P.ssq[rowO[nt]]; }
        }
#pragma unroll
        for (int nt = 0; nt < 2; ++nt) {
            f32x4 acc = {0.f, 0.f, 0.f, 0.f};
#pragma unroll
            for (int kk = 0; kk < 4; ++kk) { const h8 hb = *(const S5_LAS h8*)(img + (tq + 16 * nt) * IMG_PITCH + (32 * kk + 8 * q4) * 2);
                acc = __builtin_amdgcn_mfma_f32_16x16x32_f16(Cf[kk], hb, acc, 0, 0, 0); }
            if (!second) *(f32x4*)(yb + (size_t)rowO[nt] * 16 + 4 * q4) = acc;
            else {
                const float rs = 1.0f / sqrtf(sqO[nt] * (1.f / 1024.f) + 1e-6f);
                h4 o;
#pragma unroll
                for (int j = 0; j < 4; ++j) { const float u = rs * (float)u4[nt][j] + shO[j]; o[j] = (_Float16)gelu_fast(u * dvO[j] + acc[j] + ybv[nt][j]); }
                *(h4*)(P.Y2 + ((size_t)(2 * g + (q4 >> 1)) * TT + rowO[nt]) * 8 + 4 * (q4 & 1)) = o;
            }
        }
    }
    if (ctx && hi == 0) {
#pragma unroll
        for (int half = 0; half < 2; ++half) { const int p = n + 32 * half;
            P.new_state[((seq * 2 + dir) * 2 + 0) * 4096 + g * 64 + p] = cr[half]; P.new_state[((seq * 2 + dir) * 2 + 1) * 4096 + g * 64 + p] = cim[half]; }
    }
}
__device__ __forceinline__ void s5_phase(S5_LAS unsigned char* lds, volatile S5_LAS int* flags, const Args& P, int G, int bid) {
    const int w = __builtin_amdgcn_readfirstlane(threadIdx.x >> 6), dir = w & 1;
    S5_LAS unsigned char* img = lds + w * WAVE_LDS;
    int epoch = 0;
    for (int b = bid; b < 256; b += G) {
        if (w < 4) { const int lu = 2 * b + (w >> 1); ++epoch; s5_task(img, flags + w, flags + (w ^ 1), epoch, P, 16 + (lu >> 6), lu & 63, dir); }
        else for (int r = 0; r < 2; ++r) { const int cu = 4 * b + 2 * r + ((w - 4) >> 1); ++epoch; s5_task(img, flags + w, flags + (w ^ 1), epoch, P, cu >> 6, cu & 63, dir); }
    }
}
}
#define LAS __attribute__((address_space(3)))
#define XB_TMO      128
#define XB_XCNT(j)  (256  + 64 * (j))
#define XB_XSUB(j)  (1280 + 64 * (j))
#define XB_XGEN(j)  (2304 + 64 * (j))
#define XB_TOP      3328
#define XB_TOPGEN   3392
#define XCD_BAR_WORDS 3456
#define XB_SPIN_CAP (1u << 18)
__device__ __forceinline__ unsigned xb_ld(unsigned* p)              { return __hip_atomic_load(p, __ATOMIC_RELAXED, __HIP_MEMORY_SCOPE_AGENT); }
__device__ __forceinline__ unsigned xb_add(unsigned* p, unsigned v) { return __hip_atomic_fetch_add(p, v, __ATOMIC_RELAXED, __HIP_MEMORY_SCOPE_AGENT); }
__device__ __forceinline__ unsigned xb_xcc_id() { return (unsigned)__builtin_amdgcn_s_getreg((3 << 11) | 20) & 0xFu; }
#define XB_SPIN(cond, bar) do { unsigned _sp = 0; while (cond) { __builtin_amdgcn_s_sleep(1); \
    if ((++_sp & 255u) == 0u) { if (xb_ld(&(bar)[XB_TMO])) break; if (_sp > XB_SPIN_CAP) { atomicAdd(&(bar)[XB_TMO], 1u); break; } } } } while (0)
struct XcdBarrier { unsigned* bar; unsigned x; volatile LAS unsigned* st; };
__device__ __forceinline__ XcdBarrier xcd_barrier_post(unsigned* bar, volatile LAS unsigned* st) {
    XcdBarrier b; b.bar = bar; b.x = xb_xcc_id(); b.st = st;
    if (threadIdx.x == 0) (void)xb_add(&bar[XB_XCNT(b.x)], 1u);
    return b;
}
__device__ __forceinline__ void xcd_barrier_complete(unsigned* bar, unsigned x, unsigned& nloc, unsigned& nx) {
    const unsigned G = gridDim.x * gridDim.y * gridDim.z;
    unsigned sum, cnt, mine, sp = 0u;
    for (;;) {
        sum = 0u; cnt = 0u; mine = 0u;
#pragma unroll
        for (unsigned j = 0; j < 16; ++j) { const unsigned c = xb_ld(&bar[XB_XCNT(j)]); sum += c; cnt += (c > 0u) ? 1u : 0u; mine = (j == x) ? c : mine; }
        if (sum == G) break;
        __builtin_amdgcn_s_sleep(1);
        if ((++sp & 255u) == 0u) { if (xb_ld(&bar[XB_TMO])) break; if (sp > XB_SPIN_CAP) { atomicAdd(&bar[XB_TMO], 1u); break; } }
    }
    nloc = mine > 0u ? mine : 1u; nx = cnt > 0u ? cnt : 1u;
}
__device__ __forceinline__ void xcd_barrier(const XcdBarrier& b) {
    asm volatile("s_waitcnt vmcnt(0)" ::: "memory");
    __syncthreads();
    if (threadIdx.x == 0) {
        unsigned* bar = b.bar;
        __builtin_amdgcn_s_waitcnt(0);
        unsigned nloc = b.st[0], nx = b.st[1];
        if (nloc == 0u) { xcd_barrier_complete(bar, b.x, nloc, nx); b.st[0] = nloc; b.st[1] = nx; }
        const unsigned old = xb_add(&bar[XB_XSUB(b.x)], 1u);
        const unsigned gen = old / nloc;
        if (old + 1u == (gen + 1u) * nloc) {
            __builtin_amdgcn_fence(__ATOMIC_RELEASE, "agent");
            asm volatile("s_waitcnt vmcnt(0)" ::: "memory");
            const unsigned og = xb_add(&bar[XB_TOP], 1u);
            const unsigned tg = og / nx;
            if (og + 1u == (tg + 1u) * nx) xb_add(&bar[XB_TOPGEN], 1u);
            else XB_SPIN(xb_ld(&bar[XB_TOPGEN]) == tg, bar);
            __builtin_amdgcn_fence(__ATOMIC_ACQUIRE, "agent");
            xb_add(&bar[XB_XGEN(b.x)], 1u);
            asm volatile("s_waitcnt vmcnt(0)" ::: "memory");
        } else {
            XB_SPIN(xb_ld(&bar[XB_XGEN(b.x)]) == gen, bar);
            __builtin_amdgcn_fence(__ATOMIC_ACQUIRE, "agent");
            asm volatile("s_waitcnt vmcnt(0)" ::: "memory");
        }
    }
    __syncthreads();
}

struct EpiZT { f16h* zT; const float* bias;
    __device__ __forceinline__ void operator()(const g8::f32x4 (&acc)[2][2][4][2], const g8::Unit& u, int wr, int wc, int fr, int fq) const {
        const int row0 = u.pm * 256 + wr * 64 + fr, col0 = u.pn * 256 + wc * 32 + 4 * fq;
#pragma unroll
        for (int ai = 0; ai < 2; ++ai)
#pragma unroll
            for (int m = 0; m < 4; ++m) { const int row = row0 + ai * 128 + m * 16; const float bv = bias[row];
#pragma unroll
                for (int bj = 0; bj < 2; ++bj)
#pragma unroll
                    for (int n = 0; n < 2; ++n) { const g8::f32x4 a = acc[ai][bj][m][n]; g8::u32x2 w; w.x = pkh(a[0] + bv, a[1] + bv); w.y = pkh(a[2] + bv, a[3] + bv);
                        *(g8::u32x2*)(zT + (size_t)row * 12288 + col0 + bj * 128 + n * 16) = w; } }
    } };
struct ResOut { float* X; const float* Xr; f16h* XA; const float* ng; float* ssq; const float* xp; const float* xs; const float* post; int xa_mode; int pad; };
template <bool XIN> __device__ __forceinline__ void res_store(const ResOut& R, const float* gate, const float* sc, int row, int c, g8::f32x4 val, float& sq) {
    float* p = R.X + (size_t)row * 1024 + c; g8::f32x4 x;
    if (XIN) {
        if (row < NCTX) x = *(const g8::f32x4*)(R.xp + (size_t)row * 1024 + c);
        else { const int r = row - NCTX, t = r & 1023; x = *(const g8::f32x4*)(R.xs + (size_t)r * 1024 + c);
            x += *(const g8::f32x4*)(c < 512 ? R.post + (t >> 6) * 512 + c : R.post + 16 * 512 + (t & 63) * 512 + (c - 512)); }
    } else x = *(const g8::f32x4*)(R.Xr + (size_t)row * 1024 + c);
    x += *(const g8::f32x4*)(gate + c) * val; *(g8::f32x4*)p = x;
    sq += (x[0] * x[0] + x[1] * x[1]) + (x[2] * x[2] + x[3] * x[3]);
    if (R.XA) { const g8::f32x4 ng = *(const g8::f32x4*)(R.ng + c), s = *(const g8::f32x4*)(sc + c); g8::u32x2 w;
        w.x = pkh(x[0] * ng[0] * (1.f + s[0]), x[1] * ng[1] * (1.f + s[1])); w.y = pkh(x[2] * ng[2] * (1.f + s[2]), x[3] * ng[3] * (1.f + s[3]));
        f16h* q = R.xa_mode == 0 ? R.XA + (size_t)row * 1024 + c : R.XA + ((size_t)(c >> 4) * T + row) * 16 + (c & 15);
        *(g8::u32x2*)q = w; }
}
template <bool XIN> struct EpiRes2 { ResOut R; const float* bias; const float* MOD; int gateoff, scoff;
    __device__ __forceinline__ void operator()(const g8::f32x4 (&acc)[2][2][4][2], const g8::Unit& u, int wr, int wc, int fr, int fq) const {
        const int row0 = u.pm * 256 + wr * 64 + fr, col0 = u.pn * 256 + wc * 32 + 4 * fq;
        const float* mb = MOD + (row_ci(u.pm * 256) * 2) * 6144; const float* gate = mb + gateoff; const float* sc = mb + scoff;
        float olds[8] = {0.f, 0.f, 0.f, 0.f, 0.f, 0.f, 0.f, 0.f};
#pragma unroll
        for (int ai = 0; ai < 2; ++ai)
#pragma unroll
            for (int m = 0; m < 4; ++m) { const int row = row0 + ai * 128 + m * 16; float sq = 0.f;
#pragma unroll
                for (int bj = 0; bj < 2; ++bj)
#pragma unroll
                    for (int n = 0; n < 2; ++n) { const int c = col0 + bj * 128 + n * 16; g8::f32x4 v = acc[ai][bj][m][n]; if (bias) v += *(const g8::f32x4*)(bias + c); res_store<XIN>(R, gate, sc, row, c, v, sq); }
                if (R.ssq) { sq += __shfl_xor(sq, 16); sq += __shfl_xor(sq, 32); if (fq == 0) olds[ai * 4 + m] = atomicAdd(R.ssq + row, sq); } }
        asm volatile("" :: "v"(olds[0]), "v"(olds[1]), "v"(olds[2]), "v"(olds[3]), "v"(olds[4]), "v"(olds[5]), "v"(olds[6]), "v"(olds[7]));
    } };
struct EpiGlu2 { ResOut R; const float* bias; const float* MOD; int gateoff, scoff;
    __device__ __forceinline__ void operator()(const g8::f32x4 (&acc)[2][2][4][2], const g8::Unit& u, int wr, int wc, int fr, int fq) const {
        const int row0 = u.pm * 256 + wr * 64 + fr, col0 = u.pn * 128 + wc * 32 + 4 * fq;
        const float* mb = MOD + (row_ci(u.pm * 256) * 2) * 6144; const float* gate = mb + gateoff; const float* sc = mb + scoff;
        float olds[8] = {0.f, 0.f, 0.f, 0.f, 0.f, 0.f, 0.f, 0.f};
#pragma unroll
        for (int ai = 0; ai < 2; ++ai)
#pragma unroll
            for (int m = 0; m < 4; ++m) { const int row = row0 + ai * 128 + m * 16; float sq = 0.f;
#pragma unroll
                for (int n = 0; n < 2; ++n) { const int c = col0 + n * 16; const g8::f32x4 a = acc[ai][0][m][n] + *(const g8::f32x4*)(bias + c), g = acc[ai][1][m][n] + *(const g8::f32x4*)(bias + 1024 + c);
                    g8::f32x4 v;
#pragma unroll
                    for (int j = 0; j < 4; ++j) v[j] = a[j] * sigmf(g[j]);
                    res_store<false>(R, gate, sc, row, c, v, sq); }
                if (R.ssq) { sq += __shfl_xor(sq, 16); sq += __shfl_xor(sq, 32); if (fq == 0) olds[ai * 4 + m] = atomicAdd(R.ssq + row, sq); } }
        asm volatile("" :: "v"(olds[0]), "v"(olds[1]), "v"(olds[2]), "v"(olds[3]), "v"(olds[4]), "v"(olds[5]), "v"(olds[6]), "v"(olds[7]));
    } };
struct EpiSwiglu2 { f16h* hid; const float* ssq; const float* bias2;
    __device__ __forceinline__ void operator()(const g8::f32x4 (&acc)[2][2][4][2], const g8::Unit& u, int wr, int wc, int fr, int fq) const {
        const int row0 = u.pm * 256 + wr * 64 + fr, col0 = u.pn * 128 + wc * 32 + 4 * fq;
        const float* b2 = bias2 + row_ci(u.pm * 256) * 5632;
#pragma unroll
        for (int n = 0; n < 2; ++n) { const g8::f32x4 ba = *(const g8::f32x4*)(b2 + col0 + n * 16), bb = *(const g8::f32x4*)(b2 + 2816 + col0 + n * 16);
#pragma unroll
            for (int ai = 0; ai < 2; ++ai)
#pragma unroll
                for (int m = 0; m < 4; ++m) { const int row = row0 + ai * 128 + m * 16; const float rstd = 1.0f / sqrtf(ssq[row] * (1.f / 1024.f) + 1e-6f);
                    const g8::f32x4 a = acc[ai][0][m][n] * rstd + ba, b = acc[ai][1][m][n] * rstd + bb; g8::u32x2 w;
                    w.x = pkh(siluf(a[0]) * b[0], siluf(a[1]) * b[1]); w.y = pkh(siluf(a[2]) * b[2], siluf(a[3]) * b[3]);
                    *(g8::u32x2*)(hid + (size_t)row * 2816 + col0 + n * 16) = w; } }
    } };

typedef const __attribute__((address_space(4))) Params* KP;
struct Frame { LAS unsigned char* lds; int tid, lane, wave, G, bid; };
__device__ __forceinline__ float wave_sum(float v) {
#pragma unroll
    for (int o = 1; o < 64; o <<= 1) v += __shfl_xor(v, o);
    return v;
}
__device__ __forceinline__ void transpose_item(const float* W, int K, int N, f16h* WT, LAS float* scr, int item, int lane) {
    const int nblk = N / 32, kb = item / nblk, nb = item % nblk, k0 = 64 * kb, n0 = 32 * nb;
#pragma unroll 8
    for (int i = 0; i < 32; ++i) { const int kk = 2 * i + (lane >> 5); scr[kk * 33 + (lane & 31)] = W[(size_t)(k0 + kk) * N + n0 + (lane & 31)]; }
    asm volatile("s_waitcnt lgkmcnt(0)" ::: "memory");
    const int c = lane & 7;
#pragma unroll
    for (int j = 0; j < 4; ++j) { const int n = (lane >> 3) + 8 * j; const LAS float* s = scr + (8 * c) * 33 + n;
        g8::u32x4 o; o.x = pkh(s[0 * 33], s[1 * 33]); o.y = pkh(s[2 * 33], s[3 * 33]); o.z = pkh(s[4 * 33], s[5 * 33]); o.w = pkh(s[6 * 33], s[7 * 33]);
        *(g8::u32x4*)(WT + (size_t)(n0 + n) * K + k0 + 8 * c) = o; }
    asm volatile("s_waitcnt lgkmcnt(0)" ::: "memory");
}
__device__ __forceinline__ void gemv9_item(const float* W, int ldw, int col0, int kq, const LAS float* tab, float* out, int ostride, const float* bias, int lane) {
    const int col = col0 + lane; float acc[9];
#pragma unroll
    for (int ci = 0; ci < 9; ++ci) acc[ci] = 0.f;
    const float* w = W + (size_t)(kq * 256) * ldw + col;
#pragma unroll 2
    for (int k4 = 0; k4 < 64; ++k4) {
        const float w0 = w[(size_t)(4 * k4) * ldw], w1 = w[(size_t)(4 * k4 + 1) * ldw], w2 = w[(size_t)(4 * k4 + 2) * ldw], w3 = w[(size_t)(4 * k4 + 3) * ldw];
#pragma unroll
        for (int ci = 0; ci < 9; ++ci) { const g8::f32x4 s = *(const LAS g8::f32x4*)(tab + ci * 1024 + kq * 256 + 4 * k4); acc[ci] += s[0] * w0 + s[1] * w1 + s[2] * w2 + s[3] * w3; }
    }
    float olds[9];
#pragma unroll
    for (int ci = 0; ci < 9; ++ci) olds[ci] = atomicAdd(out + (size_t)ci * ostride + col, acc[ci] + ((bias && kq == 0) ? bias[col] : 0.f));
    asm volatile("" :: "v"(olds[0]), "v"(olds[1]), "v"(olds[2]), "v"(olds[3]), "v"(olds[4]), "v"(olds[5]), "v"(olds[6]), "v"(olds[7]), "v"(olds[8]));
}
__device__ __forceinline__ void filt_item(const float* H2, const float* w3, float* NORM, f16h* FILT, int lv, int o, int mr, int d0, int lane, bool pass2, LAS float* hs) {
    const int L = lv ? 1024 : 256, d = d0 + lane, m0 = 32 * mr, dir = m0 >= L ? 1 : 0;
    const int extra = (!pass2 && m0 == L) ? 1 : 0;
    const int ilo = dir ? (m0 - (L - 1)) - extra : (L - 32 - m0);
    const float* h2 = H2 + (lv ? 256 : 0) * 64;
    for (int r = 0; r < 32 + extra; ++r) { const int i = ilo + r; hs[r * 64 + lane] = i < L ? h2[i * 64 + lane] : 0.f; }
    float w[64];
#pragma unroll
    for (int m = 0; m < 64; ++m) w[m] = w3[m * 4096 + o * 2048 + dir * 1024 + d];
    const double maxd = log(1e-2) / 0.3, mind = log(1e-2) / 1.5;
    const float delta = fabsf((float)(mind + (double)d * (maxd - mind) / 1023.0));
    const float tstep = (float)(1.0 / (double)(L - 1));
    float inv = 0.f; if (pass2) inv = cv::FSCALE / (NORM[(lv * 2 + o) * 1024 + d] + 1e-6f);
    float sabs = 0.f; f16h taps[32];
    asm volatile("s_waitcnt lgkmcnt(0)" ::: "memory");
#pragma unroll 1
    for (int mm = -extra; mm < 32; ++mm) {
        const int m = m0 + mm, j = (L - 1) - m, i = j < 0 ? -j : j;
        const LAS g8::f32x4* hr = (const LAS g8::f32x4*)(hs + (i - ilo) * 64);
        float a = 0.f;
#pragma unroll
        for (int q = 0; q < 16; ++q) { const g8::f32x4 h = hr[q]; a += h[0] * w[4 * q] + h[1] * w[4 * q + 1] + h[2] * w[4 * q + 2] + h[3] * w[4 * q + 3]; }
        a = i < L ? a * __expf(-(float)i * tstep * delta) : 0.f;
        sabs += fabsf(a);
        if (mm >= 0) {
#pragma unroll
            for (int q = 0; q < 32; ++q) if (q == mm) taps[q] = (f16h)(a * inv);
        }
    }
    if (!pass2) atomic_add_done(&NORM[(lv * 2 + o) * 1024 + d], sabs);
    else {
        f16h* dst = FILT + (lv ? (size_t)2 * 1024 * 512 + (size_t)(o * 1024 + d) * 2048 : (size_t)(o * 1024 + d) * 512) + m0;
#pragma unroll
        for (int q = 0; q < 4; ++q) { cv::h8 v;
#pragma unroll
            for (int e = 0; e < 8; ++e) v[e] = taps[8 * q + e];
            *(cv::h8*)(dst + 8 * q) = v; }
    }
    asm volatile("s_waitcnt lgkmcnt(0)" ::: "memory");
}
__device__ __forceinline__ void filt_items(Frame& F, KP P, int first_block, int nblocks, bool pass2) {
    const float* H2 = (const float*)(P->ws + WS_H2); float* NORM = (float*)(P->ws + WS_NORM); f16h* FILT = (f16h*)(P->ws + WS_FILT);
    if (F.bid < first_block) return;
    const int gw = (F.bid - first_block) * 8 + F.wave, NGW = nblocks * 8;
    for (int it = gw; it < 2560; it += NGW) {
        int lv, r = it; if (r < 512) lv = 0; else { lv = 1; r -= 512; }
        const int nr = lv ? 64 : 16, db = r & 15, mr = (r >> 4) % nr, o = (r >> 4) / nr;
        filt_item(H2, P->in[20], NORM, FILT, lv, o, mr, db * 64, F.lane, pass2, (LAS float*)(F.lds + F.wave * 8704));
    }
}
__device__ __forceinline__ void phase0(Frame& F, KP P, bool domods) {
    LAS float* tab = (LAS float*)F.lds;
    LAS float* scr = (LAS float*)(F.lds + 36864 + F.wave * 8448);
    for (int i = F.tid; i < 9 * 1024; i += 512) { const int ci = i >> 10, k = i & 1023; const float v = ci == 0 ? P->in[4][k] : P->in[3][(ci - 1) * 1024 + k]; tab[i] = v / (1.f + expf(-v)); }
    __syncthreads();
    const int gw = F.bid * 8 + F.wave, NGW = F.G * 8;
    float* MOD = (float*)(P->ws + WS_MOD);
    if (domods) for (int it = gw; it < 768; it += NGW) { const int kq = it & 3, cb = (it >> 2) % 96, l = (it >> 2) / 96;
        gemv9_item(P->in[8] + (size_t)l * 1024 * 6144, 6144, cb * 64, kq, tab, MOD + l * 6144, 2 * 6144, P->in[9] + l * 6144, F.lane); }
    for (int pos = gw; pos < 1280; pos += NGW) {
        const int L = pos < 256 ? 256 : 1024, i = pos < 256 ? pos : pos - 256, lane = F.lane;
        if (lane < 33) { float z;
            if (lane == 0) z = (float)((double)i / (double)(L - 1));
            else { const int m = (lane - 1) & 15; const double band = 1e-4 + (double)m * ((15.0 - 1e-4) / 15.0), w = 2.0 * 3.14159265358979323846 * (double)i / (double)L;
                z = lane <= 16 ? (float)cos(band * w) : (float)(-sin(band * w)); }
            scr[lane] = z; }
        asm volatile("s_waitcnt lgkmcnt(0)" ::: "memory");
        float a = P->in[17][lane];
        for (int k = 0; k < 33; ++k) a += scr[k] * P->in[16][k * 64 + lane];
        scr[64 + lane] = sinf(P->in[21][lane] * a);
        asm volatile("s_waitcnt lgkmcnt(0)" ::: "memory");
        float a2 = P->in[19][lane];
        for (int k = 0; k < 64; ++k) a2 += scr[64 + k] * P->in[18][k * 64 + lane];
        ((float*)(P->ws + WS_H2))[pos * 64 + lane] = sinf(P->in[21][lane] * a2);
        asm volatile("s_waitcnt lgkmcnt(0)" ::: "memory");
    }
    { float* post = (float*)(P->ws + WS_POST);
      for (int i = F.bid * 512 + F.tid; i < 80 * 512; i += F.G * 512) { const int n = i >> 9, d = i & 511, nn = n < 16 ? n : n - 16;
          const double om = exp(-log(10000.0) * (double)(d & 255) / 256.0), ang = (double)nn * om; post[i] = (float)(d < 256 ? sin(ang) : cos(ang)); } }
    for (int ix = F.bid * 512 + F.tid; ix < 8192; ix += F.G * 512) s5::s5_table(ix, P->in[25], P->in[26], P->in[27], P->in[28], P->in[29], (float*)(P->ws + WS_S5PW), (f16h*)(P->ws + WS_S5BB));
    { constexpr int I_IN = 16 * 96, I_OUT = 16 * 32, I_13 = 16 * 176, I_2 = 44 * 32, I_GLU = 16 * 64, NIT = I_IN + I_OUT + 2 * I_13 + 2 * I_2 + I_GLU;
      for (int it = gw; it < NIT; it += NGW) { int r = it;
          if (r < I_IN) { transpose_item(P->in[12], 1024, 3072, (f16h*)(P->ws + WS_WIN), scr, r, F.lane); continue; } r -= I_IN;
          if (r < I_OUT) { transpose_item(P->in[23], 1024, 1024, (f16h*)(P->ws + WS_WOUT), scr, r, F.lane); continue; } r -= I_OUT;
          if (r < 2 * I_13) { const int l = r / I_13; transpose_item(P->in[10] + (size_t)l * 1024 * 5632, 1024, 5632, (f16h*)(P->ws + WS_W13) + (size_t)l * 5632 * 1024, scr, r % I_13, F.lane); continue; } r -= 2 * I_13;
          if (r < 2 * I_2) { const int l = r / I_2; transpose_item(P->in[11] + (size_t)l * 2816 * 1024, 2816, 1024, (f16h*)(P->ws + WS_W2) + (size_t)l * 1024 * 2816, scr, r % I_2, F.lane); continue; } r -= 2 * I_2;
          transpose_item(P->in[33], 1024, 2048, (f16h*)(P->ws + WS_WGLU), scr, r, F.lane); } }
}
__device__ __forceinline__ void phase1(Frame& F, KP P) {
    const float* MOD = (const float*)(P->ws + WS_MOD);
    const int gw = F.bid * 8 + F.wave, NGW = F.G * 8;
    LAS float* tab = (LAS float*)F.lds;
    for (int i = F.tid; i < 2 * 9 * 1024; i += 512) { const int l = i / 9216, r = i % 9216, ci = r >> 10, k = r & 1023; tab[i] = MOD[(ci * 2 + l) * 6144 + 3072 + k]; }
    __syncthreads();
    float* BIAS2 = (float*)(P->ws + WS_BIAS2);
    for (int it = gw; it < 704; it += NGW) { const int kq = it & 3, cb = (it >> 2) % 88, l = (it >> 2) / 88;
        gemv9_item(P->in[10] + (size_t)l * 1024 * 5632, 5632, cb * 64, kq, tab + l * 9216, BIAS2 + (size_t)l * 9 * 5632, 5632, nullptr, F.lane); }
    { f16h* XA = (f16h*)(P->ws + WS_XA); const float* post = (const float*)(P->ws + WS_POST); const float* ng = P->in[5];
      for (int row = gw; row < T; row += NGW) {
          const float* mb = MOD + (row_ci(row) * 2) * 6144; g8::f32x4 v[4]; float s = 0.f;
#pragma unroll
          for (int j = 0; j < 4; ++j) { const int c = 4 * F.lane + 256 * j;
              if (row < NCTX) v[j] = *(const g8::f32x4*)(P->in[0] + (size_t)row * 1024 + c);
              else { const int r = row - NCTX, t = r & 1023; v[j] = *(const g8::f32x4*)(P->in[1] + (size_t)r * 1024 + c);
                  v[j] += *(const g8::f32x4*)(c < 512 ? post + (t >> 6) * 512 + c : post + 16 * 512 + (t & 63) * 512 + (c - 512)); }
              s += (v[j][0] * v[j][0] + v[j][1] * v[j][1]) + (v[j][2] * v[j][2] + v[j][3] * v[j][3]); }
          const float rstd = 1.0f / sqrtf(wave_sum(s) * (1.f / 1024.f) + 1e-6f);
#pragma unroll
          for (int j = 0; j < 4; ++j) { const int c = 4 * F.lane + 256 * j; const g8::f32x4 g = *(const g8::f32x4*)(ng + c), sh = *(const g8::f32x4*)(mb + c), sc = *(const g8::f32x4*)(mb + 1024 + c);
              g8::u32x2 w; w.x = pkh(v[j][0] * rstd * g[0] * (1.f + sc[0]) + sh[0], v[j][1] * rstd * g[1] * (1.f + sc[1]) + sh[1]);
              w.y = pkh(v[j][2] * rstd * g[2] * (1.f + sc[2]) + sh[2], v[j][3] * rstd * g[3] * (1.f + sc[3]) + sh[3]);
              *(g8::u32x2*)(XA + (size_t)row * 1024 + c) = w; } } }
    __syncthreads();
    filt_items(F, P, 0, F.G, false);
}
__device__ __forceinline__ void phase_final(Frame& F, KP P) {
    const float* ssq = (const float*)(P->ws + WS_SSQ) + 3 * T; const float* fg = P->in[7];
    const int gw = F.bid * 8 + F.wave, NGW = F.G * 8;
    for (int row = gw; row < T; row += NGW) { const float rstd = 1.0f / sqrtf(ssq[row] * (1.f / 1024.f) + 1e-6f); float* x = P->out + (size_t)row * 1024;
#pragma unroll
        for (int j = 0; j < 4; ++j) { const int c = 4 * F.lane + 256 * j; g8::f32x4 v = *(g8::f32x4*)(x + c); const g8::f32x4 g = *(const g8::f32x4*)(fg + c);
            v[0] *= rstd * g[0]; v[1] *= rstd * g[1]; v[2] *= rstd * g[2]; v[3] *= rstd * g[3]; *(g8::f32x4*)(x + c) = v; } }
}

#define LAUNDER(p) asm volatile("" : "+s"(p))
__global__ void __launch_bounds__(512, 2) mk_fwd(Params prm_unused) {
    extern __shared__ __attribute__((aligned(16))) unsigned char lds_raw[];
    KP kp = (KP)__builtin_amdgcn_kernarg_segment_ptr();
    Frame F; F.lds = (LAS unsigned char*)lds_raw; F.tid = threadIdx.x; F.lane = F.tid & 63; F.wave = __builtin_amdgcn_readfirstlane(F.tid >> 6); F.G = gridDim.x; F.bid = blockIdx.x;
    volatile LAS unsigned* MISC = (volatile LAS unsigned*)(F.lds + LDS_MISC);
    if (F.tid < 32) MISC[F.tid] = 0u;
    __syncthreads();
    XcdBarrier bar; bar.bar = (unsigned*)(kp->ws + CTL_BAR); bar.x = 0; bar.st = nullptr;
    if (MK_LAUNCHES == 1) bar = xcd_barrier_post((unsigned*)(kp->ws + CTL_BAR), MISC + 8);
    const int lo = kp->ph_lo, hi = kp->ph_hi;
#define IN(k) (lo <= (k) && (k) < hi)
#define SEAM(k) do { if (IN(k) && IN((k) + 1)) xcd_barrier(bar); } while (0)
#define WSP(T_, off) ((T_*)(ws + (off)))
    if (IN(0)) { LAUNDER(kp); phase0(F, kp, true); if (MK_DUP & 1) { xcd_barrier(bar); phase0(F, kp, false); } }
    SEAM(0);
    if (IN(1)) { LAUNDER(kp); phase1(F, kp); }
    SEAM(1);
    if (IN(2)) {
        LAUNDER(kp); unsigned char* ws = kp->ws;
        g8::Gemm g{ws + WS_WIN, ws + WS_XA, 1024, 2048u, 16u, 256, 128, 12, 48, 0}; g8::StaticOrder S; S.init(12, 48, F.G, F.bid);
        EpiZT E{WSP(f16h, WS_ZT), kp->in[13]}; g8::gemm_phase<EpiZT>(F.lds, g, S, E);
        filt_items(F, kp, 64, F.G - 64, true);
    }
    if (MK_DUP & (1 << 2)) { xcd_barrier(bar); if (IN(2)) {
        LAUNDER(kp); unsigned char* ws = kp->ws;
        g8::Gemm g{ws + WS_WIN, ws + WS_XA, 1024, 2048u, 16u, 256, 128, 12, 48, 0}; g8::StaticOrder S; S.init(12, 48, F.G, F.bid);
        EpiZT E{WSP(f16h, WS_ZT), kp->in[13]}; g8::gemm_phase<EpiZT>(F.lds, g, S, E);
        filt_items(F, kp, 64, F.G - 64, true);
    } }
    SEAM(2);
    if (IN(3)) { LAUNDER(kp); unsigned char* ws = kp->ws; cv::Args A{WSP(f16h, WS_ZT), WSP(const f16h, WS_FILT), kp->in[14], kp->in[15], kp->in[22], WSP(f16h, WS_V2)}; cv::conv_phase(F.lds, A, F.G, F.bid); }
    if (MK_DUP & (1 << 3)) { xcd_barrier(bar); if (IN(3)) { LAUNDER(kp); unsigned char* ws = kp->ws; cv::Args A{WSP(f16h, WS_ZT), WSP(const f16h, WS_FILT), kp->in[14], kp->in[15], kp->in[22], WSP(f16h, WS_V2)}; cv::conv_phase(F.lds, A, F.G, F.bid); } }
    SEAM(3);
    if (IN(4) && (MK_DUP & (1 << 4))) {
        LAUNDER(kp); unsigned char* ws = kp->ws;
        g8::Gemm g{ws + WS_V2, ws + WS_WOUT, 1024, 16u, 16u * 12288u, 256, 128, 48, 4, 0}; g8::StaticOrder S; S.init(48, 4, F.G, F.bid);
        EpiRes2<true> E{ResOut{WSP(float, WS_YB), kp->out, nullptr, kp->in[6], nullptr, kp->in[0], kp->in[1], WSP(const float, WS_POST), 0, 0}, kp->in[24], WSP(const float, WS_MOD), 2048, 4096};
        g8::gemm_phase<EpiRes2<true>>(F.lds, g, S, E);
    }
    if (IN(4) && (MK_DUP & (1 << 4))) xcd_barrier(bar);
    if (IN(4)) {
        LAUNDER(kp); unsigned char* ws = kp->ws;
        g8::Gemm g{ws + WS_V2, ws + WS_WOUT, 1024, 16u, 16u * 12288u, 256, 128, 48, 4, 0}; g8::StaticOrder S; S.init(48, 4, F.G, F.bid);
        EpiRes2<true> E{ResOut{kp->out, kp->out, WSP(f16h, WS_XA), kp->in[6], WSP(float, WS_SSQ), kp->in[0], kp->in[1], WSP(const float, WS_POST), 0, 0}, kp->in[24], WSP(const float, WS_MOD), 2048, 4096};
        g8::gemm_phase<EpiRes2<true>>(F.lds, g, S, E);
    }
    SEAM(4);
    if (IN(5)) { LAUNDER(kp); unsigned char* ws = kp->ws;
        g8::Gemm g{ws + WS_XA, ws + WS_W13, 1024, 2048u, 16u, 128, 2816, 48, 22, 0}; g8::StaticOrder S; S.init(48, 22, F.G, F.bid);
        EpiSwiglu2 E{WSP(f16h, WS_ZT), WSP(const float, WS_SSQ), WSP(const float, WS_BIAS2)}; g8::gemm_phase<EpiSwiglu2>(F.lds, g, S, E); }
    if (MK_DUP & (1 << 5)) { xcd_barrier(bar); if (IN(5)) { LAUNDER(kp); unsigned char* ws = kp->ws;
        g8::Gemm g{ws + WS_XA, ws + WS_W13, 1024, 2048u, 16u, 128, 2816, 48, 22, 0}; g8::StaticOrder S; S.init(48, 22, F.G, F.bid);
        EpiSwiglu2 E{WSP(f16h, WS_ZT), WSP(const float, WS_SSQ), WSP(const float, WS_BIAS2)}; g8::gemm_phase<EpiSwiglu2>(F.lds, g, S, E); } }
    SEAM(5);
    if (IN(6) && (MK_DUP & (1 << 6))) { LAUNDER(kp); unsigned char* ws = kp->ws;
        g8::Gemm g{ws + WS_ZT, ws + WS_W2, 2816, 5632u, 16u, 256, 128, 48, 4, 0}; g8::StaticOrder S; S.init(48, 4, F.G, F.bid);
        EpiRes2<false> E{ResOut{WSP(float, WS_YB), kp->out, nullptr, kp->in[5] + D, nullptr, nullptr, nullptr, nullptr, 1, 0}, nullptr, WSP(const float, WS_MOD), 5120, 6144 + 1024};
        g8::gemm_phase<EpiRes2<false>>(F.lds, g, S, E); }
    if (IN(6) && (MK_DUP & (1 << 6))) xcd_barrier(bar);
    if (IN(6)) { LAUNDER(kp); unsigned char* ws = kp->ws;
        g8::Gemm g{ws + WS_ZT, ws + WS_W2, 2816, 5632u, 16u, 256, 128, 48, 4, 0}; g8::StaticOrder S; S.init(48, 4, F.G, F.bid);
        EpiRes2<false> E{ResOut{kp->out, kp->out, WSP(f16h, WS_XA), kp->in[5] + D, WSP(float, WS_SSQ) + T, nullptr, nullptr, nullptr, 1, 0}, nullptr, WSP(const float, WS_MOD), 5120, 6144 + 1024};
        g8::gemm_phase<EpiRes2<false>>(F.lds, g, S, E); }
    SEAM(6);
    if (IN(7)) { LAUNDER(kp); unsigned char* ws = kp->ws;
        s5::Args A{WSP(const f16h, WS_XA), WSP(const float, WS_SSQ) + T, WSP(const float, WS_MOD), WSP(const float, WS_S5PW), WSP(const f16h, WS_S5BB), kp->in[30], kp->in[31], kp->in[32], kp->in[2], WSP(float, WS_YB), WSP(f16h, WS_V2), kp->out + (size_t)T * D};
        if (F.tid < 8) MISC[16 + F.tid] = 0u; __syncthreads(); s5::s5_phase(F.lds, (volatile LAS int*)(MISC + 16), A, F.G, F.bid); }
    if (MK_DUP & (1 << 7)) { xcd_barrier(bar); if (IN(7)) { LAUNDER(kp); unsigned char* ws = kp->ws;
        s5::Args A{WSP(const f16h, WS_XA), WSP(const float, WS_SSQ) + T, WSP(const float, WS_MOD), WSP(const float, WS_S5PW), WSP(const f16h, WS_S5BB), kp->in[30], kp->in[31], kp->in[32], kp->in[2], WSP(float, WS_YB), WSP(f16h, WS_V2), kp->out + (size_t)T * D};
        if (F.tid < 8) MISC[16 + F.tid] = 0u; __syncthreads(); s5::s5_phase(F.lds, (volatile LAS int*)(MISC + 16), A, F.G, F.bid); } }
    SEAM(7);
    if (IN(8) && (MK_DUP & (1 << 8))) { LAUNDER(kp); unsigned char* ws = kp->ws;
        g8::Gemm g{ws + WS_V2, ws + WS_WGLU, 1024, 16u, 16u * 12288u, 128, 1024, 48, 8, 0}; g8::StaticOrder S; S.init(48, 8, F.G, F.bid);
        EpiGlu2 E{ResOut{WSP(float, WS_YB), kp->out, nullptr, kp->in[6] + D, nullptr, nullptr, nullptr, nullptr, 0, 0}, kp->in[34], WSP(const float, WS_MOD), 6144 + 2048, 6144 + 4096};
        g8::gemm_phase<EpiGlu2>(F.lds, g, S, E); }
    if (IN(8) && (MK_DUP & (1 << 8))) xcd_barrier(bar);
    if (IN(8)) { LAUNDER(kp); unsigned char* ws = kp->ws;
        g8::Gemm g{ws + WS_V2, ws + WS_WGLU, 1024, 16u, 16u * 12288u, 128, 1024, 48, 8, 0}; g8::StaticOrder S; S.init(48, 8, F.G, F.bid);
        EpiGlu2 E{ResOut{kp->out, kp->out, WSP(f16h, WS_XA), kp->in[6] + D, WSP(float, WS_SSQ) + 2 * T, nullptr, nullptr, nullptr, 0, 0}, kp->in[34], WSP(const float, WS_MOD), 6144 + 2048, 6144 + 4096};
        g8::gemm_phase<EpiGlu2>(F.lds, g, S, E); }
    SEAM(8);
    if (IN(9)) { LAUNDER(kp); unsigned char* ws = kp->ws;
        g8::Gemm g{ws + WS_XA, ws + WS_W13 + (size_t)5632 * 1024 * 2, 1024, 2048u, 16u, 128, 2816, 48, 22, 0}; g8::StaticOrder S; S.init(48, 22, F.G, F.bid);
        EpiSwiglu2 E{WSP(f16h, WS_ZT), WSP(const float, WS_SSQ) + 2 * T, WSP(const float, WS_BIAS2) + 9 * 5632}; g8::gemm_phase<EpiSwiglu2>(F.lds, g, S, E); }
    SEAM(9);
    if (IN(10) && (MK_DUP & (1 << 10))) { LAUNDER(kp); unsigned char* ws = kp->ws;
        g8::Gemm g{ws + WS_ZT, ws + WS_W2 + (size_t)1024 * 2816 * 2, 2816, 5632u, 16u, 256, 128, 48, 4, 0}; g8::StaticOrder S; S.init(48, 4, F.G, F.bid);
        EpiRes2<false> E{ResOut{WSP(float, WS_YB), kp->out, nullptr, nullptr, nullptr, nullptr, nullptr, nullptr, 0, 0}, nullptr, WSP(const float, WS_MOD), 6144 + 5120, 0};
        g8::gemm_phase<EpiRes2<false>>(F.lds, g, S, E); }
    if (IN(10) && (MK_DUP & (1 << 10))) xcd_barrier(bar);
    if (IN(10)) { LAUNDER(kp); unsigned char* ws = kp->ws;
        g8::Gemm g{ws + WS_ZT, ws + WS_W2 + (size_t)1024 * 2816 * 2, 2816, 5632u, 16u, 256, 128, 48, 4, 0}; g8::StaticOrder S; S.init(48, 4, F.G, F.bid);
        EpiRes2<false> E{ResOut{kp->out, kp->out, nullptr, nullptr, WSP(float, WS_SSQ) + 3 * T, nullptr, nullptr, nullptr, 0, 0}, nullptr, WSP(const float, WS_MOD), 6144 + 5120, 0};
        g8::gemm_phase<EpiRes2<false>>(F.lds, g, S, E); }
    SEAM(10);
    if (IN(11)) { LAUNDER(kp); phase_final(F, kp); }
#undef IN
#undef SEAM
#undef WSP
}

extern "C" void kernel_launch(void* const* d_in, const int* in_sizes, int n_in, void* d_out, int out_size, void* d_ws, size_t ws_size, hipStream_t stream) {
    static int grid = 0;
    if (grid == 0) {
        if (n_in != 35 || ws_size < WS_END) { fprintf(stderr, "kernel_launch: unexpected n_in %d / ws %zu\n", n_in, ws_size); grid = -1; return; }
        int dev = 0, cus = 0, per_cu = 0;
        if (hipGetDevice(&dev) != hipSuccess || hipDeviceGetAttribute(&cus, hipDeviceAttributeMultiprocessorCount, dev) != hipSuccess) { grid = -1; return; }
        if (hipFuncSetAttribute((const void*)mk_fwd, hipFuncAttributeMaxDynamicSharedMemorySize, LDS_BYTES) != hipSuccess) { fprintf(stderr, "kernel_launch: hipFuncSetAttribute failed\n"); grid = -1; return; }
        if (hipOccupancyMaxActiveBlocksPerMultiprocessor(&per_cu, (const void*)mk_fwd, 512, LDS_BYTES) != hipSuccess || per_cu < 1) { fprintf(stderr, "kernel_launch: occupancy query says %d\n", per_cu); per_cu = 1; }
        (void)hipGetLastError();
        grid = cus;
    }
    if (grid < 0) return;
    (void)hipMemsetAsync((char*)d_ws + WS_CTL, 0, CTL_ZERO_BYTES, stream);
    Params p; memset(&p, 0, sizeof(p));
    for (int i = 0; i < 35; ++i) p.in[i] = (const float*)d_in[i];
    p.out = (float*)d_out; p.ws = (unsigned char*)d_ws;
    if (MK_LAUNCHES == 1) { p.ph_lo = 0; p.ph_hi = NPH; hipLaunchKernelGGL(mk_fwd, dim3(grid), dim3(512), LDS_BYTES, stream, p); }
    else for (int k = 0; k < NPH; ++k) { p.ph_lo = k; p.ph_hi = k + 1; hipLaunchKernelGGL(mk_fwd, dim3(grid), dim3(512), LDS_BYTES, stream, p); }
}
```

```cpp
#include <hip/hip_runtime.h>
#include <math.h>
#include <string.h>
#include <stdio.h>

#ifndef MK_DUP
#define MK_DUP 0
#endif
#ifndef MK_LAUNCHES
#define MK_LAUNCHES 1
#endif
constexpr int D = 1024, NCTX = 4096, NLAT = 8192, T = 12288, F = 2816, NPH = 12;
constexpr size_t MiB = 1u << 20;
typedef _Float16 f16h;
constexpr size_t WS_CTL = 0, CTL_ZERO_BYTES = 2 * MiB;
constexpr size_t CTL_BAR = 16384;
constexpr size_t WS_MOD = 65536;
constexpr size_t WS_SSQ = 524288;
constexpr size_t WS_NORM = 720896;
constexpr size_t WS_BIAS2 = 786432;
constexpr size_t WS_H2 = 2 * MiB;
constexpr size_t WS_POST = 2 * MiB + 512 * 1024;
constexpr size_t WS_S5PW = 2 * MiB + 768 * 1024;
constexpr size_t WS_S5BB = 3 * MiB;
constexpr size_t WS_FILT = 4 * MiB;
constexpr size_t WS_WIN = 24 * MiB, WS_WOUT = 30 * MiB, WS_W13 = 32 * MiB  , WS_W2 = 54 * MiB  , WS_WGLU = 65 * MiB;
constexpr size_t WS_XA = 70 * MiB;
constexpr size_t WS_V2 = 94 * MiB;
constexpr size_t WS_ZT = 118 * MiB;
constexpr size_t WS_YB = 190 * MiB;
constexpr size_t WS_END = 238 * MiB;
constexpr int LDS_BYTES = 135168;
constexpr int LDS_MISC = 133120;

__device__ __forceinline__ int row_ci(int row) { return row < NCTX ? 0 : 1 + ((row - NCTX) >> 10); }
__device__ __forceinline__ float siluf(float v) { return v / (1.f + __expf(-v)); }
__device__ __forceinline__ float sigmf(float v) { return 1.f / (1.f + __expf(-v)); }
__device__ __forceinline__ unsigned pkh(float a, float b) { typedef _Float16 h2 __attribute__((ext_vector_type(2))); h2 v; v.x = (_Float16)a; v.y = (_Float16)b; return __builtin_bit_cast(unsigned, v); }

__device__ __forceinline__ void atomic_add_done(float* p, float v) { const float old = atomicAdd(p, v); asm volatile("" :: "v"(old)); }
struct Params { const float* in[35]; float* out; unsigned char* ws; int ph_lo, ph_hi; };
namespace g8 {
#define G8_LAS __attribute__((address_space(3)))
typedef _Float16 h8 __attribute__((ext_vector_type(8)));
typedef float f32x4 __attribute__((ext_vector_type(4)));
typedef unsigned u32x4 __attribute__((ext_vector_type(4)));
typedef unsigned u32x2 __attribute__((ext_vector_type(2)));
constexpr int BM = 256, BK = 64, HALF = 128, HTB = HALF * BK * 2, STAGE_BYTES = 8 * HTB, NXCD = 8, WGM = 8;
__host__ __device__ __forceinline__ int lds_byte(int r, int c) { const int st = (r >> 4) * 2 + (c >> 5), rr = r & 15, cc = c & 31, ob = rr * 64 + cc * 2; return st * 1024 + (ob ^ (((ob >> 9) & 1) << 5)); }
__host__ __device__ __forceinline__ void stage_rc(int b, int& R, int& C) { const int st = b / 1024, sb = b % 1024, swz = sb ^ (((sb >> 9) & 1) << 5); R = (st >> 1) * 16 + swz / 64; C = (st & 1) * 32 + (swz % 64) / 2; }
struct Unit { int pm, pn; };
struct Gemm { const void* A; const void* Bt; int K; unsigned a_row, a_k8; int b_tile_rows, b_half_rows; int nM, nN; int pad; };
struct StaticOrder {
    int nM, nN, nwg, G, c;
    __device__ void init(int nM_, int nN_, int G_, int c_) { nM = nM_; nN = nN_; nwg = nM * nN; G = G_; c = c_; }
    __device__ bool next(int i, Unit& u) const {
        const long L = (long)i * G + c; if (L >= nwg) return false;
        int wgid = (int)L; { const int q = nwg / NXCD, r = nwg % NXCD, xcd = wgid % NXCD, off = wgid / NXCD; wgid = (xcd < r ? xcd * (q + 1) : r * (q + 1) + (xcd - r) * q) + off; }
        const int nig = WGM * nN, gid = wgid / nig, fm = gid * WGM, gsz = (nM - fm) < WGM ? (nM - fm) : WGM;
        u.pm = fm + ((wgid % nig) % gsz); u.pn = (wgid % nig) / gsz; return true;
    }
};
template <class Epi>
__device__ __forceinline__ void gemm_phase(G8_LAS unsigned char* lds, const Gemm g, const StaticOrder& S, const Epi& E) {
    const int tid = threadIdx.x, wid = __builtin_amdgcn_readfirstlane(tid >> 6), lane = tid & 63, wr = wid >> 2, wc = wid & 3, fr = lane & 15, fq = lane >> 4;
    const int K = g.K, nt = K / BK;
    unsigned voffA[2], voffB[2];
#pragma unroll
    for (int i = 0; i < 2; ++i) { int R, C; stage_rc(tid * 16 + i * 8192, R, C);
        voffA[i] = (unsigned)R * g.a_row + (unsigned)(C >> 3) * g.a_k8; voffB[i] = (unsigned)(R * K + C) * 2u; }
    const size_t kstepA = (size_t)8 * g.a_k8, kstepB = (size_t)(BK * 2);
    const size_t hstepA = (size_t)HALF * g.a_row, tstepA = 2 * hstepA;
    const size_t hstepB = (size_t)g.b_half_rows * K * 2, tstepB = (size_t)g.b_tile_rows * K * 2;
    const unsigned ldsw = (unsigned)wid * 1024u;
    const int aoff = lds_byte(wr * 64 + fr, fq * 8), boff = lds_byte(wc * 32 + fr, fq * 8);
#define G8_SA(b, h) (((b) * 2 + (h)) * HTB)
#define G8_SB(b, h) ((4 + (b) * 2 + (h)) * HTB)
#define G8_STAGE(bufoff, gbase, voff) do { _Pragma("unroll") for (int _i = 0; _i < 2; ++_i) \
        __builtin_amdgcn_global_load_lds((const unsigned*)((const char*)(gbase) + (voff)[_i]), (G8_LAS unsigned*)(lds + (bufoff) + ldsw + _i * 8192), 16, 0, 0); } while (0)
#define G8_LDA(dst, b, h) do { _Pragma("unroll") for (int m = 0; m < 4; ++m) _Pragma("unroll") for (int k = 0; k < 2; ++k) dst[m][k] = *(const G8_LAS h8*)(lds + G8_SA(b, h) + aoff + m * 2048 + k * 1024); } while (0)
#define G8_LDB(dst, b, h) do { _Pragma("unroll") for (int n = 0; n < 2; ++n) _Pragma("unroll") for (int k = 0; k < 2; ++k) dst[n][k] = *(const G8_LAS h8*)(lds + G8_SB(b, h) + boff + n * 2048 + k * 1024); } while (0)
#define G8_MMA(ai, bj, At, Bt) do { __builtin_amdgcn_s_setprio(1); _Pragma("unroll") for (int m = 0; m < 4; ++m) _Pragma("unroll") for (int n = 0; n < 2; ++n) _Pragma("unroll") for (int k = 0; k < 2; ++k) \
        acc[ai][bj][m][n] = __builtin_amdgcn_mfma_f32_16x16x32_f16(Bt[n][k], At[m][k], acc[ai][bj][m][n], 0, 0, 0); __builtin_amdgcn_s_setprio(0); } while (0)
#define G8_WAIT_V(n) asm volatile("s_waitcnt vmcnt(" #n ")" ::: "memory")
#define G8_WAIT_L(n) asm volatile("s_waitcnt lgkmcnt(" #n ")" ::: "memory")
#define G8_BAR __builtin_amdgcn_s_barrier()
#define G8_SCHED __builtin_amdgcn_sched_barrier(0)
    Unit cur, nxt; int ui = 0;
    if (!S.next(0, cur)) return;
    f32x4 acc[2][2][4][2];
#pragma unroll
    for (int a = 0; a < 2; ++a)
#pragma unroll
        for (int b = 0; b < 2; ++b)
#pragma unroll
            for (int m = 0; m < 4; ++m)
#pragma unroll
                for (int n = 0; n < 2; ++n) acc[a][b][m][n] = (f32x4){0.f, 0.f, 0.f, 0.f};
    h8 At[4][2], B0[2][2], B1[2][2];
    const char* cA = (const char*)g.A + (size_t)cur.pm * tstepA; const char* cB = (const char*)g.Bt + (size_t)cur.pn * tstepB;
    G8_STAGE(G8_SB(0, 0), cB, voffB); G8_STAGE(G8_SA(0, 0), cA, voffA); G8_STAGE(G8_SB(0, 1), cB + hstepB, voffB); G8_STAGE(G8_SA(0, 1), cA + hstepA, voffA);
    if (wr == 1) G8_BAR;
    G8_WAIT_V(4); G8_BAR;
    G8_STAGE(G8_SB(1, 0), cB + kstepB, voffB); G8_STAGE(G8_SA(1, 0), cA + kstepA, voffA); G8_STAGE(G8_SB(1, 1), cB + hstepB + kstepB, voffB);
    G8_WAIT_V(6); G8_BAR;
    for (;;) {
        const bool has_next = S.next(ui + 1, nxt);
        const char* nA = has_next ? (const char*)g.A + (size_t)nxt.pm * tstepA : cA; const char* nB = has_next ? (const char*)g.Bt + (size_t)nxt.pn * tstepB : cB;
        for (int t = 0; t < nt; t += 2) {
            const bool last = (t == nt - 2);
            const char* a1 = cA + (size_t)(t + 1) * kstepA;
            const char* a2 = last ? nA : cA + (size_t)(t + 2) * kstepA; const char* b2 = last ? nB : cB + (size_t)(t + 2) * kstepB;
            const char* a3 = a2 + kstepA; const char* b3 = b2 + kstepB;
            G8_LDB(B0, 0, 0); G8_SCHED; G8_LDA(At, 0, 0); G8_STAGE(G8_SA(1, 1), a1 + hstepA, voffA);
            G8_WAIT_L(8); G8_BAR; G8_WAIT_L(0); G8_MMA(0, 0, At, B0); G8_BAR; G8_SCHED;
            G8_LDB(B1, 0, 1); G8_STAGE(G8_SB(0, 0), b2, voffB);
            G8_BAR; G8_WAIT_L(0); G8_MMA(0, 1, At, B1); G8_BAR;
            G8_LDA(At, 0, 1); G8_STAGE(G8_SA(0, 0), a2, voffA);
            G8_BAR; G8_WAIT_L(0); G8_MMA(1, 0, At, B0); G8_BAR; G8_SCHED;
            G8_STAGE(G8_SB(0, 1), b2 + hstepB, voffB);
            G8_WAIT_V(6); G8_BAR; G8_MMA(1, 1, At, B1); G8_BAR;
            G8_LDB(B0, 1, 0); G8_SCHED; G8_LDA(At, 1, 0); G8_STAGE(G8_SA(0, 1), a2 + hstepA, voffA);
            G8_WAIT_L(8); G8_BAR; G8_WAIT_L(0); G8_MMA(0, 0, At, B0); G8_BAR; G8_SCHED;
            G8_LDB(B1, 1, 1); G8_STAGE(G8_SB(1, 0), b3, voffB);
            G8_BAR; G8_WAIT_L(0); G8_MMA(0, 1, At, B1); G8_BAR;
            G8_LDA(At, 1, 1); G8_STAGE(G8_SA(1, 0), a3, voffA);
            G8_BAR; G8_WAIT_L(0); G8_MMA(1, 0, At, B0); G8_BAR; G8_SCHED;
            G8_STAGE(G8_SB(1, 1), b3 + hstepB, voffB);
            G8_WAIT_V(6); G8_BAR; G8_MMA(1, 1, At, B1); G8_BAR;
        }
        E(acc, cur, wr, wc, fr, fq);
        if (!has_next) break;
#pragma unroll
        for (int a = 0; a < 2; ++a)
#pragma unroll
            for (int b = 0; b < 2; ++b)
#pragma unroll
                for (int m = 0; m < 4; ++m)
#pragma unroll
                    for (int n = 0; n < 2; ++n) acc[a][b][m][n] = (f32x4){0.f, 0.f, 0.f, 0.f};
        cur = nxt; cA = nA; cB = nB; ++ui;
    }
    G8_WAIT_V(0);
    if (wr == 0) G8_BAR;
    G8_BAR;
#undef G8_SA
#undef G8_SB
#undef G8_STAGE
#undef G8_LDA
#undef G8_LDB
#undef G8_MMA
#undef G8_WAIT_V
#undef G8_WAIT_L
#undef G8_BAR
#undef G8_SCHED
}
}
namespace cv {
#define CV_LAS __attribute__((address_space(3)))
typedef _Float16 h8 __attribute__((ext_vector_type(8)));
typedef _Float16 h4 __attribute__((ext_vector_type(4)));
typedef float f32x16 __attribute__((ext_vector_type(16)));
typedef unsigned u4 __attribute__((ext_vector_type(4)));
typedef unsigned u2 __attribute__((ext_vector_type(2)));
constexpr int WAVE_LDS = 16640, V_OFF = 0, FA_OFF = 8320, FB_OFF = 12480;
constexpr float FSCALE = 64.f;
struct Args { const _Float16* zT; const _Float16* FILT; const float* conv_w; const float* conv_b; const float* fbias; _Float16* V2; };
__host__ __device__ __forceinline__ size_t filt_off(int lv, int o, int ch) { return lv ? (size_t)2 * 1024 * 512 + (size_t)(o * 1024 + ch) * 2048 : (size_t)(o * 1024 + ch) * 512; }
template <int LV> __device__ __forceinline__ void conv_unit(CV_LAS unsigned char* lds, const Args& P, int c, int bh) {
    constexpr int L = LV ? 1024 : 256, NBu = LV ? 4 : 8, T1 = L / 32, T1L = LV ? 8 : 4, NCT = T1 / T1L, PV = L * 2 + 16;
    const int tid = threadIdx.x, w = __builtin_amdgcn_readfirstlane(tid >> 6), lane = tid & 63;
    const int ch = 8 * c + w;
    const int row_base = LV ? 4096 + (4 * bh) * 1024 : (8 * bh) * 256;
    CV_LAS unsigned char* wl = lds + w * WAVE_LDS;
    {
        const _Float16* zrow = P.zT + (size_t)ch * 12288 + row_base;
        const float w0 = P.conv_w[ch], w1 = P.conv_w[3072 + ch], w2 = P.conv_w[6144 + ch], cb = P.conv_b[ch];
        for (int piece = lane; piece < NBu * L / 8; piece += 64) {
            const int bl = piece / (L / 8), t0 = (piece % (L / 8)) * 8;
            const h8 raw = *(const h8*)(zrow + bl * L + t0);
            float z[10];
            z[0] = t0 > 0 ? (float)zrow[bl * L + t0 - 1] : 0.f; z[9] = t0 + 8 < L ? (float)zrow[bl * L + t0 + 8] : 0.f;
#pragma unroll
            for (int i = 0; i < 8; ++i) z[i + 1] = (float)raw[i];
            h8 o;
#pragma unroll
            for (int i = 0; i < 8; ++i) o[i] = (_Float16)(w0 * z[i] + w1 * z[i + 1] + w2 * z[i + 2] + cb);
            *(CV_LAS h8*)(wl + V_OFF + bl * PV + t0 * 2) = o;
        }
    }
    const int t2 = lane & 31, hi = lane >> 5, col = lane & 31, bl = col / T1L, t1l = col % T1L;
    const int abase = (t2 & 1) ? FA_OFF + 2 * ((L - 1) - t2 + 8 * hi) : FB_OFF + 2 * ((L - 1) - t2 + 8 * hi - 1);
    const int vbase = V_OFF + bl * PV + 16 * hi;
#pragma unroll 1
    for (int o = 0; o < 2; ++o) {
        {
            const u4* Fg = (const u4*)(P.FILT + filt_off(LV, o, ch));
            for (int piece = lane; piece < 2 * L / 8; piece += 64) {
                const u4 a = Fg[piece]; const unsigned e0 = piece + 1 < 2 * L / 8 ? ((const unsigned*)(Fg + piece + 1))[0] : 0u;
                u4 b; b.x = (a.x >> 16) | (a.y << 16); b.y = (a.y >> 16) | (a.z << 16); b.z = (a.z >> 16) | (a.w << 16); b.w = (a.w >> 16) | (e0 << 16);
                *(CV_LAS u4*)(wl + FA_OFF + piece * 16) = a;
                *(CV_LAS u4*)(wl + FB_OFF + piece * 16) = b;
            }
        }
        f32x16 acc[NCT];
#pragma unroll
        for (int ct = 0; ct < NCT; ++ct)
#pragma unroll
            for (int r = 0; r < 16; ++r) acc[ct][r] = 0.f;
#pragma unroll 1
        for (int d = -(T1 - 1); d <= T1 - 1; ++d) {
            const CV_LAS unsigned* ap = (const CV_LAS unsigned*)(wl + abase - 64 * d);
            u4 a0, a1;
            a0.x = ap[0]; a0.y = ap[1]; a0.z = ap[2]; a0.w = ap[3];
            a1.x = ap[8]; a1.y = ap[9]; a1.z = ap[10]; a1.w = ap[11];
            const h8 A0 = __builtin_bit_cast(h8, a0), A1 = __builtin_bit_cast(h8, a1);
#pragma unroll
            for (int ct = 0; ct < NCT; ++ct) {
                const int lo = ct * T1L - d;
                if (lo + T1L - 1 < 0 || lo > T1 - 1) continue;
                const int s1 = lo + t1l; const bool valid = (unsigned)s1 < (unsigned)T1; const int s1c = valid ? s1 : 0;
                h8 b0 = *(const CV_LAS h8*)(wl + vbase + s1c * 64), b1 = *(const CV_LAS h8*)(wl + vbase + s1c * 64 + 32);
                if (!valid) {
#pragma unroll
                    for (int i = 0; i < 8; ++i) { b0[i] = (_Float16)0.f; b1[i] = (_Float16)0.f; } }
                acc[ct] = __builtin_amdgcn_mfma_f32_32x32x16_f16(A0, b0, acc[ct], 0, 0, 0);
                acc[ct] = __builtin_amdgcn_mfma_f32_32x32x16_f16(A1, b1, acc[ct], 0, 0, 0);
            }
        }
        {
            const int gch = (o + 1) * 1024 + ch;
            const _Float16* xrow = P.zT + (size_t)gch * 12288 + row_base + bl * L;
            const float g0 = P.conv_w[gch], g1 = P.conv_w[3072 + gch], g2 = P.conv_w[6144 + gch], gcb = P.conv_b[gch], fbv = P.fbias[o * 1024 + ch];
#pragma unroll
            for (int ct = 0; ct < NCT; ++ct)
#pragma unroll
                for (int g = 0; g < 4; ++g) {
                    const int t = 32 * (ct * T1L + t1l) + 8 * g + 4 * hi;
                    const h4 zz = *(const h4*)(xrow + t);
                    float z[6]; z[0] = t > 0 ? (float)xrow[t - 1] : 0.f; z[5] = t + 4 < L ? (float)xrow[t + 4] : 0.f;
#pragma unroll
                    for (int i = 0; i < 4; ++i) z[i + 1] = (float)zz[i];
                    CV_LAS h4* vp = (CV_LAS h4*)(wl + V_OFF + bl * PV + t * 2);
                    const h4 vin = *vp; h4 vo;
#pragma unroll
                    for (int i = 0; i < 4; ++i) { const float gate = g0 * z[i] + g1 * z[i + 1] + g2 * z[i + 2] + gcb;
                        vo[i] = (_Float16)((acc[ct][4 * g + i] * (1.f / FSCALE) + (float)vin[i] * fbv) * gate); }
                    *vp = vo;
                }
        }
    }
    __syncthreads();
    for (int idx = tid; idx < NBu * L; idx += 512) {
        const int b2 = idx / L, t = idx % L; h8 o;
#pragma unroll
        for (int ww = 0; ww < 8; ++ww) o[ww] = *(const CV_LAS _Float16*)(lds + ww * WAVE_LDS + V_OFF + b2 * PV + t * 2);
        *(h8*)(P.V2 + ((size_t)c * 12288 + row_base + b2 * L + t) * 8) = o;
    }
    __syncthreads();
}
__device__ __forceinline__ void conv_phase(CV_LAS unsigned char* lds, const Args& P, int G, int bid) {
    for (int u = bid; u < 256; u += G) conv_unit<1>(lds, P, u >> 1, u & 1);
    for (int u = bid; u < 256; u += G) conv_unit<0>(lds, P, u >> 1, u & 1);
}
}
namespace s5 {
#define S5_LAS __attribute__((address_space(3)))
typedef _Float16 h8 __attribute__((ext_vector_type(8)));
typedef _Float16 h4 __attribute__((ext_vector_type(4)));
typedef _Float16 h2 __attribute__((ext_vector_type(2)));
typedef float f32x16 __attribute__((ext_vector_type(16)));
typedef float f32x4 __attribute__((ext_vector_type(4)));
constexpr int IMG_PITCH = 288, WAVE_LDS = 32 * IMG_PITCH;
constexpr int TT = 12288;
struct Args { const _Float16* UP; const float* ssq; const float* MOD; const float* PW; const _Float16* BB;
              const float* C_re; const float* C_im; const float* Dv; const float* state_in; float* YB; _Float16* Y2; float* new_state; };
__device__ __forceinline__ float gelu_fast(float x) { const float u = 1.5957691216057308f * (x + 0.044715f * x * x * x); return x / (1.f + __expf(-u)); }
__device__ __forceinline__ void s5_table(int ix, const float* A_re, const float* A_im, const float* log_dt, const float* B_re, const float* B_im, float* PW, _Float16* BB) {
    const double are = A_re[ix], aim = A_im[ix], dt = exp((double)log_dt[ix >> 6]);
    const double mag = exp(dt * are), ph = dt * aim, abr = mag * cos(ph), abi = mag * sin(ph);
    const double nr = abr - 1.0, ni = abi, den = are * are + aim * aim, cor = (nr * are + ni * aim) / den, coi = (ni * are - nr * aim) / den;
    double pr = abr, pi = abi;
    for (int k = 0; k < 4; ++k) { PW[(size_t)ix * 8 + 2 * k] = (float)pr; PW[(size_t)ix * 8 + 2 * k + 1] = (float)pi; const double tr = pr * abr - pi * abi; pi = pr * abi + pi * abr; pr = tr; }
    for (int h = 0; h < 16; ++h) { const double br = B_re[(size_t)ix * 16 + h], bi = B_im[(size_t)ix * 16 + h];
        BB[(size_t)ix * 32 + h] = (_Float16)(float)(cor * br - coi * bi); BB[(size_t)ix * 32 + 16 + h] = (_Float16)(float)(cor * bi + coi * br); }
}
__device__ __forceinline__ void s5_task(S5_LAS unsigned char* img, volatile S5_LAS int* myflag, volatile S5_LAS int* pflag, int epoch, const Args& P, int seq, int g, int dir) {
    const int lane = threadIdx.x & 63, n = lane & 31, hi = lane >> 5, tq = lane & 15, q4 = lane >> 4;
    const bool ctx = seq < 16;
    const int L = ctx ? 256 : 1024, base = ctx ? seq * 256 : 4096 + (seq - 16) * 1024, ci = ctx ? 0 : 1 + (seq - 16), NT = L / 32;
    const float* mod = P.MOD + (ci * 2 + 1) * 6144;
    float shA[8], shO[4], dvO[4];
#pragma unroll
    for (int j = 0; j < 8; ++j) shA[j] = mod[16 * g + 8 * hi + j];
#pragma unroll
    for (int j = 0; j < 4; ++j) { shO[j] = mod[16 * g + 4 * q4 + j]; dvO[j] = P.Dv[16 * g + 4 * q4 + j]; }
    const _Float16* up = P.UP + (size_t)g * TT * 16;
    float* yb = P.YB + (size_t)g * TT * 16;
    float pw[2][4][2]; h8 Bf[2][2]; float cr[2], cim[2];
#pragma unroll
    for (int half = 0; half < 2; ++half) {
        const int p = n + 32 * half, ix = (dir * 64 + g) * 64 + p;
        const f32x4 q0 = *(const f32x4*)(P.PW + (size_t)ix * 8), q1 = *(const f32x4*)(P.PW + (size_t)ix * 8 + 4);
        pw[half][0][0] = q0[0]; pw[half][0][1] = q0[1]; pw[half][1][0] = q0[2]; pw[half][1][1] = q0[3]; pw[half][2][0] = q1[0]; pw[half][2][1] = q1[1]; pw[half][3][0] = q1[2]; pw[half][3][1] = q1[3];
        Bf[half][0] = *(const h8*)(P.BB + (size_t)ix * 32 + 8 * hi); Bf[half][1] = *(const h8*)(P.BB + (size_t)ix * 32 + 16 + 8 * hi);
        if (ctx) { cr[half] = 0.f; cim[half] = 0.f; }
        else { const int b = seq - 16; cr[half] = P.state_in[((b * 2 + dir) * 2 + 0) * 4096 + g * 64 + p]; cim[half] = P.state_in[((b * 2 + dir) * 2 + 1) * 4096 + g * 64 + p]; }
    }
    h8 Cf[4];
#pragma unroll
    for (int kk = 0; kk < 4; ++kk)
#pragma unroll
        for (int j = 0; j < 8; ++j) { const int k = 32 * kk + 8 * q4 + j, p = k >> 1; const size_t cx = ((size_t)(dir * 64 + g) * 16 + tq) * 64 + p;
            Cf[kk][j] = (_Float16)((k & 1) ? -P.C_im[cx] : P.C_re[cx]); }
    int rowA = base + (dir ? L - 1 - n : n);
    h8 ur = *(const h8*)(up + (size_t)rowA * 16 + 8 * hi); float sqA = P.ssq[rowA];
#pragma unroll 1
    for (int jt = 0; jt < NT; ++jt) {
        const bool second = jt >= NT / 2;
        if (jt == NT / 2) {
            asm volatile("s_waitcnt vmcnt(0)" ::: "memory");
            if (lane == 0) *myflag = epoch;
            while (*pflag < epoch) __builtin_amdgcn_s_sleep(8);
            asm volatile("" ::: "memory");
        }
        int rowO[2];
#pragma unroll
        for (int nt = 0; nt < 2; ++nt) { const int s = 32 * jt + tq + 16 * nt; rowO[nt] = base + (dir ? L - 1 - s : s); }
        const float rsA = 1.0f / sqrtf(sqA * (1.f / 1024.f) + 1e-6f);
        h8 Au;
#pragma unroll
        for (int j = 0; j < 8; ++j) Au[j] = (_Float16)(rsA * (float)ur[j] + shA[j]);
        if (jt + 1 < NT) { const int s = 32 * (jt + 1) + n; rowA = base + (dir ? L - 1 - s : s); ur = *(const h8*)(up + (size_t)rowA * 16 + 8 * hi); sqA = P.ssq[rowA]; }
        const f32x16 zero = {0.f, 0.f, 0.f, 0.f, 0.f, 0.f, 0.f, 0.f, 0.f, 0.f, 0.f, 0.f, 0.f, 0.f, 0.f, 0.f};
#pragma unroll
        for (int half = 0; half < 2; ++half) {
            f32x16 xr = __builtin_amdgcn_mfma_f32_32x32x16_f16(Au, Bf[half][0], zero, 0, 0, 0);
            f32x16 xi = __builtin_amdgcn_mfma_f32_32x32x16_f16(Au, Bf[half][1], zero, 0, 0, 0);
            const float a1r = pw[half][0][0], a1i = pw[half][0][1], a4r = pw[half][3][0], a4i = pw[half][3][1];
#pragma unroll
            for (int q = 0; q < 4; ++q)
#pragma unroll
                for (int j = 1; j < 4; ++j) { const int r = 4 * q + j; const float pr = xr[r - 1], pi = xi[r - 1];
                    xr[r] = a1r * pr - a1i * pi + xr[r]; xi[r] = a1r * pi + a1i * pr + xi[r]; }
            float er[4], ei[4], per[4], pei[4];
#pragma unroll
            for (int q = 0; q < 4; ++q) { er[q] = xr[4 * q + 3]; ei[q] = xi[4 * q + 3]; per[q] = __shfl_xor(er[q], 32); pei[q] = __shfl_xor(ei[q], 32); }
            float sr = cr[half], si = cim[half], inr[4], ini[4];
#pragma unroll
            for (int i = 0; i < 8; ++i) { const int q = i >> 1; const bool own = ((i & 1) == hi);
                if ((i & 1) == 0) { inr[q] = sr; ini[q] = si; } else { inr[q] = hi ? sr : inr[q]; ini[q] = hi ? si : ini[q]; }
                const float evr = own ? er[q] : per[q], evi = own ? ei[q] : pei[q];
                const float tr = a4r * sr - a4i * si + evr; si = a4r * si + a4i * sr + evi; sr = tr; }
            cr[half] = sr; cim[half] = si;
#pragma unroll
            for (int q = 0; q < 4; ++q)
#pragma unroll
                for (int j = 0; j < 4; ++j) { const int r = 4 * q + j; const float hr = xr[r] + pw[half][j][0] * inr[q] - pw[half][j][1] * ini[q], hm = xi[r] + pw[half][j][0] * ini[q] + pw[half][j][1] * inr[q];
                    const int tau = (r & 3) + 8 * (r >> 2) + 4 * hi; h2 v; v.x = (_Float16)hr; v.y = (_Float16)hm;
                    *(S5_LAS h2*)(img + tau * IMG_PITCH + (n + 32 * half) * 4) = v; }
        }
        f32x4 ybv[2]; h4 u4[2]; float sqO[2];
        if (second) {
#pragma unroll
            for (int nt = 0; nt < 2; ++nt) { ybv[nt] = *(const f32x4*)(yb + (size_t)rowO[nt] * 16 + 4 * q4); u4[nt] = *(const h4*)(up + (size_t)rowO[nt] * 16 + 4 * q4); sqO[nt] = P.ssq[rowO[nt]]; }
        }
#pragma unroll
        for (int nt = 0; nt < 2; ++nt) {
            f32x4 acc = {0.f, 0.f, 0.f, 0.f};
#pragma unroll
            for (int kk = 0; kk < 4; ++kk) { const h8 hb = *(const S5_LAS h8*)(img + (tq + 16 * nt) * IMG_PITCH + (32 * kk + 8 * q4) * 2);
                acc = __builtin_amdgcn_mfma_f32_16x16x32_f16(Cf[kk], hb, acc, 0, 0, 0); }
            if (!second) *(f32x4*)(yb + (size_t)rowO[nt] * 16 + 4 * q4) = acc;
            else {
                const float rs = 1.0f / sqrtf(sqO[nt] * (1.f / 1024.f) + 1e-6f);
                h4 o;
#pragma unroll
                for (int j = 0; j < 4; ++j) { const float u = rs * (float)u4[nt][j] + shO[j]; o[j] = (_Float16)gelu_fast(u * dvO[j] + acc[j] + ybv[nt][j]); }
                *(h4*)(P.Y2 + ((size_t)(2 * g + (q4 >> 1)) * TT + rowO[nt]) * 8 + 4 * (q4 & 1)) = o;
            }
        }
    }
    if (ctx && hi == 0) {
#pragma unroll
        for (int half = 0; half < 2; ++half) { const int p = n + 32 * half;
            P.new_state[((seq * 2 + dir) * 2 + 0) * 4096 + g * 64 + p] = cr[half]; P.new_state[((seq * 2 + dir) * 2 + 1) * 4096 + g * 64 + p] = cim[half]; }
    }
}
__device__ __forceinline__ void s5_phase(S5_LAS unsigned char* lds, volatile S5_LAS int* flags, const Args& P, int G, int bid) {
    const int w = __builtin_amdgcn_readfirstlane(threadIdx.x >> 6), dir = w & 1;
    S5_LAS unsigned char* img = lds + w * WAVE_LDS;
    int epoch = 0;
    for (int b = bid; b < 256; b += G) {
        if (w < 4) { const int lu = 2 * b + (w >> 1); ++epoch; s5_task(img, flags + w, flags + (w ^ 1), epoch, P, 16 + (lu >> 6), lu & 63, dir); }
        else for (int r = 0; r < 2; ++r) { const int cu = 4 * b + 2 * r + ((w - 4) >> 1); ++epoch; s5_task(img, flags + w, flags + (w ^ 1), epoch, P, cu >> 6, cu & 63, dir); }
    }
}
}
#define LAS __attribute__((address_space(3)))
#define XB_TMO      128
#define XB_XCNT(j)  (256  + 64 * (j))
#define XB_XSUB(j)  (1280 + 64 * (j))
#define XB_XGEN(j)  (2304 + 64 * (j))
#define XB_TOP      3328
#define XB_TOPGEN   3392
#define XCD_BAR_WORDS 3456
#define XB_SPIN_CAP (1u << 18)
__device__ __forceinline__ unsigned xb_ld(unsigned* p)              { return __hip_atomic_load(p, __ATOMIC_RELAXED, __HIP_MEMORY_SCOPE_AGENT); }
__device__ __forceinline__ unsigned xb_add(unsigned* p, unsigned v) { return __hip_atomic_fetch_add(p, v, __ATOMIC_RELAXED, __HIP_MEMORY_SCOPE_AGENT); }
__device__ __forceinline__ unsigned xb_xcc_id() { return (unsigned)__builtin_amdgcn_s_getreg((3 << 11) | 20) & 0xFu; }
#define XB_SPIN(cond, bar) do { unsigned _sp = 0; while (cond) { __builtin_amdgcn_s_sleep(1); \
    if ((++_sp & 255u) == 0u) { if (xb_ld(&(bar)[XB_TMO])) break; if (_sp > XB_SPIN_CAP) { atomicAdd(&(bar)[XB_TMO], 1u); break; } } } } while (0)
struct XcdBarrier { unsigned* bar; unsigned x; volatile LAS unsigned* st; };
__device__ __forceinline__ XcdBarrier xcd_barrier_post(unsigned* bar, volatile LAS unsigned* st) {
    XcdBarrier b; b.bar = bar; b.x = xb_xcc_id(); b.st = st;
    if (threadIdx.x == 0) (void)xb_add(&bar[XB_XCNT(b.x)], 1u);
    return b;
}
__device__ __forceinline__ void xcd_barrier_complete(unsigned* bar, unsigned x, unsigned& nloc, unsigned& nx) {
    const unsigned G = gridDim.x * gridDim.y * gridDim.z;
    unsigned sum, cnt, mine, sp = 0u;
    for (;;) {
        sum = 0u; cnt = 0u; mine = 0u;
#pragma unroll
        for (unsigned j = 0; j < 16; ++j) { const unsigned c = xb_ld(&bar[XB_XCNT(j)]); sum += c; cnt += (c > 0u) ? 1u : 0u; mine = (j == x) ? c : mine; }
        if (sum == G) break;
        __builtin_amdgcn_s_sleep(1);
        if ((++sp & 255u) == 0u) { if (xb_ld(&bar[XB_TMO])) break; if (sp > XB_SPIN_CAP) { atomicAdd(&bar[XB_TMO], 1u); break; } }
    }
    nloc = mine > 0u ? mine : 1u; nx = cnt > 0u ? cnt : 1u;
}
__device__ __forceinline__ void xcd_barrier(const XcdBarrier& b) {
    asm volatile("s_waitcnt vmcnt(0)" ::: "memory");
    __syncthreads();
    if (threadIdx.x == 0) {
        unsigned* bar = b.bar;
        __builtin_amdgcn_s_waitcnt(0);
        unsigned nloc = b.st[0], nx = b.st[1];
        if (nloc == 0u) { xcd_barrier_complete(bar, b.x, nloc, nx); b.st[0] = nloc; b.st[1] = nx; }
        const unsigned old = xb_add(&bar[XB_XSUB(b.x)], 1u);
        const unsigned gen = old / nloc;
        if (old + 1u == (gen + 1u) * nloc) {
            __builtin_amdgcn_fence(__ATOMIC_RELEASE, "agent");
            asm volatile("s_waitcnt vmcnt(0)" ::: "memory");
            const unsigned og = xb_add(&bar[XB_TOP], 1u);
            const unsigned tg = og / nx;
            if (og + 1u == (tg + 1u) * nx) xb_add(&bar[XB_TOPGEN], 1u);
            else XB_SPIN(xb_ld(&bar[XB_TOPGEN]) == tg, bar);
            __builtin_amdgcn_fence(__ATOMIC_ACQUIRE, "agent");
            xb_add(&bar[XB_XGEN(b.x)], 1u);
            asm volatile("s_waitcnt vmcnt(0)" ::: "memory");
        } else {
            XB_SPIN(xb_ld(&bar[XB_XGEN(b.x)]) == gen, bar);
            __builtin_amdgcn_fence(__ATOMIC_ACQUIRE, "agent");
            asm volatile("s_waitcnt vmcnt(0)" ::: "memory");
        }
    }
    __syncthreads();
}

struct EpiZT { f16h* zT; const float* bias;
    __device__ __forceinline__ void operator()(const g8::f32x4 (&acc)[2][2][4][2], const g8::Unit& u, int wr, int wc, int fr, int fq) const {
        const int row0 = u.pm * 256 + wr * 64 + fr, col0 = u.pn * 256 + wc * 32 + 4 * fq;
#pragma unroll
        for (int ai = 0; ai < 2; ++ai)
#pragma unroll
            for (int m = 0; m < 4; ++m) { const int row = row0 + ai * 128 + m * 16; const float bv = bias[row];
#pragma unroll
                for (int bj = 0; bj < 2; ++bj)
#pragma unroll
                    for (int n = 0; n < 2; ++n) { const g8::f32x4 a = acc[ai][bj][m][n]; g8::u32x2 w; w.x = pkh(a[0] + bv, a[1] + bv); w.y = pkh(a[2] + bv, a[3] + bv);
                        *(g8::u32x2*)(zT + (size_t)row * 12288 + col0 + bj * 128 + n * 16) = w; } }
    } };
struct ResOut { float* X; const float* Xr; f16h* XA; const float* ng; float* ssq; const float* xp; const float* xs; const float* post; int xa_mode; int pad; };
template <bool XIN, class GV> __device__ __forceinline__ void res_group(const ResOut& R, const float* gate, const float* sc, int row0, int c, GV getval, float (&sq)[8]) {
    constexpr int NB = 8;
    const g8::f32x4 gv = *(const g8::f32x4*)(gate + c);
    g8::f32x4 gm = {0.f, 0.f, 0.f, 0.f};
    if (R.XA) { const g8::f32x4 ng = *(const g8::f32x4*)(R.ng + c), s = *(const g8::f32x4*)(sc + c); gm = ng * (s + 1.f); }
    unsigned o0 = (unsigned)row0 * 1024u + (unsigned)c;
    asm volatile("" : "+v"(o0));
    const bool lat = XIN && row0 >= NCTX;
#pragma unroll
    for (int b0 = 0; b0 < 8; b0 += NB) {
        g8::f32x4 x[NB];
#pragma unroll
        for (int k = 0; k < NB; ++k) { const int i = b0 + k; const unsigned o = o0 + (unsigned)(((i >> 2) * 128 + (i & 3) * 16) * 1024);
            if (XIN) x[k] = lat ? *(const g8::f32x4*)(R.xs + (o - (unsigned)NCTX * 1024u)) : *(const g8::f32x4*)(R.xp + o);
            else x[k] = *(const g8::f32x4*)(R.Xr + o); }
#pragma unroll
        for (int k = 0; k < NB; ++k) { const int i = b0 + k, row = row0 + (i >> 2) * 128 + (i & 3) * 16; const unsigned o = o0 + (unsigned)(((i >> 2) * 128 + (i & 3) * 16) * 1024); g8::f32x4 xv = x[k];
            if (lat) { const int t = (row - NCTX) & 1023; xv += *(const g8::f32x4*)(c < 512 ? R.post + (t >> 6) * 512 + c : R.post + 16 * 512 + (t & 63) * 512 + (c - 512)); }
            xv += gv * getval(i); *(g8::f32x4*)(R.X + o) = xv;
            sq[i] += (xv[0] * xv[0] + xv[1] * xv[1]) + (xv[2] * xv[2] + xv[3] * xv[3]);
            if (R.XA) { g8::u32x2 w; w.x = pkh(xv[0] * gm[0], xv[1] * gm[1]); w.y = pkh(xv[2] * gm[2], xv[3] * gm[3]);
                f16h* q = R.xa_mode == 0 ? R.XA + o : R.XA + ((size_t)(c >> 4) * T + row) * 16 + (c & 15);
                *(g8::u32x2*)q = w; } }
    }
}
__device__ __forceinline__ void res_ssq(const ResOut& R, int row0, int fq, float (&sq)[8]) {
    if (!R.ssq) return;
    float olds[8];
#pragma unroll
    for (int i = 0; i < 8; ++i) { float v = sq[i]; v += __shfl_xor(v, 16); v += __shfl_xor(v, 32); olds[i] = 0.f; if (fq == 0) olds[i] = atomicAdd(R.ssq + row0 + (i >> 2) * 128 + (i & 3) * 16, v); }
    asm volatile("" :: "v"(olds[0]), "v"(olds[1]), "v"(olds[2]), "v"(olds[3]), "v"(olds[4]), "v"(olds[5]), "v"(olds[6]), "v"(olds[7]));
}
template <bool XIN> struct EpiRes2 { ResOut R; const float* bias; const float* MOD; int gateoff, scoff;
    __device__ __forceinline__ void operator()(const g8::f32x4 (&acc)[2][2][4][2], const g8::Unit& u, int wr, int wc, int fr, int fq) const {
        const int row0 = u.pm * 256 + wr * 64 + fr, col0 = u.pn * 256 + wc * 32 + 4 * fq;
        const float* mb = MOD + (row_ci(u.pm * 256) * 2) * 6144; const float* gate = mb + gateoff; const float* sc = mb + scoff;
        float sq[8] = {0.f, 0.f, 0.f, 0.f, 0.f, 0.f, 0.f, 0.f};
#pragma unroll
        for (int bj = 0; bj < 2; ++bj)
#pragma unroll
            for (int n = 0; n < 2; ++n) { const int c = col0 + bj * 128 + n * 16; g8::f32x4 bv = {0.f, 0.f, 0.f, 0.f}; if (bias) bv = *(const g8::f32x4*)(bias + c);
                res_group<XIN>(R, gate, sc, row0, c, [&](int i) { return acc[i >> 2][bj][i & 3][n] + bv; }, sq); }
        res_ssq(R, row0, fq, sq);
    } };
struct EpiGlu2 { ResOut R; const float* bias; const float* MOD; int gateoff, scoff;
    __device__ __forceinline__ void operator()(const g8::f32x4 (&acc)[2][2][4][2], const g8::Unit& u, int wr, int wc, int fr, int fq) const {
        const int row0 = u.pm * 256 + wr * 64 + fr, col0 = u.pn * 128 + wc * 32 + 4 * fq;
        const float* mb = MOD + (row_ci(u.pm * 256) * 2) * 6144; const float* gate = mb + gateoff; const float* sc = mb + scoff;
        float sq[8] = {0.f, 0.f, 0.f, 0.f, 0.f, 0.f, 0.f, 0.f};
#pragma unroll
        for (int n = 0; n < 2; ++n) { const int c = col0 + n * 16; const g8::f32x4 ba = *(const g8::f32x4*)(bias + c), bg = *(const g8::f32x4*)(bias + 1024 + c);
            res_group<false>(R, gate, sc, row0, c, [&](int i) { const g8::f32x4 a = acc[i >> 2][0][i & 3][n] + ba, g = acc[i >> 2][1][i & 3][n] + bg; g8::f32x4 v;
#pragma unroll
                for (int j = 0; j < 4; ++j) v[j] = a[j] * sigmf(g[j]);
                return v; }, sq); }
        res_ssq(R, row0, fq, sq);
    } };
struct EpiSwiglu2 { f16h* hid; const float* ssq; const float* bias2;
    __device__ __forceinline__ void operator()(const g8::f32x4 (&acc)[2][2][4][2], const g8::Unit& u, int wr, int wc, int fr, int fq) const {
        const int row0 = u.pm * 256 + wr * 64 + fr, col0 = u.pn * 128 + wc * 32 + 4 * fq;
        const float* b2 = bias2 + row_ci(u.pm * 256) * 5632;
#pragma unroll
        for (int n = 0; n < 2; ++n) { const g8::f32x4 ba = *(const g8::f32x4*)(b2 + col0 + n * 16), bb = *(const g8::f32x4*)(b2 + 2816 + col0 + n * 16);
#pragma unroll
            for (int ai = 0; ai < 2; ++ai)
#pragma unroll
                for (int m = 0; m < 4; ++m) { const int row = row0 + ai * 128 + m * 16; const float rstd = 1.0f / sqrtf(ssq[row] * (1.f / 1024.f) + 1e-6f);
                    const g8::f32x4 a = acc[ai][0][m][n] * rstd + ba, b = acc[ai][1][m][n] * rstd + bb; g8::u32x2 w;
                    w.x = pkh(siluf(a[0]) * b[0], siluf(a[1]) * b[1]); w.y = pkh(siluf(a[2]) * b[2], siluf(a[3]) * b[3]);
                    *(g8::u32x2*)(hid + (size_t)row * 2816 + col0 + n * 16) = w; } }
    } };

typedef const __attribute__((address_space(4))) Params* KP;
struct Frame { LAS unsigned char* lds; int tid, lane, wave, G, bid; };
__device__ __forceinline__ float wave_sum(float v) {
#pragma unroll
    for (int o = 1; o < 64; o <<= 1) v += __shfl_xor(v, o);
    return v;
}
__device__ __forceinline__ void transpose_item(const float* W, int K, int N, f16h* WT, LAS float* scr, int item, int lane) {
    const int nblk = N / 32, kb = item / nblk, nb = item % nblk, k0 = 64 * kb, n0 = 32 * nb;
#pragma unroll 8
    for (int i = 0; i < 32; ++i) { const int kk = 2 * i + (lane >> 5); scr[kk * 33 + (lane & 31)] = W[(size_t)(k0 + kk) * N + n0 + (lane & 31)]; }
    asm volatile("s_waitcnt lgkmcnt(0)" ::: "memory");
    const int c = lane & 7;
#pragma unroll
    for (int j = 0; j < 4; ++j) { const int n = (lane >> 3) + 8 * j; const LAS float* s = scr + (8 * c) * 33 + n;
        g8::u32x4 o; o.x = pkh(s[0 * 33], s[1 * 33]); o.y = pkh(s[2 * 33], s[3 * 33]); o.z = pkh(s[4 * 33], s[5 * 33]); o.w = pkh(s[6 * 33], s[7 * 33]);
        *(g8::u32x4*)(WT + (size_t)(n0 + n) * K + k0 + 8 * c) = o; }
    asm volatile("s_waitcnt lgkmcnt(0)" ::: "memory");
}
__device__ __forceinline__ void gemv9_item(const float* W, int ldw, int col0, int kc, const LAS float* tab, float* out, int ostride, const float* bias, int lane) {
    const int col = col0 + lane; float acc[9];
#pragma unroll
    for (int ci = 0; ci < 9; ++ci) acc[ci] = 0.f;
    const float* w = W + (size_t)(kc * 64) * ldw + col;
#pragma unroll 1
    for (int c = 0; c < 4; ++c) {
        float wv[16];
#pragma unroll
        for (int k = 0; k < 16; ++k) wv[k] = w[(size_t)(16 * c + k) * ldw];
#pragma unroll
        for (int k4 = 0; k4 < 4; ++k4)
#pragma unroll
            for (int ci = 0; ci < 9; ++ci) { const g8::f32x4 s = *(const LAS g8::f32x4*)(tab + ci * 1024 + kc * 64 + 16 * c + 4 * k4); acc[ci] += s[0] * wv[4 * k4] + s[1] * wv[4 * k4 + 1] + s[2] * wv[4 * k4 + 2] + s[3] * wv[4 * k4 + 3]; }
    }
    float olds[9];
#pragma unroll
    for (int ci = 0; ci < 9; ++ci) olds[ci] = atomicAdd(out + (size_t)ci * ostride + col, acc[ci] + ((bias && kc == 0) ? bias[col] : 0.f));
    asm volatile("" :: "v"(olds[0]), "v"(olds[1]), "v"(olds[2]), "v"(olds[3]), "v"(olds[4]), "v"(olds[5]), "v"(olds[6]), "v"(olds[7]), "v"(olds[8]));
}
__device__ __forceinline__ void filt_item(const float* H2, const float* w3, float* NORM, f16h* FILT, int lv, int o, int mr, int d0, int lane, bool pass2, LAS float* hs) {
    const int L = lv ? 1024 : 256, d = d0 + lane, m0 = 32 * mr, dir = m0 >= L ? 1 : 0;
    const int extra = (!pass2 && m0 == L) ? 1 : 0;
    const int ilo = dir ? (m0 - (L - 1)) - extra : (L - 32 - m0);
    const float* h2 = H2 + (lv ? 256 : 0) * 64;
    for (int r = 0; r < 32 + extra; ++r) { const int i = ilo + r; hs[r * 64 + lane] = i < L ? h2[i * 64 + lane] : 0.f; }
    float w[64];
#pragma unroll
    for (int m = 0; m < 64; ++m) w[m] = w3[m * 4096 + o * 2048 + dir * 1024 + d];
    const double maxd = log(1e-2) / 0.3, mind = log(1e-2) / 1.5;
    const float delta = fabsf((float)(mind + (double)d * (maxd - mind) / 1023.0));
    const float tstep = (float)(1.0 / (double)(L - 1));
    float inv = 0.f; if (pass2) inv = cv::FSCALE / (NORM[(lv * 2 + o) * 1024 + d] + 1e-6f);
    float sabs = 0.f; f16h taps[32];
    asm volatile("s_waitcnt lgkmcnt(0)" ::: "memory");
#pragma unroll 1
    for (int mm = -extra; mm < 32; ++mm) {
        const int m = m0 + mm, j = (L - 1) - m, i = j < 0 ? -j : j;
        const LAS g8::f32x4* hr = (const LAS g8::f32x4*)(hs + (i - ilo) * 64);
        float a = 0.f;
#pragma unroll
        for (int q = 0; q < 16; ++q) { const g8::f32x4 h = hr[q]; a += h[0] * w[4 * q] + h[1] * w[4 * q + 1] + h[2] * w[4 * q + 2] + h[3] * w[4 * q + 3]; }
        a = i < L ? a * __expf(-(float)i * tstep * delta) : 0.f;
        sabs += fabsf(a);
        if (mm >= 0) {
#pragma unroll
            for (int q = 0; q < 32; ++q) if (q == mm) taps[q] = (f16h)(a * inv);
        }
    }
    if (!pass2) atomic_add_done(&NORM[(lv * 2 + o) * 1024 + d], sabs);
    else {
        f16h* dst = FILT + (lv ? (size_t)2 * 1024 * 512 + (size_t)(o * 1024 + d) * 2048 : (size_t)(o * 1024 + d) * 512) + m0;
#pragma unroll
        for (int q = 0; q < 4; ++q) { cv::h8 v;
#pragma unroll
            for (int e = 0; e < 8; ++e) v[e] = taps[8 * q + e];
            *(cv::h8*)(dst + 8 * q) = v; }
    }
    asm volatile("s_waitcnt lgkmcnt(0)" ::: "memory");
}
__device__ __forceinline__ void filt_items(Frame& F, KP P, int first_block, int nblocks, bool pass2) {
    const float* H2 = (const float*)(P->ws + WS_H2); float* NORM = (float*)(P->ws + WS_NORM); f16h* FILT = (f16h*)(P->ws + WS_FILT);
    if (F.bid < first_block) return;
    const int gw = (F.bid - first_block) * 8 + F.wave, NGW = nblocks * 8;
    for (int it = gw; it < 2560; it += NGW) {
        int lv, r = it; if (r < 512) lv = 0; else { lv = 1; r -= 512; }
        const int nr = lv ? 64 : 16, db = r & 15, mr = (r >> 4) % nr, o = (r >> 4) / nr;
        filt_item(H2, P->in[20], NORM, FILT, lv, o, mr, db * 64, F.lane, pass2, (LAS float*)(F.lds + F.wave * 8704));
    }
}
__device__ __forceinline__ void phase0(Frame& F, KP P, bool domods) {
    LAS float* tab = (LAS float*)F.lds;
    LAS float* scr = (LAS float*)(F.lds + 36864 + F.wave * 8448);
    for (int i = F.tid; i < 9 * 1024; i += 512) { const int ci = i >> 10, k = i & 1023; const float v = ci == 0 ? P->in[4][k] : P->in[3][(ci - 1) * 1024 + k]; tab[i] = v / (1.f + expf(-v)); }
    __syncthreads();
    const int gw = F.bid * 8 + F.wave, NGW = F.G * 8;
    float* MOD = (float*)(P->ws + WS_MOD);
    if (domods) for (int it = gw; it < 3072; it += NGW) { const int kq = it & 15, cb = (it >> 4) % 96, l = (it >> 4) / 96;
        gemv9_item(P->in[8] + (size_t)l * 1024 * 6144, 6144, cb * 64, kq, tab, MOD + l * 6144, 2 * 6144, P->in[9] + l * 6144, F.lane); }
    for (int pos = gw; pos < 1280; pos += NGW) {
        const int L = pos < 256 ? 256 : 1024, i = pos < 256 ? pos : pos - 256, lane = F.lane;
        if (lane < 33) { float z;
            if (lane == 0) z = (float)((double)i / (double)(L - 1));
            else { const int m = (lane - 1) & 15; const double band = 1e-4 + (double)m * ((15.0 - 1e-4) / 15.0), w = 2.0 * 3.14159265358979323846 * (double)i / (double)L;
                z = lane <= 16 ? (float)cos(band * w) : (float)(-sin(band * w)); }
            scr[lane] = z; }
        asm volatile("s_waitcnt lgkmcnt(0)" ::: "memory");
        float a = P->in[17][lane];
        for (int k = 0; k < 33; ++k) a += scr[k] * P->in[16][k * 64 + lane];
        scr[64 + lane] = sinf(P->in[21][lane] * a);
        asm volatile("s_waitcnt lgkmcnt(0)" ::: "memory");
        float a2 = P->in[19][lane];
        for (int k = 0; k < 64; ++k) a2 += scr[64 + k] * P->in[18][k * 64 + lane];
        ((float*)(P->ws + WS_H2))[pos * 64 + lane] = sinf(P->in[21][lane] * a2);
        asm volatile("s_waitcnt lgkmcnt(0)" ::: "memory");
    }
    { float* post = (float*)(P->ws + WS_POST);
      for (int i = F.bid * 512 + F.tid; i < 80 * 512; i += F.G * 512) { const int n = i >> 9, d = i & 511, nn = n < 16 ? n : n - 16;
          const double om = exp(-log(10000.0) * (double)(d & 255) / 256.0), ang = (double)nn * om; post[i] = (float)(d < 256 ? sin(ang) : cos(ang)); } }
    for (int ix = F.bid * 512 + F.tid; ix < 8192; ix += F.G * 512) s5::s5_table(ix, P->in[25], P->in[26], P->in[27], P->in[28], P->in[29], (float*)(P->ws + WS_S5PW), (f16h*)(P->ws + WS_S5BB));
    { constexpr int I_IN = 16 * 96, I_OUT = 16 * 32, NIT = I_IN + I_OUT;
      for (int it = gw; it < NIT; it += NGW) { int r = it;
          if (r < I_IN) { transpose_item(P->in[12], 1024, 3072, (f16h*)(P->ws + WS_WIN), scr, r, F.lane); continue; } r -= I_IN;
          transpose_item(P->in[23], 1024, 1024, (f16h*)(P->ws + WS_WOUT), scr, r, F.lane); } }
}
__device__ __forceinline__ void convert_items(Frame& F, KP P, int first, int set) {
    if (F.bid < first) return;
    LAS float* scr = (LAS float*)(F.lds + F.wave * 8448);
    const int gw = (F.bid - first) * 8 + F.wave, NGW = (F.G - first) * 8;
    constexpr int I_13 = 16 * 176, I_2 = 44 * 32, I_GLU = 16 * 64;
    const int l = set;
    const int NIT = I_13 + I_2 + (set ? I_GLU : 0);
    for (int it = gw; it < NIT; it += NGW) { int r = it;
        if (r < I_13) { transpose_item(P->in[10] + (size_t)l * 1024 * 5632, 1024, 5632, (f16h*)(P->ws + WS_W13) + (size_t)l * 5632 * 1024, scr, r, F.lane); continue; } r -= I_13;
        if (r < I_2) { transpose_item(P->in[11] + (size_t)l * 2816 * 1024, 2816, 1024, (f16h*)(P->ws + WS_W2) + (size_t)l * 1024 * 2816, scr, r, F.lane); continue; } r -= I_2;
        transpose_item(P->in[33], 1024, 2048, (f16h*)(P->ws + WS_WGLU), scr, r, F.lane); }
}
__device__ __forceinline__ void phase1(Frame& F, KP P) {
    const float* MOD = (const float*)(P->ws + WS_MOD);
    const int gw = F.bid * 8 + F.wave, NGW = F.G * 8;
    { f16h* XA = (f16h*)(P->ws + WS_XA); const float* post = (const float*)(P->ws + WS_POST); const float* ng = P->in[5];
      for (int row = gw; row < T; row += NGW) {
          const float* mb = MOD + (row_ci(row) * 2) * 6144; g8::f32x4 v[4]; float s = 0.f;
#pragma unroll
          for (int j = 0; j < 4; ++j) { const int c = 4 * F.lane + 256 * j;
              if (row < NCTX) v[j] = *(const g8::f32x4*)(P->in[0] + (size_t)row * 1024 + c);
              else { const int r = row - NCTX, t = r & 1023; v[j] = *(const g8::f32x4*)(P->in[1] + (size_t)r * 1024 + c);
                  v[j] += *(const g8::f32x4*)(c < 512 ? post + (t >> 6) * 512 + c : post + 16 * 512 + (t & 63) * 512 + (c - 512)); }
              s += (v[j][0] * v[j][0] + v[j][1] * v[j][1]) + (v[j][2] * v[j][2] + v[j][3] * v[j][3]); }
          const float rstd = 1.0f / sqrtf(wave_sum(s) * (1.f / 1024.f) + 1e-6f);
#pragma unroll
          for (int j = 0; j < 4; ++j) { const int c = 4 * F.lane + 256 * j; const g8::f32x4 g = *(const g8::f32x4*)(ng + c), sh = *(const g8::f32x4*)(mb + c), sc = *(const g8::f32x4*)(mb + 1024 + c);
              g8::u32x2 w; w.x = pkh(v[j][0] * rstd * g[0] * (1.f + sc[0]) + sh[0], v[j][1] * rstd * g[1] * (1.f + sc[1]) + sh[1]);
              w.y = pkh(v[j][2] * rstd * g[2] * (1.f + sc[2]) + sh[2], v[j][3] * rstd * g[3] * (1.f + sc[3]) + sh[3]);
              *(g8::u32x2*)(XA + (size_t)row * 1024 + c) = w; } } }
    filt_items(F, P, 0, F.G, false);
}
__device__ __forceinline__ void bias2_items(Frame& F, KP P, int first) {
    if (F.bid < first) return;
    const float* MOD = (const float*)(P->ws + WS_MOD);
    LAS float* tab = (LAS float*)F.lds;
    for (int i = F.tid; i < 2 * 9 * 1024; i += 512) { const int l = i / 9216, r = i % 9216, ci = r >> 10, k = r & 1023; tab[i] = MOD[(ci * 2 + l) * 6144 + 3072 + k]; }
    __syncthreads();
    float* BIAS2 = (float*)(P->ws + WS_BIAS2);
    const int gw = (F.bid - first) * 8 + F.wave, NGW = (F.G - first) * 8;
    for (int it = gw; it < 2816; it += NGW) { const int kq = it & 15, cb = (it >> 4) % 88, l = (it >> 4) / 88;
        gemv9_item(P->in[10] + (size_t)l * 1024 * 5632, 5632, cb * 64, kq, tab + l * 9216, BIAS2 + (size_t)l * 9 * 5632, 5632, nullptr, F.lane); }
    __syncthreads();
}
__device__ __forceinline__ void phase_final(Frame& F, KP P) {
    const float* ssq = (const float*)(P->ws + WS_SSQ) + 3 * T; const float* fg = P->in[7];
    const int gw = F.bid * 8 + F.wave, NGW = F.G * 8;
    for (int row = gw; row < T; row += NGW) { const float rstd = 1.0f / sqrtf(ssq[row] * (1.f / 1024.f) + 1e-6f); float* x = P->out + (size_t)row * 1024;
#pragma unroll
        for (int j = 0; j < 4; ++j) { const int c = 4 * F.lane + 256 * j; g8::f32x4 v = *(g8::f32x4*)(x + c); const g8::f32x4 g = *(const g8::f32x4*)(fg + c);
            v[0] *= rstd * g[0]; v[1] *= rstd * g[1]; v[2] *= rstd * g[2]; v[3] *= rstd * g[3]; *(g8::f32x4*)(x + c) = v; } }
}

#define LAUNDER(p) asm volatile("" : "+s"(p))
__global__ void __launch_bounds__(512, 2) mk_fwd(Params prm_unused) {
    extern __shared__ __attribute__((aligned(16))) unsigned char lds_raw[];
    KP kp = (KP)__builtin_amdgcn_kernarg_segment_ptr();
    Frame F; F.lds = (LAS unsigned char*)lds_raw; F.tid = threadIdx.x; F.lane = F.tid & 63; F.wave = __builtin_amdgcn_readfirstlane(F.tid >> 6); F.G = gridDim.x; F.bid = blockIdx.x;
    volatile LAS unsigned* MISC = (volatile LAS unsigned*)(F.lds + LDS_MISC);
    if (F.tid < 32) MISC[F.tid] = 0u;
    __syncthreads();
    XcdBarrier bar; bar.bar = (unsigned*)(kp->ws + CTL_BAR); bar.x = 0; bar.st = nullptr;
    if (MK_LAUNCHES == 1) bar = xcd_barrier_post((unsigned*)(kp->ws + CTL_BAR), MISC + 8);
    const int lo = kp->ph_lo, hi = kp->ph_hi;
#define IN(k) (lo <= (k) && (k) < hi)
#define SEAM(k) do { if (IN(k) && IN((k) + 1)) xcd_barrier(bar); } while (0)
#define WSP(T_, off) ((T_*)(ws + (off)))
    if (IN(0)) { LAUNDER(kp); phase0(F, kp, true); if (MK_DUP & 1) { xcd_barrier(bar); phase0(F, kp, false); } }
    SEAM(0);
    if (IN(1)) { LAUNDER(kp); phase1(F, kp); }
    SEAM(1);
    if (IN(2)) {
        LAUNDER(kp); unsigned char* ws = kp->ws;
        g8::Gemm g{ws + WS_WIN, ws + WS_XA, 1024, 2048u, 16u, 256, 128, 12, 48, 0}; g8::StaticOrder S; S.init(12, 48, F.G, F.bid);
        EpiZT E{WSP(f16h, WS_ZT), kp->in[13]}; g8::gemm_phase<EpiZT>(F.lds, g, S, E);
        bias2_items(F, kp, 64);
        filt_items(F, kp, 64, F.G - 64, true);
    }
    if (MK_DUP & (1 << 2)) { xcd_barrier(bar); if (IN(2)) {
        LAUNDER(kp); unsigned char* ws = kp->ws;
        g8::Gemm g{ws + WS_WIN, ws + WS_XA, 1024, 2048u, 16u, 256, 128, 12, 48, 0}; g8::StaticOrder S; S.init(12, 48, F.G, F.bid);
        EpiZT E{WSP(f16h, WS_ZT), kp->in[13]}; g8::gemm_phase<EpiZT>(F.lds, g, S, E);
        filt_items(F, kp, 64, F.G - 64, true);
    } }
    SEAM(2);
    if (IN(3)) { LAUNDER(kp); unsigned char* ws = kp->ws; cv::Args A{WSP(f16h, WS_ZT), WSP(const f16h, WS_FILT), kp->in[14], kp->in[15], kp->in[22], WSP(f16h, WS_V2)}; cv::conv_phase(F.lds, A, F.G, F.bid); }
    if (MK_DUP & (1 << 3)) { xcd_barrier(bar); if (IN(3)) { LAUNDER(kp); unsigned char* ws = kp->ws; cv::Args A{WSP(f16h, WS_ZT), WSP(const f16h, WS_FILT), kp->in[14], kp->in[15], kp->in[22], WSP(f16h, WS_V2)}; cv::conv_phase(F.lds, A, F.G, F.bid); } }
    SEAM(3);
    if (IN(4) && (MK_DUP & (1 << 4))) {
        LAUNDER(kp); unsigned char* ws = kp->ws;
        g8::Gemm g{ws + WS_V2, ws + WS_WOUT, 1024, 16u, 16u * 12288u, 256, 128, 48, 4, 0}; g8::StaticOrder S; S.init(48, 4, F.G, F.bid);
        EpiRes2<true> E{ResOut{WSP(float, WS_YB), kp->out, nullptr, kp->in[6], nullptr, kp->in[0], kp->in[1], WSP(const float, WS_POST), 0, 0}, kp->in[24], WSP(const float, WS_MOD), 2048, 4096};
        g8::gemm_phase<EpiRes2<true>>(F.lds, g, S, E);
    }
    if (IN(4) && (MK_DUP & (1 << 4))) xcd_barrier(bar);
    if (IN(4)) {
        LAUNDER(kp); unsigned char* ws = kp->ws;
        g8::Gemm g{ws + WS_V2, ws + WS_WOUT, 1024, 16u, 16u * 12288u, 256, 128, 48, 4, 0}; g8::StaticOrder S; S.init(48, 4, F.G, F.bid);
        EpiRes2<true> E{ResOut{kp->out, kp->out, WSP(f16h, WS_XA), kp->in[6], WSP(float, WS_SSQ), kp->in[0], kp->in[1], WSP(const float, WS_POST), 0, 0}, kp->in[24], WSP(const float, WS_MOD), 2048, 4096};
        g8::gemm_phase<EpiRes2<true>>(F.lds, g, S, E);
        convert_items(F, kp, 192, 0);
    }
    SEAM(4);
    if (IN(5)) { LAUNDER(kp); unsigned char* ws = kp->ws;
        g8::Gemm g{ws + WS_XA, ws + WS_W13, 1024, 2048u, 16u, 128, 2816, 48, 22, 0}; g8::StaticOrder S; S.init(48, 22, F.G, F.bid);
        EpiSwiglu2 E{WSP(f16h, WS_ZT), WSP(const float, WS_SSQ), WSP(const float, WS_BIAS2)}; g8::gemm_phase<EpiSwiglu2>(F.lds, g, S, E); }
    if (MK_DUP & (1 << 5)) { xcd_barrier(bar); if (IN(5)) { LAUNDER(kp); unsigned char* ws = kp->ws;
        g8::Gemm g{ws + WS_XA, ws + WS_W13, 1024, 2048u, 16u, 128, 2816, 48, 22, 0}; g8::StaticOrder S; S.init(48, 22, F.G, F.bid);
        EpiSwiglu2 E{WSP(f16h, WS_ZT), WSP(const float, WS_SSQ), WSP(const float, WS_BIAS2)}; g8::gemm_phase<EpiSwiglu2>(F.lds, g, S, E); } }
    SEAM(5);
    if (IN(6) && (MK_DUP & (1 << 6))) { LAUNDER(kp); unsigned char* ws = kp->ws;
        g8::Gemm g{ws + WS_ZT, ws + WS_W2, 2816, 5632u, 16u, 256, 128, 48, 4, 0}; g8::StaticOrder S; S.init(48, 4, F.G, F.bid);
        EpiRes2<false> E{ResOut{WSP(float, WS_YB), kp->out, nullptr, kp->in[5] + D, nullptr, nullptr, nullptr, nullptr, 1, 0}, nullptr, WSP(const float, WS_MOD), 5120, 6144 + 1024};
        g8::gemm_phase<EpiRes2<false>>(F.lds, g, S, E); }
    if (IN(6) && (MK_DUP & (1 << 6))) xcd_barrier(bar);
    if (IN(6)) { LAUNDER(kp); unsigned char* ws = kp->ws;
        g8::Gemm g{ws + WS_ZT, ws + WS_W2, 2816, 5632u, 16u, 256, 128, 48, 4, 0}; g8::StaticOrder S; S.init(48, 4, F.G, F.bid);
        EpiRes2<false> E{ResOut{kp->out, kp->out, WSP(f16h, WS_XA), kp->in[5] + D, WSP(float, WS_SSQ) + T, nullptr, nullptr, nullptr, 1, 0}, nullptr, WSP(const float, WS_MOD), 5120, 6144 + 1024};
        g8::gemm_phase<EpiRes2<false>>(F.lds, g, S, E); convert_items(F, kp, 192, 1); }
    SEAM(6);
    if (IN(7)) { LAUNDER(kp); unsigned char* ws = kp->ws;
        s5::Args A{WSP(const f16h, WS_XA), WSP(const float, WS_SSQ) + T, WSP(const float, WS_MOD), WSP(const float, WS_S5PW), WSP(const f16h, WS_S5BB), kp->in[30], kp->in[31], kp->in[32], kp->in[2], WSP(float, WS_YB), WSP(f16h, WS_V2), kp->out + (size_t)T * D};
        if (F.tid < 8) MISC[16 + F.tid] = 0u; __syncthreads(); s5::s5_phase(F.lds, (volatile LAS int*)(MISC + 16), A, F.G, F.bid); }
    if (MK_DUP & (1 << 7)) { xcd_barrier(bar); if (IN(7)) { LAUNDER(kp); unsigned char* ws = kp->ws;
        s5::Args A{WSP(const f16h, WS_XA), WSP(const float, WS_SSQ) + T, WSP(const float, WS_MOD), WSP(const float, WS_S5PW), WSP(const f16h, WS_S5BB), kp->in[30], kp->in[31], kp->in[32], kp->in[2], WSP(float, WS_YB), WSP(f16h, WS_V2), kp->out + (size_t)T * D};
        if (F.tid < 8) MISC[16 + F.tid] = 0u; __syncthreads(); s5::s5_phase(F.lds, (volatile LAS int*)(MISC + 16), A, F.G, F.bid); } }
    SEAM(7);
    if (IN(8) && (MK_DUP & (1 << 8))) { LAUNDER(kp); unsigned char* ws = kp->ws;
        g8::Gemm g{ws + WS_V2, ws + WS_WGLU, 1024, 16u, 16u * 12288u, 128, 1024, 48, 8, 0}; g8::StaticOrder S; S.init(48, 8, F.G, F.bid);
        EpiGlu2 E{ResOut{WSP(float, WS_YB), kp->out, nullptr, kp->in[6] + D, nullptr, nullptr, nullptr, nullptr, 0, 0}, kp->in[34], WSP(const float, WS_MOD), 6144 + 2048, 6144 + 4096};
        g8::gemm_phase<EpiGlu2>(F.lds, g, S, E); }
    if (IN(8) && (MK_DUP & (1 << 8))) xcd_barrier(bar);
    if (IN(8)) { LAUNDER(kp); unsigned char* ws = kp->ws;
        g8::Gemm g{ws + WS_V2, ws + WS_WGLU, 1024, 16u, 16u * 12288u, 128, 1024, 48, 8, 0}; g8::StaticOrder S; S.init(48, 8, F.G, F.bid);
        EpiGlu2 E{ResOut{kp->out, kp->out, WSP(f16h, WS_XA), kp->in[6] + D, WSP(float, WS_SSQ) + 2 * T, nullptr, nullptr, nullptr, 0, 0}, kp->in[34], WSP(const float, WS_MOD), 6144 + 2048, 6144 + 4096};
        g8::gemm_phase<EpiGlu2>(F.lds, g, S, E); }
    SEAM(8);
    if (IN(9)) { LAUNDER(kp); unsigned char* ws = kp->ws;
        g8::Gemm g{ws + WS_XA, ws + WS_W13 + (size_t)5632 * 1024 * 2, 1024, 2048u, 16u, 128, 2816, 48, 22, 0}; g8::StaticOrder S; S.init(48, 22, F.G, F.bid);
        EpiSwiglu2 E{WSP(f16h, WS_ZT), WSP(const float, WS_SSQ) + 2 * T, WSP(const float, WS_BIAS2) + 9 * 5632}; g8::gemm_phase<EpiSwiglu2>(F.lds, g, S, E); }
    SEAM(9);
    if (IN(10) && (MK_DUP & (1 << 10))) { LAUNDER(kp); unsigned char* ws = kp->ws;
        g8::Gemm g{ws + WS_ZT, ws + WS_W2 + (size_t)1024 * 2816 * 2, 2816, 5632u, 16u, 256, 128, 48, 4, 0}; g8::StaticOrder S; S.init(48, 4, F.G, F.bid);
        EpiRes2<false> E{ResOut{WSP(float, WS_YB), kp->out, nullptr, nullptr, nullptr, nullptr, nullptr, nullptr, 0, 0}, nullptr, WSP(const float, WS_MOD), 6144 + 5120, 0};
        g8::gemm_phase<EpiRes2<false>>(F.lds, g, S, E); }
    if (IN(10) && (MK_DUP & (1 << 10))) xcd_barrier(bar);
    if (IN(10)) { LAUNDER(kp); unsigned char* ws = kp->ws;
        g8::Gemm g{ws + WS_ZT, ws + WS_W2 + (size_t)1024 * 2816 * 2, 2816, 5632u, 16u, 256, 128, 48, 4, 0}; g8::StaticOrder S; S.init(48, 4, F.G, F.bid);
        EpiRes2<false> E{ResOut{kp->out, kp->out, nullptr, nullptr, WSP(float, WS_SSQ) + 3 * T, nullptr, nullptr, nullptr, 0, 0}, nullptr, WSP(const float, WS_MOD), 6144 + 5120, 0};
        g8::gemm_phase<EpiRes2<false>>(F.lds, g, S, E); }
    SEAM(10);
    if (IN(11)) { LAUNDER(kp); phase_final(F, kp); }
#undef IN
#undef SEAM
#undef WSP
}

extern "C" void kernel_launch(void* const* d_in, const int* in_sizes, int n_in, void* d_out, int out_size, void* d_ws, size_t ws_size, hipStream_t stream) {
    static int grid = 0;
    if (grid == 0) {
        if (n_in != 35 || ws_size < WS_END) { fprintf(stderr, "kernel_launch: unexpected n_in %d / ws %zu\n", n_in, ws_size); grid = -1; return; }
        int dev = 0, cus = 0, per_cu = 0;
        if (hipGetDevice(&dev) != hipSuccess || hipDeviceGetAttribute(&cus, hipDeviceAttributeMultiprocessorCount, dev) != hipSuccess) { grid = -1; return; }
        if (hipFuncSetAttribute((const void*)mk_fwd, hipFuncAttributeMaxDynamicSharedMemorySize, LDS_BYTES) != hipSuccess) { fprintf(stderr, "kernel_launch: hipFuncSetAttribute failed\n"); grid = -1; return; }
        if (hipOccupancyMaxActiveBlocksPerMultiprocessor(&per_cu, (const void*)mk_fwd, 512, LDS_BYTES) != hipSuccess || per_cu < 1) { fprintf(stderr, "kernel_launch: occupancy query says %d\n", per_cu); per_cu = 1; }
        (void)hipGetLastError();
        grid = cus;
    }
    if (grid < 0) return;
    (void)hipMemsetAsync((char*)d_ws + WS_CTL, 0, CTL_ZERO_BYTES, stream);
    Params p; memset(&p, 0, sizeof(p));
    for (int i = 0; i < 35; ++i) p.in[i] = (const float*)d_in[i];
    p.out = (float*)d_out; p.ws = (unsigned char*)d_ws;
    if (MK_LAUNCHES == 1) { p.ph_lo = 0; p.ph_hi = NPH; hipLaunchKernelGGL(mk_fwd, dim3(grid), dim3(512), LDS_BYTES, stream, p); }
    else for (int k = 0; k < NPH; ++k) { p.ph_lo = k; p.ph_hi = k + 1; hipLaunchKernelGGL(mk_fwd, dim3(grid), dim3(512), LDS_BYTES, stream, p); }
}
```

```cpp
#include <hip/hip_runtime.h>
#include <math.h>
#include <string.h>
#include <stdio.h>

#ifndef MK_DUP
#define MK_DUP 0
#endif
#ifndef MK_LAUNCHES
#define MK_LAUNCHES 1
#endif
constexpr int D = 1024, NCTX = 4096, NLAT = 8192, T = 12288, F = 2816, NPH = 12;
constexpr size_t MiB = 1u << 20;
typedef _Float16 f16h;
constexpr size_t WS_CTL = 0, CTL_ZERO_BYTES = 2 * MiB;
constexpr size_t CTL_BAR = 16384;
constexpr size_t WS_MOD = 65536;
constexpr size_t WS_SSQ = 524288;
constexpr size_t WS_NORM = 720896;
constexpr size_t WS_BIAS2 = 786432;
constexpr size_t WS_H2 = 2 * MiB;
constexpr size_t WS_POST = 2 * MiB + 512 * 1024;
constexpr size_t WS_S5PW = 2 * MiB + 768 * 1024;
constexpr size_t WS_S5BB = 3 * MiB;
constexpr size_t WS_FILT = 4 * MiB;
constexpr size_t WS_WIN = 24 * MiB, WS_WOUT = 30 * MiB, WS_W13 = 32 * MiB  , WS_W2 = 54 * MiB  , WS_WGLU = 65 * MiB;
constexpr size_t WS_XA = 70 * MiB;
constexpr size_t WS_V2 = 94 * MiB;
constexpr size_t WS_ZT = 118 * MiB;
constexpr size_t WS_YB = 190 * MiB;
constexpr size_t WS_END = 238 * MiB;
constexpr int LDS_BYTES = 135168;
constexpr int LDS_MISC = 133120;

__device__ __forceinline__ int row_ci(int row) { return row < NCTX ? 0 : 1 + ((row - NCTX) >> 10); }
__device__ __forceinline__ float siluf(float v) { return v / (1.f + __expf(-v)); }
__device__ __forceinline__ float sigmf(float v) { return 1.f / (1.f + __expf(-v)); }
__device__ __forceinline__ unsigned pkh(float a, float b) { typedef _Float16 h2 __attribute__((ext_vector_type(2))); h2 v; v.x = (_Float16)a; v.y = (_Float16)b; return __builtin_bit_cast(unsigned, v); }

__device__ __forceinline__ void atomic_add_done(float* p, float v) { const float old = atomicAdd(p, v); asm volatile("" :: "v"(old)); }
struct Params { const float* in[35]; float* out; unsigned char* ws; int ph_lo, ph_hi; };
namespace g8 {
#define G8_LAS __attribute__((address_space(3)))
typedef _Float16 h8 __attribute__((ext_vector_type(8)));
typedef float f32x4 __attribute__((ext_vector_type(4)));
typedef unsigned u32x4 __attribute__((ext_vector_type(4)));
typedef unsigned u32x2 __attribute__((ext_vector_type(2)));
constexpr int BM = 256, BK = 64, HALF = 128, HTB = HALF * BK * 2, STAGE_BYTES = 8 * HTB, NXCD = 8, WGM = 8;
__host__ __device__ __forceinline__ int lds_byte(int r, int c) { const int st = (r >> 4) * 2 + (c >> 5), rr = r & 15, cc = c & 31, ob = rr * 64 + cc * 2; return st * 1024 + (ob ^ (((ob >> 9) & 1) << 5)); }
__host__ __device__ __forceinline__ void stage_rc(int b, int& R, int& C) { const int st = b / 1024, sb = b % 1024, swz = sb ^ (((sb >> 9) & 1) << 5); R = (st >> 1) * 16 + swz / 64; C = (st & 1) * 32 + (swz % 64) / 2; }
struct Unit { int pm, pn; };
struct Gemm { const void* A; const void* Bt; int K; unsigned a_row, a_k8; int b_tile_rows, b_half_rows; int nM, nN; int pad; };
struct StaticOrder {
    int nM, nN, nwg, G, c;
    __device__ void init(int nM_, int nN_, int G_, int c_) { nM = nM_; nN = nN_; nwg = nM * nN; G = G_; c = c_; }
    __device__ bool next(int i, Unit& u) const {
        const long L = (long)i * G + c; if (L >= nwg) return false;
        int wgid = (int)L; { const int q = nwg / NXCD, r = nwg % NXCD, xcd = wgid % NXCD, off = wgid / NXCD; wgid = (xcd < r ? xcd * (q + 1) : r * (q + 1) + (xcd - r) * q) + off; }
        const int nig = WGM * nN, gid = wgid / nig, fm = gid * WGM, gsz = (nM - fm) < WGM ? (nM - fm) : WGM;
        u.pm = fm + ((wgid % nig) % gsz); u.pn = (wgid % nig) / gsz; return true;
    }
};
template <class Epi>
__device__ __forceinline__ void gemm_phase(G8_LAS unsigned char* lds, const Gemm g, const StaticOrder& S, const Epi& E) {
    const int tid = threadIdx.x, wid = __builtin_amdgcn_readfirstlane(tid >> 6), lane = tid & 63, wr = wid >> 2, wc = wid & 3, fr = lane & 15, fq = lane >> 4;
    const int K = g.K, nt = K / BK;
    unsigned voffA[2], voffB[2];
#pragma unroll
    for (int i = 0; i < 2; ++i) { int R, C; stage_rc(tid * 16 + i * 8192, R, C);
        voffA[i] = (unsigned)R * g.a_row + (unsigned)(C >> 3) * g.a_k8; voffB[i] = (unsigned)(R * K + C) * 2u; }
    const size_t kstepA = (size_t)8 * g.a_k8, kstepB = (size_t)(BK * 2);
    const size_t hstepA = (size_t)HALF * g.a_row, tstepA = 2 * hstepA;
    const size_t hstepB = (size_t)g.b_half_rows * K * 2, tstepB = (size_t)g.b_tile_rows * K * 2;
    const unsigned ldsw = (unsigned)wid * 1024u;
    const int aoff = lds_byte(wr * 64 + fr, fq * 8), boff = lds_byte(wc * 32 + fr, fq * 8);
#define G8_SA(b, h) (((b) * 2 + (h)) * HTB)
#define G8_SB(b, h) ((4 + (b) * 2 + (h)) * HTB)
#define G8_STAGE(bufoff, gbase, voff) do { _Pragma("unroll") for (int _i = 0; _i < 2; ++_i) \
        __builtin_amdgcn_global_load_lds((const unsigned*)((const char*)(gbase) + (voff)[_i]), (G8_LAS unsigned*)(lds + (bufoff) + ldsw + _i * 8192), 16, 0, 0); } while (0)
#define G8_LDA(dst, b, h) do { _Pragma("unroll") for (int m = 0; m < 4; ++m) _Pragma("unroll") for (int k = 0; k < 2; ++k) dst[m][k] = *(const G8_LAS h8*)(lds + G8_SA(b, h) + aoff + m * 2048 + k * 1024); } while (0)
#define G8_LDB(dst, b, h) do { _Pragma("unroll") for (int n = 0; n < 2; ++n) _Pragma("unroll") for (int k = 0; k < 2; ++k) dst[n][k] = *(const G8_LAS h8*)(lds + G8_SB(b, h) + boff + n * 2048 + k * 1024); } while (0)
#define G8_MMA(ai, bj, At, Bt) do { __builtin_amdgcn_s_setprio(1); _Pragma("unroll") for (int m = 0; m < 4; ++m) _Pragma("unroll") for (int n = 0; n < 2; ++n) _Pragma("unroll") for (int k = 0; k < 2; ++k) \
        acc[ai][bj][m][n] = __builtin_amdgcn_mfma_f32_16x16x32_f16(Bt[n][k], At[m][k], acc[ai][bj][m][n], 0, 0, 0); __builtin_amdgcn_s_setprio(0); } while (0)
#define G8_WAIT_V(n) asm volatile("s_waitcnt vmcnt(" #n ")" ::: "memory")
#define G8_WAIT_L(n) asm volatile("s_waitcnt lgkmcnt(" #n ")" ::: "memory")
#define G8_BAR __builtin_amdgcn_s_barrier()
#define G8_SCHED __builtin_amdgcn_sched_barrier(0)
    Unit cur, nxt; int ui = 0;
    if (!S.next(0, cur)) return;
    f32x4 acc[2][2][4][2];
#pragma unroll
    for (int a = 0; a < 2; ++a)
#pragma unroll
        for (int b = 0; b < 2; ++b)
#pragma unroll
            for (int m = 0; m < 4; ++m)
#pragma unroll
                for (int n = 0; n < 2; ++n) acc[a][b][m][n] = (f32x4){0.f, 0.f, 0.f, 0.f};
    h8 At[4][2], B0[2][2], B1[2][2];
    const char* cA = (const char*)g.A + (size_t)cur.pm * tstepA; const char* cB = (const char*)g.Bt + (size_t)cur.pn * tstepB;
    G8_STAGE(G8_SB(0, 0), cB, voffB); G8_STAGE(G8_SB(0, 1), cB + hstepB, voffB); G8_STAGE(G8_SA(0, 0), cA, voffA); G8_STAGE(G8_SA(0, 1), cA + hstepA, voffA);
    if (wr == 1) G8_BAR;
    G8_WAIT_V(2); G8_BAR;
    G8_STAGE(G8_SB(1, 0), cB + kstepB, voffB); G8_STAGE(G8_SA(1, 0), cA + kstepA, voffA); G8_STAGE(G8_SB(1, 1), cB + hstepB + kstepB, voffB);
    G8_WAIT_V(6); G8_BAR;
    for (;;) {
        const bool has_next = S.next(ui + 1, nxt);
        const char* nA = has_next ? (const char*)g.A + (size_t)nxt.pm * tstepA : cA; const char* nB = has_next ? (const char*)g.Bt + (size_t)nxt.pn * tstepB : cB;
        for (int t = 0; t < nt; t += 2) {
            const bool last = (t == nt - 2);
            const char* a1 = cA + (size_t)(t + 1) * kstepA;
            const char* a2 = last ? nA : cA + (size_t)(t + 2) * kstepA; const char* b2 = last ? nB : cB + (size_t)(t + 2) * kstepB;
            const char* a3 = a2 + kstepA; const char* b3 = b2 + kstepB;
            G8_LDB(B0, 0, 0); G8_LDB(B1, 0, 1); G8_SCHED; G8_LDA(At, 0, 0); G8_STAGE(G8_SA(1, 1), a1 + hstepA, voffA);
            G8_WAIT_V(8); G8_WAIT_L(0); G8_BAR; G8_MMA(0, 0, At, B0); G8_MMA(0, 1, At, B1); G8_BAR; G8_SCHED;
            G8_LDA(At, 0, 1); G8_STAGE(G8_SB(0, 0), b2, voffB); G8_STAGE(G8_SB(0, 1), b2 + hstepB, voffB); G8_STAGE(G8_SA(0, 0), a2, voffA);
            G8_WAIT_V(8); G8_WAIT_L(0); G8_BAR; G8_MMA(1, 0, At, B0); G8_MMA(1, 1, At, B1); G8_BAR; G8_SCHED;
            G8_LDB(B0, 1, 0); G8_LDB(B1, 1, 1); G8_SCHED; G8_LDA(At, 1, 0); G8_STAGE(G8_SA(0, 1), a2 + hstepA, voffA);
            G8_WAIT_V(8); G8_WAIT_L(0); G8_BAR; G8_MMA(0, 0, At, B0); G8_MMA(0, 1, At, B1); G8_BAR; G8_SCHED;
            G8_LDA(At, 1, 1); G8_STAGE(G8_SB(1, 0), b3, voffB); G8_STAGE(G8_SB(1, 1), b3 + hstepB, voffB); G8_STAGE(G8_SA(1, 0), a3, voffA);
            G8_WAIT_V(8); G8_WAIT_L(0); G8_BAR; G8_MMA(1, 0, At, B0); G8_MMA(1, 1, At, B1); G8_BAR; G8_SCHED;
        }
        if (wr == 0) G8_BAR;
        E(acc, cur, wr, wc, fr, fq);
        if (!has_next) break;
#pragma unroll
        for (int a = 0; a < 2; ++a)
#pragma unroll
            for (int b = 0; b < 2; ++b)
#pragma unroll
                for (int m = 0; m < 4; ++m)
#pragma unroll
                    for (int n = 0; n < 2; ++n) acc[a][b][m][n] = (f32x4){0.f, 0.f, 0.f, 0.f};
        cur = nxt; cA = nA; cB = nB; ++ui;
        if (wr == 1) G8_BAR;
    }
    G8_WAIT_V(0);
    G8_BAR;
#undef G8_SA
#undef G8_SB
#undef G8_STAGE
#undef G8_LDA
#undef G8_LDB
#undef G8_MMA
#undef G8_WAIT_V
#undef G8_WAIT_L
#undef G8_BAR
#undef G8_SCHED
}
}
namespace cv {
#define CV_LAS __attribute__((address_space(3)))
typedef _Float16 h8 __attribute__((ext_vector_type(8)));
typedef _Float16 h4 __attribute__((ext_vector_type(4)));
typedef float f32x16 __attribute__((ext_vector_type(16)));
typedef unsigned u4 __attribute__((ext_vector_type(4)));
typedef unsigned u2 __attribute__((ext_vector_type(2)));
constexpr int WAVE_LDS = 16640, V_OFF = 0, FA_OFF = 8320, FB_OFF = 12480;
constexpr float FSCALE = 64.f;
struct Args { const _Float16* zT; const _Float16* FILT; const float* conv_w; const float* conv_b; const float* fbias; _Float16* V2; };
__host__ __device__ __forceinline__ size_t filt_off(int lv, int o, int ch) { return lv ? (size_t)2 * 1024 * 512 + (size_t)(o * 1024 + ch) * 2048 : (size_t)(o * 1024 + ch) * 512; }
template <int LV> __device__ __forceinline__ void conv_unit(CV_LAS unsigned char* lds, const Args& P, int c, int bh) {
    constexpr int L = LV ? 1024 : 256, NBu = LV ? 4 : 8, T1 = L / 32, T1L = LV ? 8 : 4, NCT = T1 / T1L, PV = L * 2 + 16;
    const int tid = threadIdx.x, w = __builtin_amdgcn_readfirstlane(tid >> 6), lane = tid & 63;
    const int ch = 8 * c + w;
    const int row_base = LV ? 4096 + (4 * bh) * 1024 : (8 * bh) * 256;
    CV_LAS unsigned char* wl = lds + w * WAVE_LDS;
    {
        const _Float16* zrow = P.zT + (size_t)ch * 12288 + row_base;
        const float w0 = P.conv_w[ch], w1 = P.conv_w[3072 + ch], w2 = P.conv_w[6144 + ch], cb = P.conv_b[ch];
        for (int piece = lane; piece < NBu * L / 8; piece += 64) {
            const int bl = piece / (L / 8), t0 = (piece % (L / 8)) * 8;
            const h8 raw = *(const h8*)(zrow + bl * L + t0);
            float z[10];
            z[0] = t0 > 0 ? (float)zrow[bl * L + t0 - 1] : 0.f; z[9] = t0 + 8 < L ? (float)zrow[bl * L + t0 + 8] : 0.f;
#pragma unroll
            for (int i = 0; i < 8; ++i) z[i + 1] = (float)raw[i];
            h8 o;
#pragma unroll
            for (int i = 0; i < 8; ++i) o[i] = (_Float16)(w0 * z[i] + w1 * z[i + 1] + w2 * z[i + 2] + cb);
            *(CV_LAS h8*)(wl + V_OFF + bl * PV + t0 * 2) = o;
        }
    }
    const int t2 = lane & 31, hi = lane >> 5, col = lane & 31, bl = col / T1L, t1l = col % T1L;
    const int abase = (t2 & 1) ? FA_OFF + 2 * ((L - 1) - t2 + 8 * hi) : FB_OFF + 2 * ((L - 1) - t2 + 8 * hi - 1);
    const int vbase = V_OFF + bl * PV + 16 * hi;
#pragma unroll 1
    for (int o = 0; o < 2; ++o) {
        {
            const u4* Fg = (const u4*)(P.FILT + filt_off(LV, o, ch));
            for (int piece = lane; piece < 2 * L / 8; piece += 64) {
                const u4 a = Fg[piece]; const unsigned e0 = piece + 1 < 2 * L / 8 ? ((const unsigned*)(Fg + piece + 1))[0] : 0u;
                u4 b; b.x = (a.x >> 16) | (a.y << 16); b.y = (a.y >> 16) | (a.z << 16); b.z = (a.z >> 16) | (a.w << 16); b.w = (a.w >> 16) | (e0 << 16);
                *(CV_LAS u4*)(wl + FA_OFF + piece * 16) = a;
                *(CV_LAS u4*)(wl + FB_OFF + piece * 16) = b;
            }
        }
        f32x16 acc[NCT];
#pragma unroll
        for (int ct = 0; ct < NCT; ++ct)
#pragma unroll
            for (int r = 0; r < 16; ++r) acc[ct][r] = 0.f;
#pragma unroll 1
        for (int d = -(T1 - 1); d <= T1 - 1; ++d) {
            const CV_LAS unsigned* ap = (const CV_LAS unsigned*)(wl + abase - 64 * d);
            u4 a0, a1;
            a0.x = ap[0]; a0.y = ap[1]; a0.z = ap[2]; a0.w = ap[3];
            a1.x = ap[8]; a1.y = ap[9]; a1.z = ap[10]; a1.w = ap[11];
            const h8 A0 = __builtin_bit_cast(h8, a0), A1 = __builtin_bit_cast(h8, a1);
#pragma unroll
            for (int ct = 0; ct < NCT; ++ct) {
                const int lo = ct * T1L - d;
                if (lo + T1L - 1 < 0 || lo > T1 - 1) continue;
                const int s1 = lo + t1l; const bool valid = (unsigned)s1 < (unsigned)T1; const int s1c = valid ? s1 : 0;
                h8 b0 = *(const CV_LAS h8*)(wl + vbase + s1c * 64), b1 = *(const CV_LAS h8*)(wl + vbase + s1c * 64 + 32);
                if (!valid) {
#pragma unroll
                    for (int i = 0; i < 8; ++i) { b0[i] = (_Float16)0.f; b1[i] = (_Float16)0.f; } }
                acc[ct] = __builtin_amdgcn_mfma_f32_32x32x16_f16(A0, b0, acc[ct], 0, 0, 0);
                acc[ct] = __builtin_amdgcn_mfma_f32_32x32x16_f16(A1, b1, acc[ct], 0, 0, 0);
            }
        }
        {
            const int gch = (o + 1) * 1024 + ch;
            const _Float16* xrow = P.zT + (size_t)gch * 12288 + row_base + bl * L;
            const float g0 = P.conv_w[gch], g1 = P.conv_w[3072 + gch], g2 = P.conv_w[6144 + gch], gcb = P.conv_b[gch], fbv = P.fbias[o * 1024 + ch];
#pragma unroll
            for (int ct = 0; ct < NCT; ++ct)
#pragma unroll
                for (int g = 0; g < 4; ++g) {
                    const int t = 32 * (ct * T1L + t1l) + 8 * g + 4 * hi;
                    const h4 zz = *(const h4*)(xrow + t);
                    float z[6]; z[0] = t > 0 ? (float)xrow[t - 1] : 0.f; z[5] = t + 4 < L ? (float)xrow[t + 4] : 0.f;
#pragma unroll
                    for (int i = 0; i < 4; ++i) z[i + 1] = (float)zz[i];
                    CV_LAS h4* vp = (CV_LAS h4*)(wl + V_OFF + bl * PV + t * 2);
                    const h4 vin = *vp; h4 vo;
#pragma unroll
                    for (int i = 0; i < 4; ++i) { const float gate = g0 * z[i] + g1 * z[i + 1] + g2 * z[i + 2] + gcb;
                        vo[i] = (_Float16)((acc[ct][4 * g + i] * (1.f / FSCALE) + (float)vin[i] * fbv) * gate); }
                    *vp = vo;
                }
        }
    }
    __syncthreads();
    for (int idx = tid; idx < NBu * L; idx += 512) {
        const int b2 = idx / L, t = idx % L; h8 o;
#pragma unroll
        for (int ww = 0; ww < 8; ++ww) o[ww] = *(const CV_LAS _Float16*)(lds + ww * WAVE_LDS + V_OFF + b2 * PV + t * 2);
        *(h8*)(P.V2 + ((size_t)c * 12288 + row_base + b2 * L + t) * 8) = o;
    }
    __syncthreads();
}
__device__ __forceinline__ void conv_phase(CV_LAS unsigned char* lds, const Args& P, int G, int bid) {
    for (int u = bid; u < 256; u += G) conv_unit<1>(lds, P, u >> 1, u & 1);
    for (int u = bid; u < 256; u += G) conv_unit<0>(lds, P, u >> 1, u & 1);
}
}
namespace s5 {
#define S5_LAS __attribute__((address_space(3)))
typedef _Float16 h8 __attribute__((ext_vector_type(8)));
typedef _Float16 h4 __attribute__((ext_vector_type(4)));
typedef _Float16 h2 __attribute__((ext_vector_type(2)));
typedef float f32x16 __attribute__((ext_vector_type(16)));
typedef float f32x4 __attribute__((ext_vector_type(4)));
constexpr int IMG_PITCH = 288, WAVE_LDS = 32 * IMG_PITCH;
constexpr int TT = 12288;
struct Args { const _Float16* UP; const float* ssq; const float* MOD; const float* PW; const _Float16* BB;
              const float* C_re; const float* C_im; const float* Dv; const float* state_in; float* YB; _Float16* Y2; float* new_state; };
__device__ __forceinline__ float gelu_fast(float x) { const float u = 1.5957691216057308f * (x + 0.044715f * x * x * x); return x / (1.f + __expf(-u)); }
__device__ __forceinline__ void s5_table(int ix, const float* A_re, const float* A_im, const float* log_dt, const float* B_re, const float* B_im, float* PW, _Float16* BB) {
    const double are = A_re[ix], aim = A_im[ix], dt = exp((double)log_dt[ix >> 6]);
    const double mag = exp(dt * are), ph = dt * aim, abr = mag * cos(ph), abi = mag * sin(ph);
    const double nr = abr - 1.0, ni = abi, den = are * are + aim * aim, cor = (nr * are + ni * aim) / den, coi = (ni * are - nr * aim) / den;
    double pr = abr, pi = abi;
    for (int k = 0; k < 4; ++k) { PW[(size_t)ix * 8 + 2 * k] = (float)pr; PW[(size_t)ix * 8 + 2 * k + 1] = (float)pi; const double tr = pr * abr - pi * abi; pi = pr * abi + pi * abr; pr = tr; }
    for (int h = 0; h < 16; ++h) { const double br = B_re[(size_t)ix * 16 + h], bi = B_im[(size_t)ix * 16 + h];
        BB[(size_t)ix * 32 + h] = (_Float16)(float)(cor * br - coi * bi); BB[(size_t)ix * 32 + 16 + h] = (_Float16)(float)(cor * bi + coi * br); }
}
__device__ __forceinline__ void s5_task(S5_LAS unsigned char* img, volatile S5_LAS int* myflag, volatile S5_LAS int* pflag, int epoch, const Args& P, int seq, int g, int dir) {
    const int lane = threadIdx.x & 63, n = lane & 31, hi = lane >> 5, tq = lane & 15, q4 = lane >> 4;
    const bool ctx = seq < 16;
    const int L = ctx ? 256 : 1024, base = ctx ? seq * 256 : 4096 + (seq - 16) * 1024, ci = ctx ? 0 : 1 + (seq - 16), NT = L / 32;
    const float* mod = P.MOD + (ci * 2 + 1) * 6144;
    float shA[8], shO[4], dvO[4];
#pragma unroll
    for (int j = 0; j < 8; ++j) shA[j] = mod[16 * g + 8 * hi + j];
#pragma unroll
    for (int j = 0; j < 4; ++j) { shO[j] = mod[16 * g + 4 * q4 + j]; dvO[j] = P.Dv[16 * g + 4 * q4 + j]; }
    const _Float16* up = P.UP + (size_t)g * TT * 16;
    float* yb = P.YB + (size_t)g * TT * 16;
    float pw[2][4][2]; h8 Bf[2][2]; float cr[2], cim[2];
#pragma unroll
    for (int half = 0; half < 2; ++half) {
        const int p = n + 32 * half, ix = (dir * 64 + g) * 64 + p;
        const f32x4 q0 = *(const f32x4*)(P.PW + (size_t)ix * 8), q1 = *(const f32x4*)(P.PW + (size_t)ix * 8 + 4);
        pw[half][0][0] = q0[0]; pw[half][0][1] = q0[1]; pw[half][1][0] = q0[2]; pw[half][1][1] = q0[3]; pw[half][2][0] = q1[0]; pw[half][2][1] = q1[1]; pw[half][3][0] = q1[2]; pw[half][3][1] = q1[3];
        Bf[half][0] = *(const h8*)(P.BB + (size_t)ix * 32 + 8 * hi); Bf[half][1] = *(const h8*)(P.BB + (size_t)ix * 32 + 16 + 8 * hi);
        if (ctx) { cr[half] = 0.f; cim[half] = 0.f; }
        else { const int b = seq - 16; cr[half] = P.state_in[((b * 2 + dir) * 2 + 0) * 4096 + g * 64 + p]; cim[half] = P.state_in[((b * 2 + dir) * 2 + 1) * 4096 + g * 64 + p]; }
    }
    h8 Cf[4];
#pragma unroll
    for (int kk = 0; kk < 4; ++kk)
#pragma unroll
        for (int j = 0; j < 8; ++j) { const int k = 32 * kk + 8 * q4 + j, p = k >> 1; const size_t cx = ((size_t)(dir * 64 + g) * 16 + tq) * 64 + p;
            Cf[kk][j] = (_Float16)((k & 1) ? -P.C_im[cx] : P.C_re[cx]); }
    int rowA = base + (dir ? L - 1 - n : n);
    h8 ur = *(const h8*)(up + (size_t)rowA * 16 + 8 * hi); float sqA = P.ssq[rowA];
#pragma unroll 1
    for (int jt = 0; jt < NT; ++jt) {
        const bool second = jt >= NT / 2;
        if (jt == NT / 2) {
            asm volatile("s_waitcnt vmcnt(0)" ::: "memory");
            if (lane == 0) *myflag = epoch;
            while (*pflag < epoch) __builtin_amdgcn_s_sleep(8);
            asm volatile("" ::: "memory");
        }
        int rowO[2];
#pragma unroll
        for (int nt = 0; nt < 2; ++nt) { const int s = 32 * jt + tq + 16 * nt; rowO[nt] = base + (dir ? L - 1 - s : s); }
        const float rsA = 1.0f / sqrtf(sqA * (1.f / 1024.f) + 1e-6f);
        h8 Au;
#pragma unroll
        for (int j = 0; j < 8; ++j) Au[j] = (_Float16)(rsA * (float)ur[j] + shA[j]);
        if (jt + 1 < NT) { const int s = 32 * (jt + 1) + n; rowA = base + (dir ? L - 1 - s : s); ur = *(const h8*)(up + (size_t)rowA * 16 + 8 * hi); sqA = P.ssq[rowA]; }
        const f32x16 zero = {0.f, 0.f, 0.f, 0.f, 0.f, 0.f, 0.f, 0.f, 0.f, 0.f, 0.f, 0.f, 0.f, 0.f, 0.f, 0.f};
#pragma unroll
        for (int half = 0; half < 2; ++half) {
            f32x16 xr = __builtin_amdgcn_mfma_f32_32x32x16_f16(Au, Bf[half][0], zero, 0, 0, 0);
            f32x16 xi = __builtin_amdgcn_mfma_f32_32x32x16_f16(Au, Bf[half][1], zero, 0, 0, 0);
            const float a1r = pw[half][0][0], a1i = pw[half][0][1], a4r = pw[half][3][0], a4i = pw[half][3][1];
#pragma unroll
            for (int q = 0; q < 4; ++q)
#pragma unroll
                for (int j = 1; j < 4; ++j) { const int r = 4 * q + j; const float pr = xr[r - 1], pi = xi[r - 1];
                    xr[r] = a1r * pr - a1i * pi + xr[r]; xi[r] = a1r * pi + a1i * pr + xi[r]; }
            float er[4], ei[4], per[4], pei[4];
#pragma unroll
            for (int q = 0; q < 4; ++q) { er[q] = xr[4 * q + 3]; ei[q] = xi[4 * q + 3]; per[q] = __shfl_xor(er[q], 32); pei[q] = __shfl_xor(ei[q], 32); }
            float sr = cr[half], si = cim[half], inr[4], ini[4];
#pragma unroll
            for (int i = 0; i < 8; ++i) { const int q = i >> 1; const bool own = ((i & 1) == hi);
                if ((i & 1) == 0) { inr[q] = sr; ini[q] = si; } else { inr[q] = hi ? sr : inr[q]; ini[q] = hi ? si : ini[q]; }
                const float evr = own ? er[q] : per[q], evi = own ? ei[q] : pei[q];
                const float tr = a4r * sr - a4i * si + evr; si = a4r * si + a4i * sr + evi; sr = tr; }
            cr[half] = sr; cim[half] = si;
#pragma unroll
            for (int q = 0; q < 4; ++q)
#pragma unroll
                for (int j = 0; j < 4; ++j) { const int r = 4 * q + j; const float hr = xr[r] + pw[half][j][0] * inr[q] - pw[half][j][1] * ini[q], hm = xi[r] + pw[half][j][0] * ini[q] + pw[half][j][1] * inr[q];
                    const int tau = (r & 3) + 8 * (r >> 2) + 4 * hi; h2 v; v.x = (_Float16)hr; v.y = (_Float16)hm;
                    *(S5_LAS h2*)(img + tau * IMG_PITCH + (n + 32 * half) * 4) = v; }
        }
        f32x4 ybv[2]; h4 u4[2]; float sqO[2];
        if (second) {
#pragma unroll
            for (int nt = 0; nt < 2; ++nt) { ybv[nt] = *(const f32x4*)(yb + (size_t)rowO[nt] * 16 + 4 * q4); u4[nt] = *(const h4*)(up + (size_t)rowO[nt] * 16 + 4 * q4); sqO[nt] = P.ssq[rowO[nt]]; }
        }
#pragma unroll
        for (int nt = 0; nt < 2; ++nt) {
            f32x4 acc = {0.f, 0.f, 0.f, 0.f};
#pragma unroll
            for (int kk = 0; kk < 4; ++kk) { const h8 hb = *(const S5_LAS h8*)(img + (tq + 16 * nt) * IMG_PITCH + (32 * kk + 8 * q4) * 2);
                acc = __builtin_amdgcn_mfma_f32_16x16x32_f16(Cf[kk], hb, acc, 0, 0, 0); }
            if (!second) *(f32x4*)(yb + (size_t)rowO[nt] * 16 + 4 * q4) = acc;
            else {
                const float rs = 1.0f / sqrtf(sqO[nt] * (1.f / 1024.f) + 1e-6f);
                h4 o;
#pragma unroll
                for (int j = 0; j < 4; ++j) { const float u = rs * (float)u4[nt][j] + shO[j]; o[j] = (_Float16)gelu_fast(u * dvO[j] + acc[j] + ybv[nt][j]); }
                *(h4*)(P.Y2 + ((size_t)(2 * g + (q4 >> 1)) * TT + rowO[nt]) * 8 + 4 * (q4 & 1)) = o;
            }
        }
    }
    if (ctx && hi == 0) {
#pragma unroll
        for (int half = 0; half < 2; ++half) { const int p = n + 32 * half;
            P.new_state[((seq * 2 + dir) * 2 + 0) * 4096 + g * 64 + p] = cr[half]; P.new_state[((seq * 2 + dir) * 2 + 1) * 4096 + g * 64 + p] = cim[half]; }
    }
}
__device__ __forceinline__ void s5_phase(S5_LAS unsigned char* lds, volatile S5_LAS int* flags, const Args& P, int G, int bid) {
    const int w = __builtin_amdgcn_readfirstlane(threadIdx.x >> 6), dir = w & 1;
    S5_LAS unsigned char* img = lds + w * WAVE_LDS;
    int epoch = 0;
    for (int b = bid; b < 256; b += G) {
        if (w < 4) { const int lu = 2 * b + (w >> 1); ++epoch; s5_task(img, flags + w, flags + (w ^ 1), epoch, P, 16 + (lu >> 6), lu & 63, dir); }
        else for (int r = 0; r < 2; ++r) { const int cu = 4 * b + 2 * r + ((w - 4) >> 1); ++epoch; s5_task(img, flags + w, flags + (w ^ 1), epoch, P, cu >> 6, cu & 63, dir); }
    }
}
}
#define LAS __attribute__((address_space(3)))
#define XB_TMO      128
#define XB_XCNT(j)  (256  + 64 * (j))
#define XB_XSUB(j)  (1280 + 64 * (j))
#define XB_XGEN(j)  (2304 + 64 * (j))
#define XB_TOP      3328
#define XB_TOPGEN   3392
#define XCD_BAR_WORDS 3456
#define XB_SPIN_CAP (1u << 18)
__device__ __forceinline__ unsigned xb_ld(unsigned* p)              { return __hip_atomic_load(p, __ATOMIC_RELAXED, __HIP_MEMORY_SCOPE_AGENT); }
__device__ __forceinline__ unsigned xb_add(unsigned* p, unsigned v) { return __hip_atomic_fetch_add(p, v, __ATOMIC_RELAXED, __HIP_MEMORY_SCOPE_AGENT); }
__device__ __forceinline__ unsigned xb_xcc_id() { return (unsigned)__builtin_amdgcn_s_getreg((3 << 11) | 20) & 0xFu; }
#define XB_SPIN(cond, bar) do { unsigned _sp = 0; while (cond) { __builtin_amdgcn_s_sleep(1); \
    if ((++_sp & 255u) == 0u) { if (xb_ld(&(bar)[XB_TMO])) break; if (_sp > XB_SPIN_CAP) { atomicAdd(&(bar)[XB_TMO], 1u); break; } } } } while (0)
struct XcdBarrier { unsigned* bar; unsigned x; volatile LAS unsigned* st; };
__device__ __forceinline__ XcdBarrier xcd_barrier_post(unsigned* bar, volatile LAS unsigned* st) {
    XcdBarrier b; b.bar = bar; b.x = xb_xcc_id(); b.st = st;
    if (threadIdx.x == 0) (void)xb_add(&bar[XB_XCNT(b.x)], 1u);
    return b;
}
__device__ __forceinline__ void xcd_barrier_complete(unsigned* bar, unsigned x, unsigned& nloc, unsigned& nx) {
    const unsigned G = gridDim.x * gridDim.y * gridDim.z;
    unsigned sum, cnt, mine, sp = 0u;
    for (;;) {
        sum = 0u; cnt = 0u; mine = 0u;
#pragma unroll
        for (unsigned j = 0; j < 16; ++j) { const unsigned c = xb_ld(&bar[XB_XCNT(j)]); sum += c; cnt += (c > 0u) ? 1u : 0u; mine = (j == x) ? c : mine; }
        if (sum == G) break;
        __builtin_amdgcn_s_sleep(1);
        if ((++sp & 255u) == 0u) { if (xb_ld(&bar[XB_TMO])) break; if (sp > XB_SPIN_CAP) { atomicAdd(&bar[XB_TMO], 1u); break; } }
    }
    nloc = mine > 0u ? mine : 1u; nx = cnt > 0u ? cnt : 1u;
}
__device__ __forceinline__ void xcd_barrier(const XcdBarrier& b) {
    asm volatile("s_waitcnt vmcnt(0)" ::: "memory");
    __syncthreads();
    if (threadIdx.x == 0) {
        unsigned* bar = b.bar;
        __builtin_amdgcn_s_waitcnt(0);
        unsigned nloc = b.st[0], nx = b.st[1];
        if (nloc == 0u) { xcd_barrier_complete(bar, b.x, nloc, nx); b.st[0] = nloc; b.st[1] = nx; }
        const unsigned old = xb_add(&bar[XB_XSUB(b.x)], 1u);
        const unsigned gen = old / nloc;
        if (old + 1u == (gen + 1u) * nloc) {
            __builtin_amdgcn_fence(__ATOMIC_RELEASE, "agent");
            asm volatile("s_waitcnt vmcnt(0)" ::: "memory");
            const unsigned og = xb_add(&bar[XB_TOP], 1u);
            const unsigned tg = og / nx;
            if (og + 1u == (tg + 1u) * nx) xb_add(&bar[XB_TOPGEN], 1u);
            else XB_SPIN(xb_ld(&bar[XB_TOPGEN]) == tg, bar);
            __builtin_amdgcn_fence(__ATOMIC_ACQUIRE, "agent");
            xb_add(&bar[XB_XGEN(b.x)], 1u);
            asm volatile("s_waitcnt vmcnt(0)" ::: "memory");
        } else {
            XB_SPIN(xb_ld(&bar[XB_XGEN(b.x)]) == gen, bar);
            __builtin_amdgcn_fence(__ATOMIC_ACQUIRE, "agent");
            asm volatile("s_waitcnt vmcnt(0)" ::: "memory");
        }
    }
    __syncthreads();
}

struct EpiZT { f16h* zT; const float* bias;
    __device__ __forceinline__ void operator()(const g8::f32x4 (&acc)[2][2][4][2], const g8::Unit& u, int wr, int wc, int fr, int fq) const {
        const int row0 = u.pm * 256 + wr * 64 + fr, col0 = u.pn * 256 + wc * 32 + 4 * fq;
#pragma unroll
        for (int ai = 0; ai < 2; ++ai)
#pragma unroll
            for (int m = 0; m < 4; ++m) { const int row = row0 + ai * 128 + m * 16; const float bv = bias[row];
#pragma unroll
                for (int bj = 0; bj < 2; ++bj)
#pragma unroll
                    for (int n = 0; n < 2; ++n) { const g8::f32x4 a = acc[ai][bj][m][n]; g8::u32x2 w; w.x = pkh(a[0] + bv, a[1] + bv); w.y = pkh(a[2] + bv, a[3] + bv);
                        *(g8::u32x2*)(zT + (size_t)row * 12288 + col0 + bj * 128 + n * 16) = w; } }
    } };
struct ResOut { float* X; const float* Xr; f16h* XA; const float* ng; float* ssq; const float* xp; const float* xs; const float* post; int xa_mode; int pad; };
template <bool XIN, class GV> __device__ __forceinline__ void res_group(const ResOut& R, const float* gate, const float* sc, int row0, int c, GV getval, float (&sq)[8]) {
    constexpr int NB = 8;
    const g8::f32x4 gv = *(const g8::f32x4*)(gate + c);
    g8::f32x4 gm = {0.f, 0.f, 0.f, 0.f};
    if (R.XA) { const g8::f32x4 ng = *(const g8::f32x4*)(R.ng + c), s = *(const g8::f32x4*)(sc + c); gm = ng * (s + 1.f); }
    unsigned o0 = (unsigned)row0 * 1024u + (unsigned)c;
    asm volatile("" : "+v"(o0));
    const bool lat = XIN && row0 >= NCTX;
#pragma unroll
    for (int b0 = 0; b0 < 8; b0 += NB) {
        g8::f32x4 x[NB];
#pragma unroll
        for (int k = 0; k < NB; ++k) { const int i = b0 + k; const unsigned o = o0 + (unsigned)(((i >> 2) * 128 + (i & 3) * 16) * 1024);
            if (XIN) x[k] = lat ? *(const g8::f32x4*)(R.xs + (o - (unsigned)NCTX * 1024u)) : *(const g8::f32x4*)(R.xp + o);
            else x[k] = *(const g8::f32x4*)(R.Xr + o); }
#pragma unroll
        for (int k = 0; k < NB; ++k) { const int i = b0 + k, row = row0 + (i >> 2) * 128 + (i & 3) * 16; const unsigned o = o0 + (unsigned)(((i >> 2) * 128 + (i & 3) * 16) * 1024); g8::f32x4 xv = x[k];
            if (lat) { const int t = (row - NCTX) & 1023; xv += *(const g8::f32x4*)(c < 512 ? R.post + (t >> 6) * 512 + c : R.post + 16 * 512 + (t & 63) * 512 + (c - 512)); }
            xv += gv * getval(i); *(g8::f32x4*)(R.X + o) = xv;
            sq[i] += (xv[0] * xv[0] + xv[1] * xv[1]) + (xv[2] * xv[2] + xv[3] * xv[3]);
            if (R.XA) { g8::u32x2 w; w.x = pkh(xv[0] * gm[0], xv[1] * gm[1]); w.y = pkh(xv[2] * gm[2], xv[3] * gm[3]);
                f16h* q = R.xa_mode == 0 ? R.XA + o : R.XA + ((size_t)(c >> 4) * T + row) * 16 + (c & 15);
                *(g8::u32x2*)q = w; } }
    }
}
__device__ __forceinline__ void res_ssq(const ResOut& R, int row0, int fq, float (&sq)[8]) {
    if (!R.ssq) return;
    float olds[8];
#pragma unroll
    for (int i = 0; i < 8; ++i) { float v = sq[i]; v += __shfl_xor(v, 16); v += __shfl_xor(v, 32); olds[i] = 0.f; if (fq == 0) olds[i] = atomicAdd(R.ssq + row0 + (i >> 2) * 128 + (i & 3) * 16, v); }
    asm volatile("" :: "v"(olds[0]), "v"(olds[1]), "v"(olds[2]), "v"(olds[3]), "v"(olds[4]), "v"(olds[5]), "v"(olds[6]), "v"(olds[7]));
}
template <bool XIN> struct EpiRes2 { ResOut R; const float* bias; const float* MOD; int gateoff, scoff;
    __device__ __forceinline__ void operator()(const g8::f32x4 (&acc)[2][2][4][2], const g8::Unit& u, int wr, int wc, int fr, int fq) const {
        const int row0 = u.pm * 256 + wr * 64 + fr, col0 = u.pn * 256 + wc * 32 + 4 * fq;
        const float* mb = MOD + (row_ci(u.pm * 256) * 2) * 6144; const float* gate = mb + gateoff; const float* sc = mb + scoff;
        float sq[8] = {0.f, 0.f, 0.f, 0.f, 0.f, 0.f, 0.f, 0.f};
#pragma unroll
        for (int bj = 0; bj < 2; ++bj)
#pragma unroll
            for (int n = 0; n < 2; ++n) { const int c = col0 + bj * 128 + n * 16; g8::f32x4 bv = {0.f, 0.f, 0.f, 0.f}; if (bias) bv = *(const g8::f32x4*)(bias + c);
                res_group<XIN>(R, gate, sc, row0, c, [&](int i) { return acc[i >> 2][bj][i & 3][n] + bv; }, sq); }
        res_ssq(R, row0, fq, sq);
    } };
struct EpiGlu2 { ResOut R; const float* bias; const float* MOD; int gateoff, scoff;
    __device__ __forceinline__ void operator()(const g8::f32x4 (&acc)[2][2][4][2], const g8::Unit& u, int wr, int wc, int fr, int fq) const {
        const int row0 = u.pm * 256 + wr * 64 + fr, col0 = u.pn * 128 + wc * 32 + 4 * fq;
        const float* mb = MOD + (row_ci(u.pm * 256) * 2) * 6144; const float* gate = mb + gateoff; const float* sc = mb + scoff;
        float sq[8] = {0.f, 0.f, 0.f, 0.f, 0.f, 0.f, 0.f, 0.f};
#pragma unroll
        for (int n = 0; n < 2; ++n) { const int c = col0 + n * 16; const g8::f32x4 ba = *(const g8::f32x4*)(bias + c), bg = *(const g8::f32x4*)(bias + 1024 + c);
            res_group<false>(R, gate, sc, row0, c, [&](int i) { const g8::f32x4 a = acc[i >> 2][0][i & 3][n] + ba, g = acc[i >> 2][1][i & 3][n] + bg; g8::f32x4 v;
#pragma unroll
                for (int j = 0; j < 4; ++j) v[j] = a[j] * sigmf(g[j]);
                return v; }, sq); }
        res_ssq(R, row0, fq, sq);
    } };
struct EpiSwiglu2 { f16h* hid; const float* ssq; const float* bias2;
    __device__ __forceinline__ void operator()(const g8::f32x4 (&acc)[2][2][4][2], const g8::Unit& u, int wr, int wc, int fr, int fq) const {
        const int row0 = u.pm * 256 + wr * 64 + fr, col0 = u.pn * 128 + wc * 32 + 4 * fq;
        const float* b2 = bias2 + row_ci(u.pm * 256) * 5632;
#pragma unroll
        for (int n = 0; n < 2; ++n) { const g8::f32x4 ba = *(const g8::f32x4*)(b2 + col0 + n * 16), bb = *(const g8::f32x4*)(b2 + 2816 + col0 + n * 16);
#pragma unroll
            for (int ai = 0; ai < 2; ++ai)
#pragma unroll
                for (int m = 0; m < 4; ++m) { const int row = row0 + ai * 128 + m * 16; const float rstd = 1.0f / sqrtf(ssq[row] * (1.f / 1024.f) + 1e-6f);
                    const g8::f32x4 a = acc[ai][0][m][n] * rstd + ba, b = acc[ai][1][m][n] * rstd + bb; g8::u32x2 w;
                    w.x = pkh(siluf(a[0]) * b[0], siluf(a[1]) * b[1]); w.y = pkh(siluf(a[2]) * b[2], siluf(a[3]) * b[3]);
                    *(g8::u32x2*)(hid + (size_t)row * 2816 + col0 + n * 16) = w; } }
    } };

typedef const __attribute__((address_space(4))) Params* KP;
struct Frame { LAS unsigned char* lds; int tid, lane, wave, G, bid; };
__device__ __forceinline__ float wave_sum(float v) {
#pragma unroll
    for (int o = 1; o < 64; o <<= 1) v += __shfl_xor(v, o);
    return v;
}
__device__ __forceinline__ void transpose_item(const float* W, int K, int N, f16h* WT, LAS float* scr, int item, int lane) {
    const int nblk = N / 32, kb = item / nblk, nb = item % nblk, k0 = 64 * kb, n0 = 32 * nb;
#pragma unroll 8
    for (int i = 0; i < 32; ++i) { const int kk = 2 * i + (lane >> 5); scr[kk * 33 + (lane & 31)] = W[(size_t)(k0 + kk) * N + n0 + (lane & 31)]; }
    asm volatile("s_waitcnt lgkmcnt(0)" ::: "memory");
    const int c = lane & 7;
#pragma unroll
    for (int j = 0; j < 4; ++j) { const int n = (lane >> 3) + 8 * j; const LAS float* s = scr + (8 * c) * 33 + n;
        g8::u32x4 o; o.x = pkh(s[0 * 33], s[1 * 33]); o.y = pkh(s[2 * 33], s[3 * 33]); o.z = pkh(s[4 * 33], s[5 * 33]); o.w = pkh(s[6 * 33], s[7 * 33]);
        *(g8::u32x4*)(WT + (size_t)(n0 + n) * K + k0 + 8 * c) = o; }
    asm volatile("s_waitcnt lgkmcnt(0)" ::: "memory");
}
__device__ __forceinline__ void gemv9_item(const float* W, int ldw, int col0, int kc, const LAS float* tab, float* out, int ostride, const float* bias, int lane) {
    const int col = col0 + lane; float acc[9];
#pragma unroll
    for (int ci = 0; ci < 9; ++ci) acc[ci] = 0.f;
    const float* w = W + (size_t)(kc * 64) * ldw + col;
#pragma unroll 1
    for (int c = 0; c < 4; ++c) {
        float wv[16];
#pragma unroll
        for (int k = 0; k < 16; ++k) wv[k] = w[(size_t)(16 * c + k) * ldw];
#pragma unroll
        for (int k4 = 0; k4 < 4; ++k4)
#pragma unroll
            for (int ci = 0; ci < 9; ++ci) { const g8::f32x4 s = *(const LAS g8::f32x4*)(tab + ci * 1024 + kc * 64 + 16 * c + 4 * k4); acc[ci] += s[0] * wv[4 * k4] + s[1] * wv[4 * k4 + 1] + s[2] * wv[4 * k4 + 2] + s[3] * wv[4 * k4 + 3]; }
    }
    float olds[9];
#pragma unroll
    for (int ci = 0; ci < 9; ++ci) olds[ci] = atomicAdd(out + (size_t)ci * ostride + col, acc[ci] + ((bias && kc == 0) ? bias[col] : 0.f));
    asm volatile("" :: "v"(olds[0]), "v"(olds[1]), "v"(olds[2]), "v"(olds[3]), "v"(olds[4]), "v"(olds[5]), "v"(olds[6]), "v"(olds[7]), "v"(olds[8]));
}
__device__ __forceinline__ void filt_item(const float* H2, const float* w3, float* NORM, f16h* FILT, int lv, int o, int mr, int d0, int lane, bool pass2, LAS float* hs) {
    const int L = lv ? 1024 : 256, d = d0 + lane, m0 = 32 * mr, dir = m0 >= L ? 1 : 0;
    const int extra = (!pass2 && m0 == L) ? 1 : 0;
    const int ilo = dir ? (m0 - (L - 1)) - extra : (L - 32 - m0);
    const float* h2 = H2 + (lv ? 256 : 0) * 64;
    for (int r = 0; r < 32 + extra; ++r) { const int i = ilo + r; hs[r * 64 + lane] = i < L ? h2[i * 64 + lane] : 0.f; }
    float w[64];
#pragma unroll
    for (int m = 0; m < 64; ++m) w[m] = w3[m * 4096 + o * 2048 + dir * 1024 + d];
    const double maxd = log(1e-2) / 0.3, mind = log(1e-2) / 1.5;
    const float delta = fabsf((float)(mind + (double)d * (maxd - mind) / 1023.0));
    const float tstep = (float)(1.0 / (double)(L - 1));
    float inv = 0.f; if (pass2) inv = cv::FSCALE / (NORM[(lv * 2 + o) * 1024 + d] + 1e-6f);
    float sabs = 0.f; f16h taps[32];
    asm volatile("s_waitcnt lgkmcnt(0)" ::: "memory");
#pragma unroll 1
    for (int mm = -extra; mm < 32; ++mm) {
        const int m = m0 + mm, j = (L - 1) - m, i = j < 0 ? -j : j;
        const LAS g8::f32x4* hr = (const LAS g8::f32x4*)(hs + (i - ilo) * 64);
        float a = 0.f;
#pragma unroll
        for (int q = 0; q < 16; ++q) { const g8::f32x4 h = hr[q]; a += h[0] * w[4 * q] + h[1] * w[4 * q + 1] + h[2] * w[4 * q + 2] + h[3] * w[4 * q + 3]; }
        a = i < L ? a * __expf(-(float)i * tstep * delta) : 0.f;
        sabs += fabsf(a);
        if (mm >= 0) {
#pragma unroll
            for (int q = 0; q < 32; ++q) if (q == mm) taps[q] = (f16h)(a * inv);
        }
    }
    if (!pass2) atomic_add_done(&NORM[(lv * 2 + o) * 1024 + d], sabs);
    else {
        f16h* dst = FILT + (lv ? (size_t)2 * 1024 * 512 + (size_t)(o * 1024 + d) * 2048 : (size_t)(o * 1024 + d) * 512) + m0;
#pragma unroll
        for (int q = 0; q < 4; ++q) { cv::h8 v;
#pragma unroll
            for (int e = 0; e < 8; ++e) v[e] = taps[8 * q + e];
            *(cv::h8*)(dst + 8 * q) = v; }
    }
    asm volatile("s_waitcnt lgkmcnt(0)" ::: "memory");
}
__device__ __forceinline__ void filt_items(Frame& F, KP P, int first_block, int nblocks, bool pass2) {
    const float* H2 = (const float*)(P->ws + WS_H2); float* NORM = (float*)(P->ws + WS_NORM); f16h* FILT = (f16h*)(P->ws + WS_FILT);
    if (F.bid < first_block) return;
    const int gw = (F.bid - first_block) * 8 + F.wave, NGW = nblocks * 8;
    for (int it = gw; it < 2560; it += NGW) {
        int lv, r = it; if (r < 512) lv = 0; else { lv = 1; r -= 512; }
        const int nr = lv ? 64 : 16, db = r & 15, mr = (r >> 4) % nr, o = (r >> 4) / nr;
        filt_item(H2, P->in[20], NORM, FILT, lv, o, mr, db * 64, F.lane, pass2, (LAS float*)(F.lds + F.wave * 8704));
    }
}
__device__ __forceinline__ void phase0(Frame& F, KP P, bool domods) {
    LAS float* tab = (LAS float*)F.lds;
    LAS float* scr = (LAS float*)(F.lds + 36864 + F.wave * 8448);
    for (int i = F.tid; i < 9 * 1024; i += 512) { const int ci = i >> 10, k = i & 1023; const float v = ci == 0 ? P->in[4][k] : P->in[3][(ci - 1) * 1024 + k]; tab[i] = v / (1.f + expf(-v)); }
    __syncthreads();
    const int gw = F.bid * 8 + F.wave, NGW = F.G * 8;
    float* MOD = (float*)(P->ws + WS_MOD);
    if (domods) for (int it = gw; it < 3072; it += NGW) { const int kq = it & 15, cb = (it >> 4) % 96, l = (it >> 4) / 96;
        gemv9_item(P->in[8] + (size_t)l * 1024 * 6144, 6144, cb * 64, kq, tab, MOD + l * 6144, 2 * 6144, P->in[9] + l * 6144, F.lane); }
    for (int pos = gw; pos < 1280; pos += NGW) {
        const int L = pos < 256 ? 256 : 1024, i = pos < 256 ? pos : pos - 256, lane = F.lane;
        if (lane < 33) { float z;
            if (lane == 0) z = (float)((double)i / (double)(L - 1));
            else { const int m = (lane - 1) & 15; const double band = 1e-4 + (double)m * ((15.0 - 1e-4) / 15.0), w = 2.0 * 3.14159265358979323846 * (double)i / (double)L;
                z = lane <= 16 ? (float)cos(band * w) : (float)(-sin(band * w)); }
            scr[lane] = z; }
        asm volatile("s_waitcnt lgkmcnt(0)" ::: "memory");
        float a = P->in[17][lane];
        for (int k = 0; k < 33; ++k) a += scr[k] * P->in[16][k * 64 + lane];
        scr[64 + lane] = sinf(P->in[21][lane] * a);
        asm volatile("s_waitcnt lgkmcnt(0)" ::: "memory");
        float a2 = P->in[19][lane];
        for (int k = 0; k < 64; ++k) a2 += scr[64 + k] * P->in[18][k * 64 + lane];
        ((float*)(P->ws + WS_H2))[pos * 64 + lane] = sinf(P->in[21][lane] * a2);
        asm volatile("s_waitcnt lgkmcnt(0)" ::: "memory");
    }
    { float* post = (float*)(P->ws + WS_POST);
      for (int i = F.bid * 512 + F.tid; i < 80 * 512; i += F.G * 512) { const int n = i >> 9, d = i & 511, nn = n < 16 ? n : n - 16;
          const double om = exp(-log(10000.0) * (double)(d & 255) / 256.0), ang = (double)nn * om; post[i] = (float)(d < 256 ? sin(ang) : cos(ang)); } }
    for (int ix = F.bid * 512 + F.tid; ix < 8192; ix += F.G * 512) s5::s5_table(ix, P->in[25], P->in[26], P->in[27], P->in[28], P->in[29], (float*)(P->ws + WS_S5PW), (f16h*)(P->ws + WS_S5BB));
    { constexpr int I_IN = 16 * 96, I_OUT = 16 * 32, NIT = I_IN + I_OUT;
      for (int it = gw; it < NIT; it += NGW) { int r = it;
          if (r < I_IN) { transpose_item(P->in[12], 1024, 3072, (f16h*)(P->ws + WS_WIN), scr, r, F.lane); continue; } r -= I_IN;
          transpose_item(P->in[23], 1024, 1024, (f16h*)(P->ws + WS_WOUT), scr, r, F.lane); } }
}
__device__ __forceinline__ void convert_items(Frame& F, KP P, int first, int set) {
    if (F.bid < first) return;
    LAS float* scr = (LAS float*)(F.lds + F.wave * 8448);
    const int gw = (F.bid - first) * 8 + F.wave, NGW = (F.G - first) * 8;
    constexpr int I_13 = 16 * 176, I_2 = 44 * 32, I_GLU = 16 * 64;
    const int l = set;
    const int NIT = I_13 + I_2 + (set ? I_GLU : 0);
    for (int it = gw; it < NIT; it += NGW) { int r = it;
        if (r < I_13) { transpose_item(P->in[10] + (size_t)l * 1024 * 5632, 1024, 5632, (f16h*)(P->ws + WS_W13) + (size_t)l * 5632 * 1024, scr, r, F.lane); continue; } r -= I_13;
        if (r < I_2) { transpose_item(P->in[11] + (size_t)l * 2816 * 1024, 2816, 1024, (f16h*)(P->ws + WS_W2) + (size_t)l * 1024 * 2816, scr, r, F.lane); continue; } r -= I_2;
        transpose_item(P->in[33], 1024, 2048, (f16h*)(P->ws + WS_WGLU), scr, r, F.lane); }
}
__device__ __forceinline__ void phase1(Frame& F, KP P) {
    const float* MOD = (const float*)(P->ws + WS_MOD);
    const int gw = F.bid * 8 + F.wave, NGW = F.G * 8;
    { f16h* XA = (f16h*)(P->ws + WS_XA); const float* post = (const float*)(P->ws + WS_POST); const float* ng = P->in[5];
      for (int row = gw; row < T; row += NGW) {
          const float* mb = MOD + (row_ci(row) * 2) * 6144; g8::f32x4 v[4]; float s = 0.f;
#pragma unroll
          for (int j = 0; j < 4; ++j) { const int c = 4 * F.lane + 256 * j;
              if (row < NCTX) v[j] = *(const g8::f32x4*)(P->in[0] + (size_t)row * 1024 + c);
              else { const int r = row - NCTX, t = r & 1023; v[j] = *(const g8::f32x4*)(P->in[1] + (size_t)r * 1024 + c);
                  v[j] += *(const g8::f32x4*)(c < 512 ? post + (t >> 6) * 512 + c : post + 16 * 512 + (t & 63) * 512 + (c - 512)); }
              s += (v[j][0] * v[j][0] + v[j][1] * v[j][1]) + (v[j][2] * v[j][2] + v[j][3] * v[j][3]); }
          const float rstd = 1.0f / sqrtf(wave_sum(s) * (1.f / 1024.f) + 1e-6f);
#pragma unroll
          for (int j = 0; j < 4; ++j) { const int c = 4 * F.lane + 256 * j; const g8::f32x4 g = *(const g8::f32x4*)(ng + c), sh = *(const g8::f32x4*)(mb + c), sc = *(const g8::f32x4*)(mb + 1024 + c);
              g8::u32x2 w; w.x = pkh(v[j][0] * rstd * g[0] * (1.f + sc[0]) + sh[0], v[j][1] * rstd * g[1] * (1.f + sc[1]) + sh[1]);
              w.y = pkh(v[j][2] * rstd * g[2] * (1.f + sc[2]) + sh[2], v[j][3] * rstd * g[3] * (1.f + sc[3]) + sh[3]);
              *(g8::u32x2*)(XA + (size_t)row * 1024 + c) = w; } } }
    filt_items(F, P, 0, F.G, false);
}
__device__ __forceinline__ void bias2_items(Frame& F, KP P, int first) {
    if (F.bid < first) return;
    const float* MOD = (const float*)(P->ws + WS_MOD);
    LAS float* tab = (LAS float*)F.lds;
    for (int i = F.tid; i < 2 * 9 * 1024; i += 512) { const int l = i / 9216, r = i % 9216, ci = r >> 10, k = r & 1023; tab[i] = MOD[(ci * 2 + l) * 6144 + 3072 + k]; }
    __syncthreads();
    float* BIAS2 = (float*)(P->ws + WS_BIAS2);
    const int gw = (F.bid - first) * 8 + F.wave, NGW = (F.G - first) * 8;
    for (int it = gw; it < 2816; it += NGW) { const int kq = it & 15, cb = (it >> 4) % 88, l = (it >> 4) / 88;
        gemv9_item(P->in[10] + (size_t)l * 1024 * 5632, 5632, cb * 64, kq, tab + l * 9216, BIAS2 + (size_t)l * 9 * 5632, 5632, nullptr, F.lane); }
    __syncthreads();
}
__device__ __forceinline__ void phase_final(Frame& F, KP P) {
    const float* ssq = (const float*)(P->ws + WS_SSQ) + 3 * T; const float* fg = P->in[7];
    const int gw = F.bid * 8 + F.wave, NGW = F.G * 8;
    for (int row = gw; row < T; row += NGW) { const float rstd = 1.0f / sqrtf(ssq[row] * (1.f / 1024.f) + 1e-6f); float* x = P->out + (size_t)row * 1024;
#pragma unroll
        for (int j = 0; j < 4; ++j) { const int c = 4 * F.lane + 256 * j; g8::f32x4 v = *(g8::f32x4*)(x + c); const g8::f32x4 g = *(const g8::f32x4*)(fg + c);
            v[0] *= rstd * g[0]; v[1] *= rstd * g[1]; v[2] *= rstd * g[2]; v[3] *= rstd * g[3]; *(g8::f32x4*)(x + c) = v; } }
}

#define LAUNDER(p) asm volatile("" : "+s"(p))
__global__ void __launch_bounds__(512, 2) mk_fwd(Params prm_unused) {
    extern __shared__ __attribute__((aligned(16))) unsigned char lds_raw[];
    KP kp = (KP)__builtin_amdgcn_kernarg_segment_ptr();
    Frame F; F.lds = (LAS unsigned char*)lds_raw; F.tid = threadIdx.x; F.lane = F.tid & 63; F.wave = __builtin_amdgcn_readfirstlane(F.tid >> 6); F.G = gridDim.x; F.bid = blockIdx.x;
    volatile LAS unsigned* MISC = (volatile LAS unsigned*)(F.lds + LDS_MISC);
    if (F.tid < 32) MISC[F.tid] = 0u;
    __syncthreads();
    XcdBarrier bar; bar.bar = (unsigned*)(kp->ws + CTL_BAR); bar.x = 0; bar.st = nullptr;
    if (MK_LAUNCHES == 1) bar = xcd_barrier_post((unsigned*)(kp->ws + CTL_BAR), MISC + 8);
    const int lo = kp->ph_lo, hi = kp->ph_hi;
#define IN(k) (lo <= (k) && (k) < hi)
#define SEAM(k) do { if (IN(k) && IN((k) + 1)) xcd_barrier(bar); } while (0)
#define WSP(T_, off) ((T_*)(ws + (off)))
    if (IN(0)) { LAUNDER(kp); phase0(F, kp, true); if (MK_DUP & 1) { xcd_barrier(bar); phase0(F, kp, false); } }
    SEAM(0);
    if (IN(1)) { LAUNDER(kp); phase1(F, kp); }
    SEAM(1);
    if (IN(2)) {
        LAUNDER(kp); unsigned char* ws = kp->ws;
        g8::Gemm g{ws + WS_WIN, ws + WS_XA, 1024, 2048u, 16u, 256, 128, 12, 48, 0}; g8::StaticOrder S; S.init(12, 48, F.G, F.bid);
        EpiZT E{WSP(f16h, WS_ZT), kp->in[13]}; g8::gemm_phase<EpiZT>(F.lds, g, S, E);
        bias2_items(F, kp, 64);
        filt_items(F, kp, 64, F.G - 64, true);
    }
    if (MK_DUP & (1 << 2)) { xcd_barrier(bar); if (IN(2)) {
        LAUNDER(kp); unsigned char* ws = kp->ws;
        g8::Gemm g{ws + WS_WIN, ws + WS_XA, 1024, 2048u, 16u, 256, 128, 12, 48, 0}; g8::StaticOrder S; S.init(12, 48, F.G, F.bid);
        EpiZT E{WSP(f16h, WS_ZT), kp->in[13]}; g8::gemm_phase<EpiZT>(F.lds, g, S, E);
        filt_items(F, kp, 64, F.G - 64, true);
    } }
    SEAM(2);
    if (IN(3)) { LAUNDER(kp); unsigned char* ws = kp->ws; cv::Args A{WSP(f16h, WS_ZT), WSP(const f16h, WS_FILT), kp->in[14], kp->in[15], kp->in[22], WSP(f16h, WS_V2)}; cv::conv_phase(F.lds, A, F.G, F.bid); }
    if (MK_DUP & (1 << 3)) { xcd_barrier(bar); if (IN(3)) { LAUNDER(kp); unsigned char* ws = kp->ws; cv::Args A{WSP(f16h, WS_ZT), WSP(const f16h, WS_FILT), kp->in[14], kp->in[15], kp->in[22], WSP(f16h, WS_V2)}; cv::conv_phase(F.lds, A, F.G, F.bid); } }
    SEAM(3);
    if (IN(4) && (MK_DUP & (1 << 4))) {
        LAUNDER(kp); unsigned char* ws = kp->ws;
        g8::Gemm g{ws + WS_V2, ws + WS_WOUT, 1024, 16u, 16u * 12288u, 256, 128, 48, 4, 0}; g8::StaticOrder S; S.init(48, 4, F.G, F.bid);
        EpiRes2<true> E{ResOut{WSP(float, WS_YB), kp->out, nullptr, kp->in[6], nullptr, kp->in[0], kp->in[1], WSP(const float, WS_POST), 0, 0}, kp->in[24], WSP(const float, WS_MOD), 2048, 4096};
        g8::gemm_phase<EpiRes2<true>>(F.lds, g, S, E);
    }
    if (IN(4) && (MK_DUP & (1 << 4))) xcd_barrier(bar);
    if (IN(4)) {
        LAUNDER(kp); unsigned char* ws = kp->ws;
        g8::Gemm g{ws + WS_V2, ws + WS_WOUT, 1024, 16u, 16u * 12288u, 256, 128, 48, 4, 0}; g8::StaticOrder S; S.init(48, 4, F.G, F.bid);
        EpiRes2<true> E{ResOut{kp->out, kp->out, WSP(f16h, WS_XA), kp->in[6], WSP(float, WS_SSQ), kp->in[0], kp->in[1], WSP(const float, WS_POST), 0, 0}, kp->in[24], WSP(const float, WS_MOD), 2048, 4096};
        g8::gemm_phase<EpiRes2<true>>(F.lds, g, S, E);
        convert_items(F, kp, 192, 0);
    }
    SEAM(4);
    if (IN(5)) { LAUNDER(kp); unsigned char* ws = kp->ws;
        g8::Gemm g{ws + WS_XA, ws + WS_W13, 1024, 2048u, 16u, 128, 2816, 48, 22, 0}; g8::StaticOrder S; S.init(48, 22, F.G, F.bid);
        EpiSwiglu2 E{WSP(f16h, WS_ZT), WSP(const float, WS_SSQ), WSP(const float, WS_BIAS2)}; g8::gemm_phase<EpiSwiglu2>(F.lds, g, S, E); }
    if (MK_DUP & (1 << 5)) { xcd_barrier(bar); if (IN(5)) { LAUNDER(kp); unsigned char* ws = kp->ws;
        g8::Gemm g{ws + WS_XA, ws + WS_W13, 1024, 2048u, 16u, 128, 2816, 48, 22, 0}; g8::StaticOrder S; S.init(48, 22, F.G, F.bid);
        EpiSwiglu2 E{WSP(f16h, WS_ZT), WSP(const float, WS_SSQ), WSP(const float, WS_BIAS2)}; g8::gemm_phase<EpiSwiglu2>(F.lds, g, S, E); } }
    SEAM(5);
    if (IN(6) && (MK_DUP & (1 << 6))) { LAUNDER(kp); unsigned char* ws = kp->ws;
        g8::Gemm g{ws + WS_ZT, ws + WS_W2, 2816, 5632u, 16u, 256, 128, 48, 4, 0}; g8::StaticOrder S; S.init(48, 4, F.G, F.bid);
        EpiRes2<false> E{ResOut{WSP(float, WS_YB), kp->out, nullptr, kp->in[5] + D, nullptr, nullptr, nullptr, nullptr, 1, 0}, nullptr, WSP(const float, WS_MOD), 5120, 6144 + 1024};
        g8::gemm_phase<EpiRes2<false>>(F.lds, g, S, E); }
    if (IN(6) && (MK_DUP & (1 << 6))) xcd_barrier(bar);
    if (IN(6)) { LAUNDER(kp); unsigned char* ws = kp->ws;
        g8::Gemm g{ws + WS_ZT, ws + WS_W2, 2816, 5632u, 16u, 256, 128, 48, 4, 0}; g8::StaticOrder S; S.init(48, 4, F.G, F.bid);
        EpiRes2<false> E{ResOut{kp->out, kp->out, WSP(f16h, WS_XA), kp->in[5] + D, WSP(float, WS_SSQ) + T, nullptr, nullptr, nullptr, 1, 0}, nullptr, WSP(const float, WS_MOD), 5120, 6144 + 1024};
        g8::gemm_phase<EpiRes2<false>>(F.lds, g, S, E); convert_items(F, kp, 192, 1); }
    SEAM(6);
    if (IN(7)) { LAUNDER(kp); unsigned char* ws = kp->ws;
        s5::Args A{WSP(const f16h, WS_XA), WSP(const float, WS_SSQ) + T, WSP(const float, WS_MOD), WSP(const float, WS_S5PW), WSP(const f16h, WS_S5BB), kp->in[30], kp->in[31], kp->in[32], kp->in[2], WSP(float, WS_YB), WSP(f16h, WS_V2), kp->out + (size_t)T * D};
        if (F.tid < 8) MISC[16 + F.tid] = 0u; __syncthreads(); s5::s5_phase(F.lds, (volatile LAS int*)(MISC + 16), A, F.G, F.bid); }
    if (MK_DUP & (1 << 7)) { xcd_barrier(bar); if (IN(7)) { LAUNDER(kp); unsigned char* ws = kp->ws;
        s5::Args A{WSP(const f16h, WS_XA), WSP(const float, WS_SSQ) + T, WSP(const float, WS_MOD), WSP(const float, WS_S5PW), WSP(const f16h, WS_S5BB), kp->in[30], kp->in[31], kp->in[32], kp->in[2], WSP(float, WS_YB), WSP(f16h, WS_V2), kp->out + (size_t)T * D};
        if (F.tid < 8) MISC[16 + F.tid] = 0u; __syncthreads(); s5::s5_phase(F.lds, (volatile LAS int*)(MISC + 16), A, F.G, F.bid); } }
    SEAM(7);
    if (IN(8) && (MK_DUP & (1 << 8))) { LAUNDER(kp); unsigned char* ws = kp->ws;
        g8::Gemm g{ws + WS_V2, ws + WS_WGLU, 1024, 16u, 16u * 12288u, 128, 1024, 48, 8, 0}; g8::StaticOrder S; S.init(48, 8, F.G, F.bid);
        EpiGlu2 E{ResOut{WSP(float, WS_YB), kp->out, nullptr, kp->in[6] + D, nullptr, nullptr, nullptr, nullptr, 0, 0}, kp->in[34], WSP(const float, WS_MOD), 6144 + 2048, 6144 + 4096};
        g8::gemm_phase<EpiGlu2>(F.lds, g, S, E); }
    if (IN(8) && (MK_DUP & (1 << 8))) xcd_barrier(bar);
    if (IN(8)) { LAUNDER(kp); unsigned char* ws = kp->ws;
        g8::Gemm g{ws + WS_V2, ws + WS_WGLU, 1024, 16u, 16u * 12288u, 128, 1024, 48, 8, 0}; g8::StaticOrder S; S.init(48, 8, F.G, F.bid);
        EpiGlu2 E{ResOut{kp->out, kp->out, WSP(f16h, WS_XA), kp->in[6] + D, WSP(float, WS_SSQ) + 2 * T, nullptr, nullptr, nullptr, 0, 0}, kp->in[34], WSP(const float, WS_MOD), 6144 + 2048, 6144 + 4096};
        g8::gemm_phase<EpiGlu2>(F.lds, g, S, E); }
    SEAM(8);
    if (IN(9)) { LAUNDER(kp); unsigned char* ws = kp->ws;
        g8::Gemm g{ws + WS_XA, ws + WS_W13 + (size_t)5632 * 1024 * 2, 1024, 2048u, 16u, 128, 2816, 48, 22, 0}; g8::StaticOrder S; S.init(48, 22, F.G, F.bid);
        EpiSwiglu2 E{WSP(f16h, WS_ZT), WSP(const float, WS_SSQ) + 2 * T, WSP(const float, WS_BIAS2) + 9 * 5632}; g8::gemm_phase<EpiSwiglu2>(F.lds, g, S, E); }
    SEAM(9);
    if (IN(10) && (MK_DUP & (1 << 10))) { LAUNDER(kp); unsigned char* ws = kp->ws;
        g8::Gemm g{ws + WS_ZT, ws + WS_W2 + (size_t)1024 * 2816 * 2, 2816, 5632u, 16u, 256, 128, 48, 4, 0}; g8::StaticOrder S; S.init(48, 4, F.G, F.bid);
        EpiRes2<false> E{ResOut{WSP(float, WS_YB), kp->out, nullptr, nullptr, nullptr, nullptr, nullptr, nullptr, 0, 0}, nullptr, WSP(const float, WS_MOD), 6144 + 5120, 0};
        g8::gemm_phase<EpiRes2<false>>(F.lds, g, S, E); }
    if (IN(10) && (MK_DUP & (1 << 10))) xcd_barrier(bar);
    if (IN(10)) { LAUNDER(kp); unsigned char* ws = kp->ws;
        g8::Gemm g{ws + WS_ZT, ws + WS_W2 + (size_t)1024 * 2816 * 2, 2816, 5632u, 16u, 256, 128, 48, 4, 0}; g8::StaticOrder S; S.init(48, 4, F.G, F.bid);
        EpiRes2<false> E{ResOut{kp->out, kp->out, nullptr, nullptr, WSP(float, WS_SSQ) + 3 * T, nullptr, nullptr, nullptr, 0, 0}, nullptr, WSP(const float, WS_MOD), 6144 + 5120, 0};
        g8::gemm_phase<EpiRes2<false>>(F.lds, g, S, E); }
    SEAM(10);
    if (IN(11)) { LAUNDER(kp); phase_final(F, kp); }
#undef IN
#undef SEAM
#undef WSP
}

extern "C" void kernel_launch(void* const* d_in, const int* in_sizes, int n_in, void* d_out, int out_size, void* d_ws, size_t ws_size, hipStream_t stream) {
    static int grid = 0;
    if (grid == 0) {
        if (n_in != 35 || ws_size < WS_END) { fprintf(stderr, "kernel_launch: unexpected n_in %d / ws %zu\n", n_in, ws_size); grid = -1; return; }
        int dev = 0, cus = 0, per_cu = 0;
        if (hipGetDevice(&dev) != hipSuccess || hipDeviceGetAttribute(&cus, hipDeviceAttributeMultiprocessorCount, dev) != hipSuccess) { grid = -1; return; }
        if (hipFuncSetAttribute((const void*)mk_fwd, hipFuncAttributeMaxDynamicSharedMemorySize, LDS_BYTES) != hipSuccess) { fprintf(stderr, "kernel_launch: hipFuncSetAttribute failed\n"); grid = -1; return; }
        if (hipOccupancyMaxActiveBlocksPerMultiprocessor(&per_cu, (const void*)mk_fwd, 512, LDS_BYTES) != hipSuccess || per_cu < 1) { fprintf(stderr, "kernel_launch: occupancy query says %d\n", per_cu); per_cu = 1; }
        (void)hipGetLastError();
        grid = cus;
    }
    if (grid < 0) return;
    (void)hipMemsetAsync((char*)d_ws + WS_CTL, 0, CTL_ZERO_BYTES, stream);
    Params p; memset(&p, 0, sizeof(p));
    for (int i = 0; i < 35; ++i) p.in[i] = (const float*)d_in[i];
    p.out = (float*)d_out; p.ws = (unsigned char*)d_ws;
    if (MK_LAUNCHES == 1) { p.ph_lo = 0; p.ph_hi = NPH; hipLaunchKernelGGL(mk_fwd, dim3(grid), dim3(512), LDS_BYTES, stream, p); }
    else for (int k = 0; k < NPH; ++k) { p.ph_lo = k; p.ph_hi = k + 1; hipLaunchKernelGGL(mk_fwd, dim3(grid), dim3(512), LDS_BYTES, stream, p); }
}
```

```cpp
#include <hip/hip_runtime.h>
#include <math.h>
#include <string.h>
#include <stdio.h>

#ifndef MK_DUP
#define MK_DUP 0
#endif
#ifndef MK_LAUNCHES
#define MK_LAUNCHES 1
#endif
constexpr int D = 1024, NCTX = 4096, NLAT = 8192, T = 12288, F = 2816, NPH = 11;
constexpr size_t MiB = 1u << 20;
typedef _Float16 f16h;
constexpr size_t WS_CTL = 0, CTL_ZERO_BYTES = 2 * MiB;
constexpr size_t CTL_BAR = 16384;
constexpr size_t CTL_PANEL = 32768;
constexpr size_t WS_MOD = 65536;
constexpr size_t WS_SSQ = 524288;
constexpr size_t WS_NORM = 720896;
constexpr size_t WS_BIAS2 = 786432;
constexpr size_t WS_H2 = 2 * MiB;
constexpr size_t WS_POST = 2 * MiB + 512 * 1024;
constexpr size_t WS_S5PW = 2 * MiB + 768 * 1024;
constexpr size_t WS_S5BB = 3 * MiB;
constexpr size_t WS_FILT = 4 * MiB;
constexpr size_t WS_WIN = 24 * MiB, WS_WOUT = 30 * MiB, WS_W13 = 32 * MiB  , WS_W2 = 54 * MiB  , WS_WGLU = 65 * MiB;
constexpr size_t WS_XA = 70 * MiB;
constexpr size_t WS_V2 = 94 * MiB;
constexpr size_t WS_ZT = 118 * MiB;
constexpr size_t WS_YB = 190 * MiB;
constexpr size_t WS_END = 238 * MiB;
constexpr int LDS_BYTES = 135168;
constexpr int LDS_MISC = 133120;

__device__ __forceinline__ int row_ci(int row) { return row < NCTX ? 0 : 1 + ((row - NCTX) >> 10); }
__device__ __forceinline__ float siluf(float v) { return v * __builtin_amdgcn_rcpf(1.f + __expf(-v)); }
__device__ __forceinline__ float sigmf(float v) { return __builtin_amdgcn_rcpf(1.f + __expf(-v)); }
__device__ __forceinline__ unsigned pkh(float a, float b) { typedef _Float16 h2 __attribute__((ext_vector_type(2))); h2 v; v.x = (_Float16)a; v.y = (_Float16)b; return __builtin_bit_cast(unsigned, v); }

__device__ __forceinline__ void atomic_add_done(float* p, float v) { const float old = atomicAdd(p, v); asm volatile("" :: "v"(old)); }
struct Params { const float* in[35]; float* out; unsigned char* ws; int ph_lo, ph_hi; };
namespace g8 {
#define G8_LAS __attribute__((address_space(3)))
typedef _Float16 h8 __attribute__((ext_vector_type(8)));
typedef float f32x4 __attribute__((ext_vector_type(4)));
typedef unsigned u32x4 __attribute__((ext_vector_type(4)));
typedef unsigned u32x2 __attribute__((ext_vector_type(2)));
constexpr int BM = 256, BK = 64, HALF = 128, HTB = HALF * BK * 2, STAGE_BYTES = 8 * HTB, NXCD = 8, WGM = 8;
__host__ __device__ __forceinline__ int lds_byte(int r, int c) { const int st = (r >> 4) * 2 + (c >> 5), rr = r & 15, cc = c & 31, ob = rr * 64 + cc * 2; return st * 1024 + (ob ^ (((ob >> 9) & 1) << 5)); }
__host__ __device__ __forceinline__ void stage_rc(int b, int& R, int& C) { const int st = b / 1024, sb = b % 1024, swz = sb ^ (((sb >> 9) & 1) << 5); R = (st >> 1) * 16 + swz / 64; C = (st & 1) * 32 + (swz % 64) / 2; }
struct Unit { int pm, pn; };
struct Gemm { const void* A; const void* Bt; int K; unsigned a_row, a_k8; int b_tile_rows, b_half_rows; int nM, nN; int pad; };
struct StaticOrder {
    int nM, nN, nwg, G, c;
    __device__ void init(int nM_, int nN_, int G_, int c_) { nM = nM_; nN = nN_; nwg = nM * nN; G = G_; c = c_; }
    __device__ bool next(int i, Unit& u) const {
        const long L = (long)i * G + c; if (L >= nwg) return false;
        int wgid = (int)L; { const int q = nwg / NXCD, r = nwg % NXCD, xcd = wgid % NXCD, off = wgid / NXCD; wgid = (xcd < r ? xcd * (q + 1) : r * (q + 1) + (xcd - r) * q) + off; }
        const int nig = WGM * nN, gid = wgid / nig, fm = gid * WGM, gsz = (nM - fm) < WGM ? (nM - fm) : WGM;
        u.pm = fm + ((wgid % nig) % gsz); u.pn = (wgid % nig) / gsz; return true;
    }
};
template <class Epi>
__device__ __forceinline__ void gemm_phase(G8_LAS unsigned char* lds, const Gemm g, const StaticOrder& S, const Epi& E) {
    const int tid = threadIdx.x, wid = __builtin_amdgcn_readfirstlane(tid >> 6), lane = tid & 63, wr = wid >> 2, wc = wid & 3, fr = lane & 15, fq = lane >> 4;
    const int K = g.K, nt = K / BK;
    unsigned voffA[2], voffB[2];
#pragma unroll
    for (int i = 0; i < 2; ++i) { int R, C; stage_rc(tid * 16 + i * 8192, R, C);
        voffA[i] = (unsigned)R * g.a_row + (unsigned)(C >> 3) * g.a_k8; voffB[i] = (unsigned)(R * K + C) * 2u; }
    const size_t kstepA = (size_t)8 * g.a_k8, kstepB = (size_t)(BK * 2);
    const size_t hstepA = (size_t)HALF * g.a_row, tstepA = 2 * hstepA;
    const size_t hstepB = (size_t)g.b_half_rows * K * 2, tstepB = (size_t)g.b_tile_rows * K * 2;
    const unsigned ldsw = (unsigned)wid * 1024u;
    const int aoff = lds_byte(wr * 64 + fr, fq * 8), boff = lds_byte(wc * 32 + fr, fq * 8);
#define G8_SA(b, h) (((b) * 2 + (h)) * HTB)
#define G8_SB(b, h) ((4 + (b) * 2 + (h)) * HTB)
#define G8_STAGE(bufoff, gbase, voff) do { _Pragma("unroll") for (int _i = 0; _i < 2; ++_i) \
        __builtin_amdgcn_global_load_lds((const unsigned*)((const char*)(gbase) + (voff)[_i]), (G8_LAS unsigned*)(lds + (bufoff) + ldsw + _i * 8192), 16, 0, 0); } while (0)
#define G8_LDA(dst, b, h) do { _Pragma("unroll") for (int m = 0; m < 4; ++m) _Pragma("unroll") for (int k = 0; k < 2; ++k) dst[m][k] = *(const G8_LAS h8*)(lds + G8_SA(b, h) + aoff + m * 2048 + k * 1024); } while (0)
#define G8_LDB(dst, b, h) do { _Pragma("unroll") for (int n = 0; n < 2; ++n) _Pragma("unroll") for (int k = 0; k < 2; ++k) dst[n][k] = *(const G8_LAS h8*)(lds + G8_SB(b, h) + boff + n * 2048 + k * 1024); } while (0)
#define G8_MMA(ai, bj, At, Bt) do { __builtin_amdgcn_s_setprio(1); _Pragma("unroll") for (int m = 0; m < 4; ++m) _Pragma("unroll") for (int n = 0; n < 2; ++n) _Pragma("unroll") for (int k = 0; k < 2; ++k) \
        acc[ai][bj][m][n] = __builtin_amdgcn_mfma_f32_16x16x32_f16(Bt[n][k], At[m][k], acc[ai][bj][m][n], 0, 0, 0); __builtin_amdgcn_s_setprio(0); } while (0)
#define G8_WAIT_V(n) asm volatile("s_waitcnt vmcnt(" #n ")" ::: "memory")
#define G8_WAIT_L(n) asm volatile("s_waitcnt lgkmcnt(" #n ")" ::: "memory")
#define G8_BAR __builtin_amdgcn_s_barrier()
#define G8_SCHED __builtin_amdgcn_sched_barrier(0)
    Unit cur, nxt; int ui = 0;
    if (!S.next(0, cur)) return;
    f32x4 acc[2][2][4][2];
#pragma unroll
    for (int a = 0; a < 2; ++a)
#pragma unroll
        for (int b = 0; b < 2; ++b)
#pragma unroll
            for (int m = 0; m < 4; ++m)
#pragma unroll
                for (int n = 0; n < 2; ++n) acc[a][b][m][n] = (f32x4){0.f, 0.f, 0.f, 0.f};
    h8 At[4][2], B0[2][2], B1[2][2];
    const char* cA = (const char*)g.A + (size_t)cur.pm * tstepA; const char* cB = (const char*)g.Bt + (size_t)cur.pn * tstepB;
    G8_STAGE(G8_SB(0, 0), cB, voffB); G8_STAGE(G8_SB(0, 1), cB + hstepB, voffB); G8_STAGE(G8_SA(0, 0), cA, voffA); G8_STAGE(G8_SA(0, 1), cA + hstepA, voffA);
    if (wr == 1) G8_BAR;
    G8_WAIT_V(2); G8_BAR;
    G8_STAGE(G8_SB(1, 0), cB + kstepB, voffB); G8_STAGE(G8_SA(1, 0), cA + kstepA, voffA); G8_STAGE(G8_SB(1, 1), cB + hstepB + kstepB, voffB);
    G8_WAIT_V(6); G8_BAR;
    for (;;) {
        const bool has_next = S.next(ui + 1, nxt);
        const char* nA = has_next ? (const char*)g.A + (size_t)nxt.pm * tstepA : cA; const char* nB = has_next ? (const char*)g.Bt + (size_t)nxt.pn * tstepB : cB;
        for (int t = 0; t < nt; t += 2) {
            const bool last = (t == nt - 2);
            const char* a1 = cA + (size_t)(t + 1) * kstepA;
            const char* a2 = last ? nA : cA + (size_t)(t + 2) * kstepA; const char* b2 = last ? nB : cB + (size_t)(t + 2) * kstepB;
            const char* a3 = a2 + kstepA; const char* b3 = b2 + kstepB;
            G8_LDB(B0, 0, 0); G8_LDB(B1, 0, 1); G8_SCHED; G8_LDA(At, 0, 0); G8_STAGE(G8_SA(1, 1), a1 + hstepA, voffA);
            G8_WAIT_V(8); G8_WAIT_L(0); G8_BAR; G8_MMA(0, 0, At, B0); G8_MMA(0, 1, At, B1); G8_BAR; G8_SCHED;
            G8_LDA(At, 0, 1); G8_STAGE(G8_SB(0, 0), b2, voffB); G8_STAGE(G8_SB(0, 1), b2 + hstepB, voffB); G8_STAGE(G8_SA(0, 0), a2, voffA);
            G8_WAIT_V(8); G8_WAIT_L(0); G8_BAR; G8_MMA(1, 0, At, B0); G8_MMA(1, 1, At, B1); G8_BAR; G8_SCHED;
            G8_LDB(B0, 1, 0); G8_LDB(B1, 1, 1); G8_SCHED; G8_LDA(At, 1, 0); G8_STAGE(G8_SA(0, 1), a2 + hstepA, voffA);
            G8_WAIT_V(8); G8_WAIT_L(0); G8_BAR; G8_MMA(0, 0, At, B0); G8_MMA(0, 1, At, B1); G8_BAR; G8_SCHED;
            G8_LDA(At, 1, 1); G8_STAGE(G8_SB(1, 0), b3, voffB); G8_STAGE(G8_SB(1, 1), b3 + hstepB, voffB); G8_STAGE(G8_SA(1, 0), a3, voffA);
            G8_WAIT_V(8); G8_WAIT_L(0); G8_BAR; G8_MMA(1, 0, At, B0); G8_MMA(1, 1, At, B1); G8_BAR; G8_SCHED;
        }
        if (wr == 0) G8_BAR;
        E(acc, cur, wr, wc, fr, fq);
        if (!has_next) break;
#pragma unroll
        for (int a = 0; a < 2; ++a)
#pragma unroll
            for (int b = 0; b < 2; ++b)
#pragma unroll
                for (int m = 0; m < 4; ++m)
#pragma unroll
                    for (int n = 0; n < 2; ++n) acc[a][b][m][n] = (f32x4){0.f, 0.f, 0.f, 0.f};
        cur = nxt; cA = nA; cB = nB; ++ui;
        if (wr == 1) G8_BAR;
    }
    G8_WAIT_V(0);
    G8_BAR;
#undef G8_SA
#undef G8_SB
#undef G8_STAGE
#undef G8_LDA
#undef G8_LDB
#undef G8_MMA
#undef G8_WAIT_V
#undef G8_WAIT_L
#undef G8_BAR
#undef G8_SCHED
}
}
namespace cv {
#define CV_LAS __attribute__((address_space(3)))
typedef _Float16 h8 __attribute__((ext_vector_type(8)));
typedef _Float16 h4 __attribute__((ext_vector_type(4)));
typedef float f32x16 __attribute__((ext_vector_type(16)));
typedef unsigned u4 __attribute__((ext_vector_type(4)));
typedef unsigned u2 __attribute__((ext_vector_type(2)));
template <int N> struct IC { static constexpr int value = N; };
constexpr int WAVE_LDS = 16640, V_OFF = 0, ZERO_OFF = 8256, FA_OFF = 8320, FB_OFF = 12480;
constexpr float FSCALE = 64.f;
struct Args { const _Float16* zT; const _Float16* FILT; const float* conv_w; const float* conv_b; const float* fbias; _Float16* V2; };
__host__ __device__ __forceinline__ size_t filt_off(int lv, int o, int ch) { return lv ? (size_t)2 * 1024 * 512 + (size_t)(o * 1024 + ch) * 2048 : (size_t)(o * 1024 + ch) * 512; }
template <int LV> __device__ __forceinline__ void conv_unit(CV_LAS unsigned char* lds, const Args& P, int c, int bh) {
    constexpr int L = LV ? 1024 : 256, NBu = LV ? 4 : 8, T1 = L / 32, T1L = LV ? 8 : 4, NCT = T1 / T1L, PV = L * 2 + 16;
    const int tid = threadIdx.x, w = __builtin_amdgcn_readfirstlane(tid >> 6), lane = tid & 63;
    const int ch = 8 * c + w;
    const int row_base = LV ? 4096 + (4 * bh) * 1024 : (8 * bh) * 256;
    CV_LAS unsigned char* wl = lds + w * WAVE_LDS;
    auto load_row = [&](int chx, int dst) {
        const _Float16* zrow = P.zT + (size_t)chx * 12288 + row_base;
        const float w0 = P.conv_w[chx], w1 = P.conv_w[3072 + chx], w2 = P.conv_w[6144 + chx], cb = P.conv_b[chx];
        constexpr int NP = NBu * L / 8 / 64;
#pragma unroll
        for (int p0 = 0; p0 < NP; p0 += 4) {
            h8 raw[4]; float zp[4], zn[4];
#pragma unroll
            for (int q = 0; q < 4; ++q) { const int piece = lane + 64 * (p0 + q), b2 = piece / (L / 8), t0 = (piece % (L / 8)) * 8;
                raw[q] = *(const h8*)(zrow + b2 * L + t0);
                zp[q] = t0 > 0 ? (float)zrow[b2 * L + t0 - 1] : 0.f; zn[q] = t0 + 8 < L ? (float)zrow[b2 * L + t0 + 8] : 0.f; }
#pragma unroll
            for (int q = 0; q < 4; ++q) { const int piece = lane + 64 * (p0 + q), b2 = piece / (L / 8), t0 = (piece % (L / 8)) * 8;
                float z[10]; z[0] = zp[q]; z[9] = zn[q];
#pragma unroll
                for (int i = 0; i < 8; ++i) z[i + 1] = (float)raw[q][i];
                h8 o;
#pragma unroll
                for (int i = 0; i < 8; ++i) o[i] = (_Float16)(w0 * z[i] + w1 * z[i + 1] + w2 * z[i + 2] + cb);
                *(CV_LAS h8*)(wl + dst + b2 * PV + t0 * 2) = o; }
        }
    };
    load_row(ch, V_OFF);
    if (lane < 16) *(CV_LAS unsigned*)(wl + ZERO_OFF + lane * 4) = 0u;
    const int t2 = lane & 31, hi = lane >> 5, col = lane & 31, bl = col / T1L, t1l = col % T1L;
    const int abase = (t2 & 1) ? FA_OFF + 2 * ((L - 1) - t2 + 8 * hi) : FB_OFF + 2 * ((L - 1) - t2 + 8 * hi - 1);
    const int vbase = V_OFF + bl * PV + 16 * hi;
#pragma unroll 1
    for (int o = 0; o < 2; ++o) {
        {
            const u4* Fg = (const u4*)(P.FILT + filt_off(LV, o, ch));
            for (int piece = lane; piece < 2 * L / 8; piece += 64) {
                const u4 a = Fg[piece]; const unsigned e0 = piece + 1 < 2 * L / 8 ? ((const unsigned*)(Fg + piece + 1))[0] : 0u;
                u4 b; b.x = (a.x >> 16) | (a.y << 16); b.y = (a.y >> 16) | (a.z << 16); b.z = (a.z >> 16) | (a.w << 16); b.w = (a.w >> 16) | (e0 << 16);
                *(CV_LAS u4*)(wl + FA_OFF + piece * 16) = a;
                *(CV_LAS u4*)(wl + FB_OFF + piece * 16) = b;
            }
        }
        f32x16 acc[NCT];
#pragma unroll
        for (int ct = 0; ct < NCT; ++ct)
#pragma unroll
            for (int r = 0; r < 16; ++r) acc[ct][r] = 0.f;
        auto ldA = [&](int d, h8& A0, h8& A1) { const CV_LAS unsigned* ap = (const CV_LAS unsigned*)(wl + abase - 64 * d); u4 a0, a1;
            a0.x = ap[0]; a0.y = ap[1]; a0.z = ap[2]; a0.w = ap[3]; a1.x = ap[8]; a1.y = ap[9]; a1.z = ap[10]; a1.w = ap[11];
            A0 = __builtin_bit_cast(h8, a0); A1 = __builtin_bit_cast(h8, a1); };
        auto ldB = [&](int d, int ct, h8& b0, h8& b1) { const int s1 = ct * T1L - d + t1l; const bool valid = (unsigned)s1 < (unsigned)T1;
            const int off = valid ? vbase + s1 * 64 : ZERO_OFF;
            b0 = *(const CV_LAS h8*)(wl + off); b1 = *(const CV_LAS h8*)(wl + off + 32); };
        auto seg = [&](auto lo_c, auto hi_c, int dlo, int dhi) {
            constexpr int LO = decltype(lo_c)::value, HI = decltype(hi_c)::value, NL = HI - LO + 1;
            h8 A0, A1, b0[NL], b1[NL];
            ldA(dlo, A0, A1);
#pragma unroll
            for (int k = 0; k < NL; ++k) ldB(dlo, LO + k, b0[k], b1[k]);
            h8 B0_[NL], B1_[NL], C0, C1, c0[NL], c1[NL];
#pragma unroll 1
            for (int d = dlo; d <= dhi; d += 2) {
                const int d1 = d + 1 <= dhi ? d + 1 : d, d2 = d + 2 <= dhi ? d + 2 : d1;
                ldA(d1, C0, C1);
#pragma unroll
                for (int k = 0; k < NL; ++k) ldB(d1, LO + k, c0[k], c1[k]);
                __builtin_amdgcn_sched_barrier(0);
#pragma unroll
                for (int k = 0; k < NL; ++k) {
                    acc[LO + k] = __builtin_amdgcn_mfma_f32_32x32x16_f16(A0, b0[k], acc[LO + k], 0, 0, 0);
                    acc[LO + k] = __builtin_amdgcn_mfma_f32_32x32x16_f16(A1, b1[k], acc[LO + k], 0, 0, 0);
                }
                __builtin_amdgcn_sched_barrier(0);
                ldA(d2, A0, A1);
#pragma unroll
                for (int k = 0; k < NL; ++k) ldB(d2, LO + k, b0[k], b1[k]);
                __builtin_amdgcn_sched_barrier(0);
                if (d + 1 <= dhi) {
#pragma unroll
                    for (int k = 0; k < NL; ++k) {
                        acc[LO + k] = __builtin_amdgcn_mfma_f32_32x32x16_f16(C0, c0[k], acc[LO + k], 0, 0, 0);
                        acc[LO + k] = __builtin_amdgcn_mfma_f32_32x32x16_f16(C1, c1[k], acc[LO + k], 0, 0, 0);
                    }
                }
                __builtin_amdgcn_sched_barrier(0);
            }
            (void)B0_; (void)B1_;
        };
        if constexpr (NCT == 4) {
            seg(IC<0>{}, IC<0>{}, -(T1 - 1), -(T1 - 1) + T1L - 1);
            seg(IC<0>{}, IC<1>{}, -(T1 - 1) + T1L, -(T1 - 1) + 2 * T1L - 1);
            seg(IC<0>{}, IC<2>{}, -(T1 - 1) + 2 * T1L, -(T1 - 1) + 3 * T1L - 1);
            seg(IC<0>{}, IC<3>{}, -(T1 - 1) + 3 * T1L, T1L - 1);
            seg(IC<1>{}, IC<3>{}, T1L, 2 * T1L - 1);
            seg(IC<2>{}, IC<3>{}, 2 * T1L, 3 * T1L - 1);
            seg(IC<3>{}, IC<3>{}, 3 * T1L, 4 * T1L - 1);
        } else {
            seg(IC<0>{}, IC<0>{}, -(T1 - 1), -(T1 - 1) + T1L - 1);
            seg(IC<0>{}, IC<1>{}, -(T1 - 1) + T1L, T1L - 1);
            seg(IC<1>{}, IC<1>{}, T1L, 2 * T1L - 1);
        }
        {
            load_row((o + 1) * 1024 + ch, FA_OFF);
            const float fbv = P.fbias[o * 1024 + ch];
#pragma unroll
            for (int ct = 0; ct < NCT; ++ct)
#pragma unroll
                for (int g = 0; g < 4; ++g) {
                    const int t = 32 * (ct * T1L + t1l) + 8 * g + 4 * hi;
                    const h4 gt = *(const CV_LAS h4*)(wl + FA_OFF + bl * PV + t * 2);
                    CV_LAS h4* vp = (CV_LAS h4*)(wl + V_OFF + bl * PV + t * 2);
                    const h4 vin = *vp; h4 vo;
#pragma unroll
                    for (int i = 0; i < 4; ++i) vo[i] = (_Float16)((acc[ct][4 * g + i] * (1.f / FSCALE) + (float)vin[i] * fbv) * (float)gt[i]);
                    *vp = vo;
                }
        }
    }
    __syncthreads();
    for (int idx = tid; idx < NBu * L; idx += 512) {
        const int b2 = idx / L, t = idx % L; h8 o;
#pragma unroll
        for (int ww = 0; ww < 8; ++ww) o[ww] = *(const CV_LAS _Float16*)(lds + ww * WAVE_LDS + V_OFF + b2 * PV + t * 2);
        *(h8*)(P.V2 + ((size_t)c * 12288 + row_base + b2 * L + t) * 8) = o;
    }
    __syncthreads();
}
__device__ __forceinline__ void conv_phase(CV_LAS unsigned char* lds, const Args& P, int G, int bid) {
    for (int u = bid; u < 256; u += G) conv_unit<1>(lds, P, u >> 1, u & 1);
    for (int u = bid; u < 256; u += G) conv_unit<0>(lds, P, u >> 1, u & 1);
}
}
namespace s5 {
#define S5_LAS __attribute__((address_space(3)))
typedef _Float16 h8 __attribute__((ext_vector_type(8)));
typedef _Float16 h4 __attribute__((ext_vector_type(4)));
typedef _Float16 h2 __attribute__((ext_vector_type(2)));
typedef float f32x16 __attribute__((ext_vector_type(16)));
typedef float f32x4 __attribute__((ext_vector_type(4)));
constexpr int IMG_PITCH = 288, WAVE_LDS = 32 * IMG_PITCH;
constexpr int TT = 12288;
struct Args { const _Float16* UP; const float* ssq; const float* MOD; const float* PW; const _Float16* BB;
              const float* C_re; const float* C_im; const float* Dv; const float* state_in; float* YB; _Float16* Y2; float* new_state; };
__device__ __forceinline__ float gelu_fast(float x) { const float u = 1.5957691216057308f * (x + 0.044715f * x * x * x); return x * __builtin_amdgcn_rcpf(1.f + __expf(-u)); }
__device__ __forceinline__ void s5_table(int ix, const float* A_re, const float* A_im, const float* log_dt, const float* B_re, const float* B_im, float* PW, _Float16* BB) {
    const double are = A_re[ix], aim = A_im[ix], dt = exp((double)log_dt[ix >> 6]);
    const double mag = exp(dt * are), ph = dt * aim, abr = mag * cos(ph), abi = mag * sin(ph);
    const double nr = abr - 1.0, ni = abi, den = are * are + aim * aim, cor = (nr * are + ni * aim) / den, coi = (ni * are - nr * aim) / den;
    double pr = abr, pi = abi;
    for (int k = 0; k < 4; ++k) { PW[(size_t)ix * 8 + 2 * k] = (float)pr; PW[(size_t)ix * 8 + 2 * k + 1] = (float)pi; const double tr = pr * abr - pi * abi; pi = pr * abi + pi * abr; pr = tr; }
    for (int h = 0; h < 16; ++h) { const double br = B_re[(size_t)ix * 16 + h], bi = B_im[(size_t)ix * 16 + h];
        BB[(size_t)ix * 32 + h] = (_Float16)(float)(cor * br - coi * bi); BB[(size_t)ix * 32 + 16 + h] = (_Float16)(float)(cor * bi + coi * br); }
}
__device__ __forceinline__ void s5_task(S5_LAS unsigned char* img, volatile S5_LAS int* myflag, volatile S5_LAS int* pflag, int epoch, const Args& P, int seq, int g, int dir) {
    const int lane = threadIdx.x & 63, n = lane & 31, hi = lane >> 5, tq = lane & 15, q4 = lane >> 4;
    const bool ctx = seq < 16;
    const int L = ctx ? 256 : 1024, base = ctx ? seq * 256 : 4096 + (seq - 16) * 1024, ci = ctx ? 0 : 1 + (seq - 16), NT = L / 32;
    const float* mod = P.MOD + (ci * 2 + 1) * 6144;
    float shO[4], dvO[4]; h8 shAh;
#pragma unroll
    for (int j = 0; j < 8; ++j) shAh[j] = (_Float16)mod[16 * g + 8 * hi + j];
#pragma unroll
    for (int j = 0; j < 4; ++j) { shO[j] = mod[16 * g + 4 * q4 + j]; dvO[j] = P.Dv[16 * g + 4 * q4 + j]; }
    const _Float16* up = P.UP + (size_t)g * TT * 16;
    float* yb = P.YB + (size_t)g * TT * 16;
    float pw[2][4][2]; h8 Bf[2][2]; float cr[2], cim[2];
#pragma unroll
    for (int half = 0; half < 2; ++half) {
        const int p = n + 32 * half, ix = (dir * 64 + g) * 64 + p;
        const f32x4 q0 = *(const f32x4*)(P.PW + (size_t)ix * 8), q1 = *(const f32x4*)(P.PW + (size_t)ix * 8 + 4);
        pw[half][0][0] = q0[0]; pw[half][0][1] = q0[1]; pw[half][1][0] = q0[2]; pw[half][1][1] = q0[3]; pw[half][2][0] = q1[0]; pw[half][2][1] = q1[1]; pw[half][3][0] = q1[2]; pw[half][3][1] = q1[3];
        Bf[half][0] = *(const h8*)(P.BB + (size_t)ix * 32 + 8 * hi); Bf[half][1] = *(const h8*)(P.BB + (size_t)ix * 32 + 16 + 8 * hi);
        if (ctx) { cr[half] = 0.f; cim[half] = 0.f; }
        else { const int b = seq - 16; cr[half] = P.state_in[((b * 2 + dir) * 2 + 0) * 4096 + g * 64 + p]; cim[half] = P.state_in[((b * 2 + dir) * 2 + 1) * 4096 + g * 64 + p]; }
    }
    h8 Cf[4];
#pragma unroll
    for (int kk = 0; kk < 4; ++kk)
#pragma unroll
        for (int j = 0; j < 8; ++j) { const int k = 32 * kk + 8 * q4 + j, p = k >> 1; const size_t cx = ((size_t)(dir * 64 + g) * 16 + tq) * 64 + p;
            Cf[kk][j] = (_Float16)((k & 1) ? -P.C_im[cx] : P.C_re[cx]); }
    int rowA = base + (dir ? L - 1 - n : n);
    h8 ur = *(const h8*)(up + (size_t)rowA * 16 + 8 * hi); float sqA = P.ssq[rowA];
#pragma unroll 1
    for (int jt = 0; jt < NT; ++jt) {
        const bool second = jt >= NT / 2;
        if (jt == NT / 2) {
            asm volatile("s_waitcnt vmcnt(0)" ::: "memory");
            if (lane == 0) *myflag = epoch;
            while (*pflag < epoch) __builtin_amdgcn_s_sleep(8);
            asm volatile("" ::: "memory");
        }
        int rowO[2];
#pragma unroll
        for (int nt = 0; nt < 2; ++nt) { const int s = 32 * jt + tq + 16 * nt; rowO[nt] = base + (dir ? L - 1 - s : s); }
        const float rsA = __builtin_amdgcn_rsqf(sqA * (1.f / 1024.f) + 1e-6f);
        h8 Au; { const _Float16 rh = (_Float16)rsA; h8 rv = {rh, rh, rh, rh, rh, rh, rh, rh}; Au = ur * rv + shAh; }
        if (jt + 1 < NT) { const int s = 32 * (jt + 1) + n; rowA = base + (dir ? L - 1 - s : s); ur = *(const h8*)(up + (size_t)rowA * 16 + 8 * hi); sqA = P.ssq[rowA]; }
        const f32x16 zero = {0.f, 0.f, 0.f, 0.f, 0.f, 0.f, 0.f, 0.f, 0.f, 0.f, 0.f, 0.f, 0.f, 0.f, 0.f, 0.f};
#pragma unroll
        for (int half = 0; half < 2; ++half) {
            f32x16 xr = __builtin_amdgcn_mfma_f32_32x32x16_f16(Au, Bf[half][0], zero, 0, 0, 0);
            f32x16 xi = __builtin_amdgcn_mfma_f32_32x32x16_f16(Au, Bf[half][1], zero, 0, 0, 0);
            const float a1r = pw[half][0][0], a1i = pw[half][0][1], a4r = pw[half][3][0], a4i = pw[half][3][1];
#pragma unroll
            for (int q = 0; q < 4; ++q)
#pragma unroll
                for (int j = 1; j < 4; ++j) { const int r = 4 * q + j; const float pr = xr[r - 1], pi = xi[r - 1];
                    xr[r] = a1r * pr - a1i * pi + xr[r]; xi[r] = a1r * pi + a1i * pr + xi[r]; }
            float er[4], ei[4], per[4], pei[4];
#pragma unroll
            for (int q = 0; q < 4; ++q) { er[q] = xr[4 * q + 3]; ei[q] = xi[4 * q + 3]; per[q] = __shfl_xor(er[q], 32); pei[q] = __shfl_xor(ei[q], 32); }
            float sr = cr[half], si = cim[half], inr[4], ini[4];
#pragma unroll
            for (int i = 0; i < 8; ++i) { const int q = i >> 1; const bool own = ((i & 1) == hi);
                if ((i & 1) == 0) { inr[q] = sr; ini[q] = si; } else { inr[q] = hi ? sr : inr[q]; ini[q] = hi ? si : ini[q]; }
                const float evr = own ? er[q] : per[q], evi = own ? ei[q] : pei[q];
                const float tr = a4r * sr - a4i * si + evr; si = a4r * si + a4i * sr + evi; sr = tr; }
            cr[half] = sr; cim[half] = si;
#pragma unroll
            for (int q = 0; q < 4; ++q)
#pragma unroll
                for (int j = 0; j < 4; ++j) { const int r = 4 * q + j; const float hr = xr[r] + pw[half][j][0] * inr[q] - pw[half][j][1] * ini[q], hm = xi[r] + pw[half][j][0] * ini[q] + pw[half][j][1] * inr[q];
                    const int tau = (r & 3) + 8 * (r >> 2) + 4 * hi;
                    *(S5_LAS h2*)(img + tau * IMG_PITCH + (n + 32 * half) * 4) = __builtin_bit_cast(h2, __builtin_amdgcn_cvt_pkrtz(hr, hm)); }
        }
        f32x4 ybv[2]; h4 u4[2]; float sqO[2];
        if (second) {
#pragma unroll
            for (int nt = 0; nt < 2; ++nt) { ybv[nt] = *(const f32x4*)(yb + (size_t)rowO[nt] * 16 + 4 * q4); u4[nt] = *(const h4*)(up + (size_t)rowO[nt] * 16 + 4 * q4); sqO[nt] = P.ssq[rowO[nt]]; }
        }
#pragma unroll
        for (int nt = 0; nt < 2; ++nt) {
            f32x4 acc = {0.f, 0.f, 0.f, 0.f};
#pragma unroll
            for (int kk = 0; kk < 4; ++kk) { const h8 hb = *(const S5_LAS h8*)(img + (tq + 16 * nt) * IMG_PITCH + (32 * kk + 8 * q4) * 2);
                acc = __builtin_amdgcn_mfma_f32_16x16x32_f16(Cf[kk], hb, acc, 0, 0, 0); }
            if (!second) *(f32x4*)(yb + (size_t)rowO[nt] * 16 + 4 * q4) = acc;
            else {
                const float rs = __builtin_amdgcn_rsqf(sqO[nt] * (1.f / 1024.f) + 1e-6f);
                h4 o;
#pragma unroll
                for (int j = 0; j < 4; ++j) { const float u = rs * (float)u4[nt][j] + shO[j]; o[j] = (_Float16)gelu_fast(u * dvO[j] + acc[j] + ybv[nt][j]); }
                *(h4*)(P.Y2 + ((size_t)(2 * g + (q4 >> 1)) * TT + rowO[nt]) * 8 + 4 * (q4 & 1)) = o;
            }
        }
    }
    if (ctx && hi == 0) {
#pragma unroll
        for (int half = 0; half < 2; ++half) { const int p = n + 32 * half;
            P.new_state[((seq * 2 + dir) * 2 + 0) * 4096 + g * 64 + p] = cr[half]; P.new_state[((seq * 2 + dir) * 2 + 1) * 4096 + g * 64 + p] = cim[half]; }
    }
}
__device__ __forceinline__ void s5_phase(S5_LAS unsigned char* lds, volatile S5_LAS int* flags, const Args& P, int G, int bid) {
    const int w = __builtin_amdgcn_readfirstlane(threadIdx.x >> 6), dir = w & 1;
    S5_LAS unsigned char* img = lds + w * WAVE_LDS;
    int epoch = 0;
    for (int b = bid; b < 256; b += G) {
        if (w < 4) { const int lu = 2 * b + (w >> 1); ++epoch; s5_task(img, flags + w, flags + (w ^ 1), epoch, P, 16 + (lu >> 6), lu & 63, dir); }
        else for (int r = 0; r < 2; ++r) { const int cu = 4 * b + 2 * r + ((w - 4) >> 1); ++epoch; s5_task(img, flags + w, flags + (w ^ 1), epoch, P, cu >> 6, cu & 63, dir); }
    }
}
}
#define LAS __attribute__((address_space(3)))
#define XB_TMO      128
#define XB_XCNT(j)  (256  + 64 * (j))
#define XB_XSUB(j)  (1280 + 64 * (j))
#define XB_XGEN(j)  (2304 + 64 * (j))
#define XB_TOP      3328
#define XB_TOPGEN   3392
#define XCD_BAR_WORDS 3456
#define XB_SPIN_CAP (1u << 18)
__device__ __forceinline__ unsigned xb_ld(unsigned* p)              { return __hip_atomic_load(p, __ATOMIC_RELAXED, __HIP_MEMORY_SCOPE_AGENT); }
__device__ __forceinline__ unsigned xb_add(unsigned* p, unsigned v) { return __hip_atomic_fetch_add(p, v, __ATOMIC_RELAXED, __HIP_MEMORY_SCOPE_AGENT); }
__device__ __forceinline__ unsigned xb_xcc_id() { return (unsigned)__builtin_amdgcn_s_getreg((3 << 11) | 20) & 0xFu; }
#define XB_SPIN(cond, bar) do { unsigned _sp = 0; while (cond) { __builtin_amdgcn_s_sleep(1); \
    if ((++_sp & 255u) == 0u) { if (xb_ld(&(bar)[XB_TMO])) break; if (_sp > XB_SPIN_CAP) { atomicAdd(&(bar)[XB_TMO], 1u); break; } } } } while (0)
struct XcdBarrier { unsigned* bar; unsigned x; volatile LAS unsigned* st; };
__device__ __forceinline__ XcdBarrier xcd_barrier_post(unsigned* bar, volatile LAS unsigned* st) {
    XcdBarrier b; b.bar = bar; b.x = xb_xcc_id(); b.st = st;
    if (threadIdx.x == 0) (void)xb_add(&bar[XB_XCNT(b.x)], 1u);
    return b;
}
__device__ __forceinline__ void xcd_barrier_complete(unsigned* bar, unsigned x, unsigned& nloc, unsigned& nx) {
    const unsigned G = gridDim.x * gridDim.y * gridDim.z;
    unsigned sum, cnt, mine, sp = 0u;
    for (;;) {
        sum = 0u; cnt = 0u; mine = 0u;
#pragma unroll
        for (unsigned j = 0; j < 16; ++j) { const unsigned c = xb_ld(&bar[XB_XCNT(j)]); sum += c; cnt += (c > 0u) ? 1u : 0u; mine = (j == x) ? c : mine; }
        if (sum == G) break;
        __builtin_amdgcn_s_sleep(1);
        if ((++sp & 255u) == 0u) { if (xb_ld(&bar[XB_TMO])) break; if (sp > XB_SPIN_CAP) { atomicAdd(&bar[XB_TMO], 1u); break; } }
    }
    nloc = mine > 0u ? mine : 1u; nx = cnt > 0u ? cnt : 1u;
}
__device__ __forceinline__ void xcd_barrier(const XcdBarrier& b) {
    asm volatile("s_waitcnt vmcnt(0)" ::: "memory");
    __syncthreads();
    if (threadIdx.x == 0) {
        unsigned* bar = b.bar;
        __builtin_amdgcn_s_waitcnt(0);
        unsigned nloc = b.st[0], nx = b.st[1];
        if (nloc == 0u) { xcd_barrier_complete(bar, b.x, nloc, nx); b.st[0] = nloc; b.st[1] = nx; }
        const unsigned old = xb_add(&bar[XB_XSUB(b.x)], 1u);
        const unsigned gen = old / nloc;
        if (old + 1u == (gen + 1u) * nloc) {
            __builtin_amdgcn_fence(__ATOMIC_RELEASE, "agent");
            asm volatile("s_waitcnt vmcnt(0)" ::: "memory");
            const unsigned og = xb_add(&bar[XB_TOP], 1u);
            const unsigned tg = og / nx;
            if (og + 1u == (tg + 1u) * nx) xb_add(&bar[XB_TOPGEN], 1u);
            else XB_SPIN(xb_ld(&bar[XB_TOPGEN]) == tg, bar);
            __builtin_amdgcn_fence(__ATOMIC_ACQUIRE, "agent");
            xb_add(&bar[XB_XGEN(b.x)], 1u);
            asm volatile("s_waitcnt vmcnt(0)" ::: "memory");
        } else {
            XB_SPIN(xb_ld(&bar[XB_XGEN(b.x)]) == gen, bar);
            __builtin_amdgcn_fence(__ATOMIC_ACQUIRE, "agent");
            asm volatile("s_waitcnt vmcnt(0)" ::: "memory");
        }
    }
    __syncthreads();
}

struct EpiZT { f16h* zT; const float* bias;
    __device__ __forceinline__ void operator()(const g8::f32x4 (&acc)[2][2][4][2], const g8::Unit& u, int wr, int wc, int fr, int fq) const {
        const int row0 = u.pm * 256 + wr * 64 + fr, col0 = u.pn * 256 + wc * 32 + 4 * fq;
#pragma unroll
        for (int ai = 0; ai < 2; ++ai)
#pragma unroll
            for (int m = 0; m < 4; ++m) { const int row = row0 + ai * 128 + m * 16; const float bv = bias[row];
#pragma unroll
                for (int bj = 0; bj < 2; ++bj)
#pragma unroll
                    for (int n = 0; n < 2; ++n) { const g8::f32x4 a = acc[ai][bj][m][n]; g8::u32x2 w; w.x = pkh(a[0] + bv, a[1] + bv); w.y = pkh(a[2] + bv, a[3] + bv);
                        *(g8::u32x2*)(zT + (size_t)row * 12288 + col0 + bj * 128 + n * 16) = w; } }
    } };
struct ResOut { float* X; const float* Xr; f16h* XA; const float* ng; float* ssq; const float* xp; const float* xs; const float* post; int xa_mode; int pad; };
template <bool XIN, class GV> __device__ __forceinline__ void res_group(const ResOut& R, const float* gate, const float* sc, int row0, int c, GV getval, float (&sq)[8]) {
    constexpr int NB = 8;
    const g8::f32x4 gv = *(const g8::f32x4*)(gate + c);
    g8::f32x4 gm = {0.f, 0.f, 0.f, 0.f};
    if (R.XA) { const g8::f32x4 ng = *(const g8::f32x4*)(R.ng + c), s = *(const g8::f32x4*)(sc + c); gm = ng * (s + 1.f); }
    unsigned o0 = (unsigned)row0 * 1024u + (unsigned)c;
    asm volatile("" : "+v"(o0));
    const bool lat = XIN && row0 >= NCTX;
#pragma unroll
    for (int b0 = 0; b0 < 8; b0 += NB) {
        g8::f32x4 x[NB];
#pragma unroll
        for (int k = 0; k < NB; ++k) { const int i = b0 + k; const unsigned o = o0 + (unsigned)(((i >> 2) * 128 + (i & 3) * 16) * 1024);
            if (XIN) x[k] = lat ? *(const g8::f32x4*)(R.xs + (o - (unsigned)NCTX * 1024u)) : *(const g8::f32x4*)(R.xp + o);
            else x[k] = *(const g8::f32x4*)(R.Xr + o); }
#pragma unroll
        for (int k = 0; k < NB; ++k) { const int i = b0 + k, row = row0 + (i >> 2) * 128 + (i & 3) * 16; const unsigned o = o0 + (unsigned)(((i >> 2) * 128 + (i & 3) * 16) * 1024); g8::f32x4 xv = x[k];
            if (lat) { const int t = (row - NCTX) & 1023; xv += *(const g8::f32x4*)(c < 512 ? R.post + (t >> 6) * 512 + c : R.post + 16 * 512 + (t & 63) * 512 + (c - 512)); }
            xv += gv * getval(i); *(g8::f32x4*)(R.X + o) = xv;
            sq[i] += (xv[0] * xv[0] + xv[1] * xv[1]) + (xv[2] * xv[2] + xv[3] * xv[3]);
            if (R.XA) { g8::u32x2 w; w.x = pkh(xv[0] * gm[0], xv[1] * gm[1]); w.y = pkh(xv[2] * gm[2], xv[3] * gm[3]);
                f16h* q = R.xa_mode == 0 ? R.XA + o : R.XA + ((size_t)(c >> 4) * T + row) * 16 + (c & 15);
                *(g8::u32x2*)q = w; } }
    }
}
__device__ __forceinline__ void res_ssq(const ResOut& R, int row0, int fq, float (&sq)[8]) {
    if (!R.ssq) return;
    float olds[8];
#pragma unroll
    for (int i = 0; i < 8; ++i) { float v = sq[i]; v += __shfl_xor(v, 16); v += __shfl_xor(v, 32); olds[i] = 0.f; if (fq == 0) olds[i] = atomicAdd(R.ssq + row0 + (i >> 2) * 128 + (i & 3) * 16, v); }
    asm volatile("" :: "v"(olds[0]), "v"(olds[1]), "v"(olds[2]), "v"(olds[3]), "v"(olds[4]), "v"(olds[5]), "v"(olds[6]), "v"(olds[7]));
}
template <bool XIN> struct EpiRes2 { ResOut R; const float* bias; const float* MOD; int gateoff, scoff;
    __device__ __forceinline__ void operator()(const g8::f32x4 (&acc)[2][2][4][2], const g8::Unit& u, int wr, int wc, int fr, int fq) const {
        const int row0 = u.pm * 256 + wr * 64 + fr, col0 = u.pn * 256 + wc * 32 + 4 * fq;
        const float* mb = MOD + (row_ci(u.pm * 256) * 2) * 6144; const float* gate = mb + gateoff; const float* sc = mb + scoff;
        float sq[8] = {0.f, 0.f, 0.f, 0.f, 0.f, 0.f, 0.f, 0.f};
#pragma unroll
        for (int bj = 0; bj < 2; ++bj)
#pragma unroll
            for (int n = 0; n < 2; ++n) { const int c = col0 + bj * 128 + n * 16; g8::f32x4 bv = {0.f, 0.f, 0.f, 0.f}; if (bias) bv = *(const g8::f32x4*)(bias + c);
                res_group<XIN>(R, gate, sc, row0, c, [&](int i) { return acc[i >> 2][bj][i & 3][n] + bv; }, sq); }
        res_ssq(R, row0, fq, sq);
    } };
struct EpiGlu2 { ResOut R; const float* bias; const float* MOD; int gateoff, scoff;
    __device__ __forceinline__ void operator()(const g8::f32x4 (&acc)[2][2][4][2], const g8::Unit& u, int wr, int wc, int fr, int fq) const {
        const int row0 = u.pm * 256 + wr * 64 + fr, col0 = u.pn * 128 + wc * 32 + 4 * fq;
        const float* mb = MOD + (row_ci(u.pm * 256) * 2) * 6144; const float* gate = mb + gateoff; const float* sc = mb + scoff;
        float sq[8] = {0.f, 0.f, 0.f, 0.f, 0.f, 0.f, 0.f, 0.f};
#pragma unroll
        for (int n = 0; n < 2; ++n) { const int c = col0 + n * 16; const g8::f32x4 ba = *(const g8::f32x4*)(bias + c), bg = *(const g8::f32x4*)(bias + 1024 + c);
            res_group<false>(R, gate, sc, row0, c, [&](int i) { const g8::f32x4 a = acc[i >> 2][0][i & 3][n] + ba, g = acc[i >> 2][1][i & 3][n] + bg; g8::f32x4 v;
#pragma unroll
                for (int j = 0; j < 4; ++j) v[j] = a[j] * sigmf(g[j]);
                return v; }, sq); }
        res_ssq(R, row0, fq, sq);
    } };

struct EpiFinal { float* out; const float* MOD; const float* fg; float* ssq; unsigned* cnt; int gateoff;
    __device__ __forceinline__ void operator()(const g8::f32x4 (&acc)[2][2][4][2], const g8::Unit& u, int wr, int wc, int fr, int fq) const {
        const int row0 = u.pm * 256 + wr * 64 + fr, col0 = u.pn * 256 + wc * 32 + 4 * fq;
        const float* gate = MOD + (row_ci(u.pm * 256) * 2) * 6144 + gateoff;
        ResOut R{out, out, nullptr, nullptr, ssq, nullptr, nullptr, nullptr, 0, 0};
        float sq[8] = {0.f, 0.f, 0.f, 0.f, 0.f, 0.f, 0.f, 0.f};
#pragma unroll
        for (int bj = 0; bj < 2; ++bj)
#pragma unroll
            for (int n = 0; n < 2; ++n) { const int c = col0 + bj * 128 + n * 16;
                res_group<false>(R, gate, gate, row0, c, [&](int i) { return acc[i >> 2][bj][i & 3][n]; }, sq); }
        res_ssq(R, row0, fq, sq);
        asm volatile("s_waitcnt vmcnt(0)" ::: "memory");
        unsigned* c = cnt + 64 * u.pm;
        if ((threadIdx.x & 63) == 0) __hip_atomic_fetch_add(c, 1u, __ATOMIC_RELAXED, __HIP_MEMORY_SCOPE_AGENT);
        { unsigned spins = 0; while ((unsigned)__builtin_amdgcn_readfirstlane(__hip_atomic_load(c, __ATOMIC_RELAXED, __HIP_MEMORY_SCOPE_AGENT)) < 32u) { __builtin_amdgcn_s_sleep(4); if (++spins > (1u << 22)) break; } }
        asm volatile("" ::: "memory");
        float rs[8];
#pragma unroll
        for (int i = 0; i < 8; ++i) rs[i] = __hip_atomic_load(ssq + row0 + (i >> 2) * 128 + (i & 3) * 16, __ATOMIC_RELAXED, __HIP_MEMORY_SCOPE_AGENT);
#pragma unroll
        for (int i = 0; i < 8; ++i) rs[i] = __builtin_amdgcn_rsqf(rs[i] * (1.f / 1024.f) + 1e-6f);
#pragma unroll
        for (int bj = 0; bj < 2; ++bj)
#pragma unroll
            for (int n = 0; n < 2; ++n) { const int c2 = col0 + bj * 128 + n * 16; const g8::f32x4 g = *(const g8::f32x4*)(fg + c2);
                unsigned o0 = (unsigned)row0 * 1024u + (unsigned)c2; asm volatile("" : "+v"(o0));
                g8::f32x4 x[8];
#pragma unroll
                for (int i = 0; i < 8; ++i) x[i] = *(const g8::f32x4*)(out + o0 + (unsigned)(((i >> 2) * 128 + (i & 3) * 16) * 1024));
#pragma unroll
                for (int i = 0; i < 8; ++i) { g8::f32x4 xv = x[i]; xv[0] *= rs[i] * g[0]; xv[1] *= rs[i] * g[1]; xv[2] *= rs[i] * g[2]; xv[3] *= rs[i] * g[3];
                    *(g8::f32x4*)(out + o0 + (unsigned)(((i >> 2) * 128 + (i & 3) * 16) * 1024)) = xv; } }
    } };
struct EpiSwiglu2 { f16h* hid; const float* ssq; const float* bias2;
    __device__ __forceinline__ void operator()(const g8::f32x4 (&acc)[2][2][4][2], const g8::Unit& u, int wr, int wc, int fr, int fq) const {
        const int row0 = u.pm * 256 + wr * 64 + fr, col0 = u.pn * 128 + wc * 32 + 4 * fq;
        const float* b2 = bias2 + row_ci(u.pm * 256) * 5632;
#pragma unroll
        for (int n = 0; n < 2; ++n) { const g8::f32x4 ba = *(const g8::f32x4*)(b2 + col0 + n * 16), bb = *(const g8::f32x4*)(b2 + 2816 + col0 + n * 16);
#pragma unroll
            for (int ai = 0; ai < 2; ++ai)
#pragma unroll
                for (int m = 0; m < 4; ++m) { const int row = row0 + ai * 128 + m * 16; const float rstd = 1.0f / sqrtf(ssq[row] * (1.f / 1024.f) + 1e-6f);
                    const g8::f32x4 a = acc[ai][0][m][n] * rstd + ba, b = acc[ai][1][m][n] * rstd + bb; g8::u32x2 w;
                    w.x = pkh(siluf(a[0]) * b[0], siluf(a[1]) * b[1]); w.y = pkh(siluf(a[2]) * b[2], siluf(a[3]) * b[3]);
                    *(g8::u32x2*)(hid + (size_t)row * 2816 + col0 + n * 16) = w; } }
    } };

typedef const __attribute__((address_space(4))) Params* KP;
struct Frame { LAS unsigned char* lds; int tid, lane, wave, G, bid; };
__device__ __forceinline__ float wave_sum(float v) {
#pragma unroll
    for (int o = 1; o < 64; o <<= 1) v += __shfl_xor(v, o);
    return v;
}
__device__ __forceinline__ void transpose_item(const float* W, int K, int N, f16h* WT, LAS float* scr, int item, int lane) {
    const int nblk = N / 32, kb = item / nblk, nb = item % nblk, k0 = 64 * kb, n0 = 32 * nb;
#pragma unroll 8
    for (int i = 0; i < 32; ++i) { const int kk = 2 * i + (lane >> 5); scr[kk * 33 + (lane & 31)] = W[(size_t)(k0 + kk) * N + n0 + (lane & 31)]; }
    asm volatile("s_waitcnt lgkmcnt(0)" ::: "memory");
    const int c = lane & 7;
#pragma unroll
    for (int j = 0; j < 4; ++j) { const int n = (lane >> 3) + 8 * j; const LAS float* s = scr + (8 * c) * 33 + n;
        g8::u32x4 o; o.x = pkh(s[0 * 33], s[1 * 33]); o.y = pkh(s[2 * 33], s[3 * 33]); o.z = pkh(s[4 * 33], s[5 * 33]); o.w = pkh(s[6 * 33], s[7 * 33]);
        *(g8::u32x4*)(WT + (size_t)(n0 + n) * K + k0 + 8 * c) = o; }
    asm volatile("s_waitcnt lgkmcnt(0)" ::: "memory");
}
__device__ __forceinline__ void gemv9_item(const float* W, int ldw, int col0, int kc, const LAS float* tab, float* out, int ostride, const float* bias, int lane) {
    const int col = col0 + lane; float acc[9];
#pragma unroll
    for (int ci = 0; ci < 9; ++ci) acc[ci] = 0.f;
    const float* w = W + (size_t)(kc * 64) * ldw + col;
#pragma unroll 1
    for (int c = 0; c < 4; ++c) {
        float wv[16];
#pragma unroll
        for (int k = 0; k < 16; ++k) wv[k] = w[(size_t)(16 * c + k) * ldw];
#pragma unroll
        for (int k4 = 0; k4 < 4; ++k4)
#pragma unroll
            for (int ci = 0; ci < 9; ++ci) { const g8::f32x4 s = *(const LAS g8::f32x4*)(tab + ci * 1024 + kc * 64 + 16 * c + 4 * k4); acc[ci] += s[0] * wv[4 * k4] + s[1] * wv[4 * k4 + 1] + s[2] * wv[4 * k4 + 2] + s[3] * wv[4 * k4 + 3]; }
    }
    float olds[9];
#pragma unroll
    for (int ci = 0; ci < 9; ++ci) olds[ci] = atomicAdd(out + (size_t)ci * ostride + col, acc[ci] + ((bias && kc == 0) ? bias[col] : 0.f));
    asm volatile("" :: "v"(olds[0]), "v"(olds[1]), "v"(olds[2]), "v"(olds[3]), "v"(olds[4]), "v"(olds[5]), "v"(olds[6]), "v"(olds[7]), "v"(olds[8]));
}
__device__ __forceinline__ void filt_item(const float* H2, const float* w3, float* NORM, f16h* FILT, int lv, int o, int mr, int d0, int lane, bool pass2, LAS float* hs) {
    const int L = lv ? 1024 : 256, d = d0 + lane, m0 = 32 * mr, dir = m0 >= L ? 1 : 0;
    const int extra = (!pass2 && m0 == L) ? 1 : 0;
    const int ilo = dir ? (m0 - (L - 1)) - extra : (L - 32 - m0);
    const float* h2 = H2 + (lv ? 256 : 0) * 64;
    for (int r = 0; r < 32 + extra; ++r) { const int i = ilo + r; hs[r * 64 + lane] = i < L ? h2[i * 64 + lane] : 0.f; }
    float w[64];
#pragma unroll
    for (int m = 0; m < 64; ++m) w[m] = w3[m * 4096 + o * 2048 + dir * 1024 + d];
    const double maxd = log(1e-2) / 0.3, mind = log(1e-2) / 1.5;
    const float delta = fabsf((float)(mind + (double)d * (maxd - mind) / 1023.0));
    const float tstep = (float)(1.0 / (double)(L - 1));
    float inv = 0.f; if (pass2) inv = cv::FSCALE / (NORM[(lv * 2 + o) * 1024 + d] + 1e-6f);
    float sabs = 0.f; f16h taps[32];
    asm volatile("s_waitcnt lgkmcnt(0)" ::: "memory");
#pragma unroll 1
    for (int mm = -extra; mm < 32; ++mm) {
        const int m = m0 + mm, j = (L - 1) - m, i = j < 0 ? -j : j;
        const LAS g8::f32x4* hr = (const LAS g8::f32x4*)(hs + (i - ilo) * 64);
        float a = 0.f;
#pragma unroll
        for (int q = 0; q < 16; ++q) { const g8::f32x4 h = hr[q]; a += h[0] * w[4 * q] + h[1] * w[4 * q + 1] + h[2] * w[4 * q + 2] + h[3] * w[4 * q + 3]; }
        a = i < L ? a * __expf(-(float)i * tstep * delta) : 0.f;
        sabs += fabsf(a);
        if (mm >= 0) {
#pragma unroll
            for (int q = 0; q < 32; ++q) if (q == mm) taps[q] = (f16h)(a * inv);
        }
    }
    if (!pass2) atomic_add_done(&NORM[(lv * 2 + o) * 1024 + d], sabs);
    else {
        f16h* dst = FILT + (lv ? (size_t)2 * 1024 * 512 + (size_t)(o * 1024 + d) * 2048 : (size_t)(o * 1024 + d) * 512) + m0;
#pragma unroll
        for (int q = 0; q < 4; ++q) { cv::h8 v;
#pragma unroll
            for (int e = 0; e < 8; ++e) v[e] = taps[8 * q + e];
            *(cv::h8*)(dst + 8 * q) = v; }
    }
    asm volatile("s_waitcnt lgkmcnt(0)" ::: "memory");
}
__device__ __forceinline__ void filt_items(Frame& F, KP P, int first_block, int nblocks, bool pass2) {
    const float* H2 = (const float*)(P->ws + WS_H2); float* NORM = (float*)(P->ws + WS_NORM); f16h* FILT = (f16h*)(P->ws + WS_FILT);
    if (F.bid < first_block) return;
    const int gw = (F.bid - first_block) * 8 + F.wave, NGW = nblocks * 8;
    for (int it = gw; it < 2560; it += NGW) {
        int lv, r = it; if (r < 512) lv = 0; else { lv = 1; r -= 512; }
        const int nr = lv ? 64 : 16, db = r & 15, mr = (r >> 4) % nr, o = (r >> 4) / nr;
        filt_item(H2, P->in[20], NORM, FILT, lv, o, mr, db * 64, F.lane, pass2, (LAS float*)(F.lds + F.wave * 8704));
    }
}
__device__ __forceinline__ void phase0(Frame& F, KP P, bool domods) {
    LAS float* tab = (LAS float*)F.lds;
    LAS float* scr = (LAS float*)(F.lds + 36864 + F.wave * 8448);
    for (int i = F.tid; i < 9 * 1024; i += 512) { const int ci = i >> 10, k = i & 1023; const float v = ci == 0 ? P->in[4][k] : P->in[3][(ci - 1) * 1024 + k]; tab[i] = v / (1.f + expf(-v)); }
    __syncthreads();
    const int gw = F.bid * 8 + F.wave, NGW = F.G * 8;
    float* MOD = (float*)(P->ws + WS_MOD);
    if (domods) for (int it = gw; it < 3072; it += NGW) { const int kq = it & 15, cb = (it >> 4) % 96, l = (it >> 4) / 96;
        gemv9_item(P->in[8] + (size_t)l * 1024 * 6144, 6144, cb * 64, kq, tab, MOD + l * 6144, 2 * 6144, P->in[9] + l * 6144, F.lane); }
    for (int pos = gw; pos < 1280; pos += NGW) {
        const int L = pos < 256 ? 256 : 1024, i = pos < 256 ? pos : pos - 256, lane = F.lane;
        if (lane < 33) { float z;
            if (lane == 0) z = (float)((double)i / (double)(L - 1));
            else { const int m = (lane - 1) & 15; const double band = 1e-4 + (double)m * ((15.0 - 1e-4) / 15.0), w = 2.0 * 3.14159265358979323846 * (double)i / (double)L;
                z = lane <= 16 ? (float)cos(band * w) : (float)(-sin(band * w)); }
            scr[lane] = z; }
        asm volatile("s_waitcnt lgkmcnt(0)" ::: "memory");
        float a = P->in[17][lane];
        for (int k = 0; k < 33; ++k) a += scr[k] * P->in[16][k * 64 + lane];
        scr[64 + lane] = sinf(P->in[21][lane] * a);
        asm volatile("s_waitcnt lgkmcnt(0)" ::: "memory");
        float a2 = P->in[19][lane];
        for (int k = 0; k < 64; ++k) a2 += scr[64 + k] * P->in[18][k * 64 + lane];
        ((float*)(P->ws + WS_H2))[pos * 64 + lane] = sinf(P->in[21][lane] * a2);
        asm volatile("s_waitcnt lgkmcnt(0)" ::: "memory");
    }
    { float* post = (float*)(P->ws + WS_POST);
      for (int i = F.bid * 512 + F.tid; i < 80 * 512; i += F.G * 512) { const int n = i >> 9, d = i & 511, nn = n < 16 ? n : n - 16;
          const double om = exp(-log(10000.0) * (double)(d & 255) / 256.0), ang = (double)nn * om; post[i] = (float)(d < 256 ? sin(ang) : cos(ang)); } }
    for (int ix = F.bid * 512 + F.tid; ix < 8192; ix += F.G * 512) s5::s5_table(ix, P->in[25], P->in[26], P->in[27], P->in[28], P->in[29], (float*)(P->ws + WS_S5PW), (f16h*)(P->ws + WS_S5BB));
    { constexpr int I_IN = 16 * 96, I_OUT = 16 * 32, NIT = I_IN + I_OUT;
      for (int it = gw; it < NIT; it += NGW) { int r = it;
          if (r < I_IN) { transpose_item(P->in[12], 1024, 3072, (f16h*)(P->ws + WS_WIN), scr, r, F.lane); continue; } r -= I_IN;
          transpose_item(P->in[23], 1024, 1024, (f16h*)(P->ws + WS_WOUT), scr, r, F.lane); } }
}
__device__ __forceinline__ void convert_items(Frame& F, KP P, int first, int set) {
    if (F.bid < first) return;
    LAS float* scr = (LAS float*)(F.lds + F.wave * 8448);
    const int gw = (F.bid - first) * 8 + F.wave, NGW = (F.G - first) * 8;
    constexpr int I_13 = 16 * 176, I_2 = 44 * 32, I_GLU = 16 * 64;
    const int l = set;
    const int NIT = I_13 + I_2 + (set ? I_GLU : 0);
    for (int it = gw; it < NIT; it += NGW) { int r = it;
        if (r < I_13) { transpose_item(P->in[10] + (size_t)l * 1024 * 5632, 1024, 5632, (f16h*)(P->ws + WS_W13) + (size_t)l * 5632 * 1024, scr, r, F.lane); continue; } r -= I_13;
        if (r < I_2) { transpose_item(P->in[11] + (size_t)l * 2816 * 1024, 2816, 1024, (f16h*)(P->ws + WS_W2) + (size_t)l * 1024 * 2816, scr, r, F.lane); continue; } r -= I_2;
        transpose_item(P->in[33], 1024, 2048, (f16h*)(P->ws + WS_WGLU), scr, r, F.lane); }
}
__device__ __forceinline__ void phase1(Frame& F, KP P) {
    const float* MOD = (const float*)(P->ws + WS_MOD);
    const int gw = F.bid * 8 + F.wave, NGW = F.G * 8;
    { f16h* XA = (f16h*)(P->ws + WS_XA); const float* post = (const float*)(P->ws + WS_POST); const float* ng = P->in[5];
      for (int row = gw; row < T; row += NGW) {
          const float* mb = MOD + (row_ci(row) * 2) * 6144; g8::f32x4 v[4]; float s = 0.f;
#pragma unroll
          for (int j = 0; j < 4; ++j) { const int c = 4 * F.lane + 256 * j;
              if (row < NCTX) v[j] = *(const g8::f32x4*)(P->in[0] + (size_t)row * 1024 + c);
              else { const int r = row - NCTX, t = r & 1023; v[j] = *(const g8::f32x4*)(P->in[1] + (size_t)r * 1024 + c);
                  v[j] += *(const g8::f32x4*)(c < 512 ? post + (t >> 6) * 512 + c : post + 16 * 512 + (t & 63) * 512 + (c - 512)); }
              s += (v[j][0] * v[j][0] + v[j][1] * v[j][1]) + (v[j][2] * v[j][2] + v[j][3] * v[j][3]); }
          const float rstd = 1.0f / sqrtf(wave_sum(s) * (1.f / 1024.f) + 1e-6f);
#pragma unroll
          for (int j = 0; j < 4; ++j) { const int c = 4 * F.lane + 256 * j; const g8::f32x4 g = *(const g8::f32x4*)(ng + c), sh = *(const g8::f32x4*)(mb + c), sc = *(const g8::f32x4*)(mb + 1024 + c);
              g8::u32x2 w; w.x = pkh(v[j][0] * rstd * g[0] * (1.f + sc[0]) + sh[0], v[j][1] * rstd * g[1] * (1.f + sc[1]) + sh[1]);
              w.y = pkh(v[j][2] * rstd * g[2] * (1.f + sc[2]) + sh[2], v[j][3] * rstd * g[3] * (1.f + sc[3]) + sh[3]);
              *(g8::u32x2*)(XA + (size_t)row * 1024 + c) = w; } } }
    filt_items(F, P, 0, F.G, false);
}
__device__ __forceinline__ void bias2_items(Frame& F, KP P, int first) {
    if (F.bid < first) return;
    const float* MOD = (const float*)(P->ws + WS_MOD);
    LAS float* tab = (LAS float*)F.lds;
    for (int i = F.tid; i < 2 * 9 * 1024; i += 512) { const int l = i / 9216, r = i % 9216, ci = r >> 10, k = r & 1023; tab[i] = MOD[(ci * 2 + l) * 6144 + 3072 + k]; }
    __syncthreads();
    float* BIAS2 = (float*)(P->ws + WS_BIAS2);
    const int gw = (F.bid - first) * 8 + F.wave, NGW = (F.G - first) * 8;
    for (int it = gw; it < 2816; it += NGW) { const int kq = it & 15, cb = (it >> 4) % 88, l = (it >> 4) / 88;
        gemv9_item(P->in[10] + (size_t)l * 1024 * 5632, 5632, cb * 64, kq, tab + l * 9216, BIAS2 + (size_t)l * 9 * 5632, 5632, nullptr, F.lane); }
    __syncthreads();
}
__device__ __forceinline__ void phase_final(Frame& F, KP P) {
    const float* ssq = (const float*)(P->ws + WS_SSQ) + 3 * T; const float* fg = P->in[7];
    const int gw = F.bid * 8 + F.wave, NGW = F.G * 8;
    for (int row = gw; row < T; row += NGW) { const float rstd = 1.0f / sqrtf(ssq[row] * (1.f / 1024.f) + 1e-6f); float* x = P->out + (size_t)row * 1024;
#pragma unroll
        for (int j = 0; j < 4; ++j) { const int c = 4 * F.lane + 256 * j; g8::f32x4 v = *(g8::f32x4*)(x + c); const g8::f32x4 g = *(const g8::f32x4*)(fg + c);
            v[0] *= rstd * g[0]; v[1] *= rstd * g[1]; v[2] *= rstd * g[2]; v[3] *= rstd * g[3]; *(g8::f32x4*)(x + c) = v; } }
}

#define LAUNDER(p) asm volatile("" : "+s"(p))
__global__ void __launch_bounds__(512, 2) mk_fwd(Params prm_unused) {
    extern __shared__ __attribute__((aligned(16))) unsigned char lds_raw[];
    KP kp = (KP)__builtin_amdgcn_kernarg_segment_ptr();
    Frame F; F.lds = (LAS unsigned char*)lds_raw; F.tid = threadIdx.x; F.lane = F.tid & 63; F.wave = __builtin_amdgcn_readfirstlane(F.tid >> 6); F.G = gridDim.x; F.bid = blockIdx.x;
    volatile LAS unsigned* MISC = (volatile LAS unsigned*)(F.lds + LDS_MISC);
    if (F.tid < 32) MISC[F.tid] = 0u;
    __syncthreads();
    XcdBarrier bar; bar.bar = (unsigned*)(kp->ws + CTL_BAR); bar.x = 0; bar.st = nullptr;
    if (MK_LAUNCHES == 1) bar = xcd_barrier_post((unsigned*)(kp->ws + CTL_BAR), MISC + 8);
    const int lo = kp->ph_lo, hi = kp->ph_hi;
#define IN(k) (lo <= (k) && (k) < hi)
#define SEAM(k) do { if (IN(k) && IN((k) + 1)) xcd_barrier(bar); } while (0)
#define WSP(T_, off) ((T_*)(ws + (off)))
    if (IN(0)) { LAUNDER(kp); phase0(F, kp, true); if (MK_DUP & 1) { xcd_barrier(bar); phase0(F, kp, false); } }
    SEAM(0);
    if (IN(1)) { LAUNDER(kp); phase1(F, kp); }
    SEAM(1);
    if (IN(2)) {
        LAUNDER(kp); unsigned char* ws = kp->ws;
        g8::Gemm g{ws + WS_WIN, ws + WS_XA, 1024, 2048u, 16u, 256, 128, 12, 48, 0}; g8::StaticOrder S; S.init(12, 48, F.G, F.bid);
        EpiZT E{WSP(f16h, WS_ZT), kp->in[13]}; g8::gemm_phase<EpiZT>(F.lds, g, S, E);
        filt_items(F, kp, 64, F.G - 64, true);
    }
    if (MK_DUP & (1 << 2)) { xcd_barrier(bar); if (IN(2)) {
        LAUNDER(kp); unsigned char* ws = kp->ws;
        g8::Gemm g{ws + WS_WIN, ws + WS_XA, 1024, 2048u, 16u, 256, 128, 12, 48, 0}; g8::StaticOrder S; S.init(12, 48, F.G, F.bid);
        EpiZT E{WSP(f16h, WS_ZT), kp->in[13]}; g8::gemm_phase<EpiZT>(F.lds, g, S, E);
        filt_items(F, kp, 64, F.G - 64, true);
    } }
    SEAM(2);
    if (IN(3)) { LAUNDER(kp); unsigned char* ws = kp->ws; cv::Args A{WSP(f16h, WS_ZT), WSP(const f16h, WS_FILT), kp->in[14], kp->in[15], kp->in[22], WSP(f16h, WS_V2)}; cv::conv_phase(F.lds, A, F.G, F.bid); }
    if (MK_DUP & (1 << 3)) { xcd_barrier(bar); if (IN(3)) { LAUNDER(kp); unsigned char* ws = kp->ws; cv::Args A{WSP(f16h, WS_ZT), WSP(const f16h, WS_FILT), kp->in[14], kp->in[15], kp->in[22], WSP(f16h, WS_V2)}; cv::conv_phase(F.lds, A, F.G, F.bid); } }
    SEAM(3);
    if (IN(4) && (MK_DUP & (1 << 4))) {
        LAUNDER(kp); unsigned char* ws = kp->ws;
        g8::Gemm g{ws + WS_V2, ws + WS_WOUT, 1024, 16u, 16u * 12288u, 256, 128, 48, 4, 0}; g8::StaticOrder S; S.init(48, 4, F.G, F.bid);
        EpiRes2<true> E{ResOut{WSP(float, WS_YB), kp->out, nullptr, kp->in[6], nullptr, kp->in[0], kp->in[1], WSP(const float, WS_POST), 0, 0}, kp->in[24], WSP(const float, WS_MOD), 2048, 4096};
        g8::gemm_phase<EpiRes2<true>>(F.lds, g, S, E);
    }
    if (IN(4) && (MK_DUP & (1 << 4))) xcd_barrier(bar);
    if (IN(4)) {
        LAUNDER(kp); unsigned char* ws = kp->ws;
        g8::Gemm g{ws + WS_V2, ws + WS_WOUT, 1024, 16u, 16u * 12288u, 256, 128, 48, 4, 0}; g8::StaticOrder S; S.init(48, 4, F.G, F.bid);
        EpiRes2<true> E{ResOut{kp->out, kp->out, WSP(f16h, WS_XA), kp->in[6], WSP(float, WS_SSQ), kp->in[0], kp->in[1], WSP(const float, WS_POST), 0, 0}, kp->in[24], WSP(const float, WS_MOD), 2048, 4096};
        g8::gemm_phase<EpiRes2<true>>(F.lds, g, S, E);
        convert_items(F, kp, 192, 0); __syncthreads(); bias2_items(F, kp, 192);
    }
    SEAM(4);
    if (IN(5)) { LAUNDER(kp); unsigned char* ws = kp->ws;
        g8::Gemm g{ws + WS_XA, ws + WS_W13, 1024, 2048u, 16u, 128, 2816, 48, 22, 0}; g8::StaticOrder S; S.init(48, 22, F.G, F.bid);
        EpiSwiglu2 E{WSP(f16h, WS_ZT), WSP(const float, WS_SSQ), WSP(const float, WS_BIAS2)}; g8::gemm_phase<EpiSwiglu2>(F.lds, g, S, E); }
    if (MK_DUP & (1 << 5)) { xcd_barrier(bar); if (IN(5)) { LAUNDER(kp); unsigned char* ws = kp->ws;
        g8::Gemm g{ws + WS_XA, ws + WS_W13, 1024, 2048u, 16u, 128, 2816, 48, 22, 0}; g8::StaticOrder S; S.init(48, 22, F.G, F.bid);
        EpiSwiglu2 E{WSP(f16h, WS_ZT), WSP(const float, WS_SSQ), WSP(const float, WS_BIAS2)}; g8::gemm_phase<EpiSwiglu2>(F.lds, g, S, E); } }
    SEAM(5);
    if (IN(6) && (MK_DUP & (1 << 6))) { LAUNDER(kp); unsigned char* ws = kp->ws;
        g8::Gemm g{ws + WS_ZT, ws + WS_W2, 2816, 5632u, 16u, 256, 128, 48, 4, 0}; g8::StaticOrder S; S.init(48, 4, F.G, F.bid);
        EpiRes2<false> E{ResOut{WSP(float, WS_YB), kp->out, nullptr, kp->in[5] + D, nullptr, nullptr, nullptr, nullptr, 1, 0}, nullptr, WSP(const float, WS_MOD), 5120, 6144 + 1024};
        g8::gemm_phase<EpiRes2<false>>(F.lds, g, S, E); }
    if (IN(6) && (MK_DUP & (1 << 6))) xcd_barrier(bar);
    if (IN(6)) { LAUNDER(kp); unsigned char* ws = kp->ws;
        g8::Gemm g{ws + WS_ZT, ws + WS_W2, 2816, 5632u, 16u, 256, 128, 48, 4, 0}; g8::StaticOrder S; S.init(48, 4, F.G, F.bid);
        EpiRes2<false> E{ResOut{kp->out, kp->out, WSP(f16h, WS_XA), kp->in[5] + D, WSP(float, WS_SSQ) + T, nullptr, nullptr, nullptr, 1, 0}, nullptr, WSP(const float, WS_MOD), 5120, 6144 + 1024};
        g8::gemm_phase<EpiRes2<false>>(F.lds, g, S, E); convert_items(F, kp, 192, 1); }
    SEAM(6);
    if (IN(7)) { LAUNDER(kp); unsigned char* ws = kp->ws;
        s5::Args A{WSP(const f16h, WS_XA), WSP(const float, WS_SSQ) + T, WSP(const float, WS_MOD), WSP(const float, WS_S5PW), WSP(const f16h, WS_S5BB), kp->in[30], kp->in[31], kp->in[32], kp->in[2], WSP(float, WS_YB), WSP(f16h, WS_V2), kp->out + (size_t)T * D};
        if (F.tid < 8) MISC[16 + F.tid] = 0u; __syncthreads(); s5::s5_phase(F.lds, (volatile LAS int*)(MISC + 16), A, F.G, F.bid); }
    if (MK_DUP & (1 << 7)) { xcd_barrier(bar); if (IN(7)) { LAUNDER(kp); unsigned char* ws = kp->ws;
        s5::Args A{WSP(const f16h, WS_XA), WSP(const float, WS_SSQ) + T, WSP(const float, WS_MOD), WSP(const float, WS_S5PW), WSP(const f16h, WS_S5BB), kp->in[30], kp->in[31], kp->in[32], kp->in[2], WSP(float, WS_YB), WSP(f16h, WS_V2), kp->out + (size_t)T * D};
        if (F.tid < 8) MISC[16 + F.tid] = 0u; __syncthreads(); s5::s5_phase(F.lds, (volatile LAS int*)(MISC + 16), A, F.G, F.bid); } }
    SEAM(7);
    if (IN(8) && (MK_DUP & (1 << 8))) { LAUNDER(kp); unsigned char* ws = kp->ws;
        g8::Gemm g{ws + WS_V2, ws + WS_WGLU, 1024, 16u, 16u * 12288u, 128, 1024, 48, 8, 0}; g8::StaticOrder S; S.init(48, 8, F.G, F.bid);
        EpiGlu2 E{ResOut{WSP(float, WS_YB), kp->out, nullptr, kp->in[6] + D, nullptr, nullptr, nullptr, nullptr, 0, 0}, kp->in[34], WSP(const float, WS_MOD), 6144 + 2048, 6144 + 4096};
        g8::gemm_phase<EpiGlu2>(F.lds, g, S, E); }
    if (IN(8) && (MK_DUP & (1 << 8))) xcd_barrier(bar);
    if (IN(8)) { LAUNDER(kp); unsigned char* ws = kp->ws;
        g8::Gemm g{ws + WS_V2, ws + WS_WGLU, 1024, 16u, 16u * 12288u, 128, 1024, 48, 8, 0}; g8::StaticOrder S; S.init(48, 8, F.G, F.bid);
        EpiGlu2 E{ResOut{kp->out, kp->out, WSP(f16h, WS_XA), kp->in[6] + D, WSP(float, WS_SSQ) + 2 * T, nullptr, nullptr, nullptr, 0, 0}, kp->in[34], WSP(const float, WS_MOD), 6144 + 2048, 6144 + 4096};
        g8::gemm_phase<EpiGlu2>(F.lds, g, S, E); }
    SEAM(8);
    if (IN(9)) { LAUNDER(kp); unsigned char* ws = kp->ws;
        g8::Gemm g{ws + WS_XA, ws + WS_W13 + (size_t)5632 * 1024 * 2, 1024, 2048u, 16u, 128, 2816, 48, 22, 0}; g8::StaticOrder S; S.init(48, 22, F.G, F.bid);
        EpiSwiglu2 E{WSP(f16h, WS_ZT), WSP(const float, WS_SSQ) + 2 * T, WSP(const float, WS_BIAS2) + 9 * 5632}; g8::gemm_phase<EpiSwiglu2>(F.lds, g, S, E); }
    SEAM(9);
    if (IN(10) && (MK_DUP & (1 << 10))) { LAUNDER(kp); unsigned char* ws = kp->ws;
        g8::Gemm g{ws + WS_ZT, ws + WS_W2 + (size_t)1024 * 2816 * 2, 2816, 5632u, 16u, 256, 128, 48, 4, 0}; g8::StaticOrder S; S.init(48, 4, F.G, F.bid);
        EpiRes2<false> E{ResOut{WSP(float, WS_YB), kp->out, nullptr, nullptr, nullptr, nullptr, nullptr, nullptr, 0, 0}, nullptr, WSP(const float, WS_MOD), 6144 + 5120, 0};
        g8::gemm_phase<EpiRes2<false>>(F.lds, g, S, E); }
    if (IN(10) && (MK_DUP & (1 << 10))) xcd_barrier(bar);
    if (IN(10)) { LAUNDER(kp); unsigned char* ws = kp->ws;
        g8::Gemm g{ws + WS_ZT, ws + WS_W2 + (size_t)1024 * 2816 * 2, 2816, 5632u, 16u, 256, 128, 48, 4, 0}; g8::StaticOrder S; S.init(48, 4, F.G, F.bid);
        EpiFinal E{kp->out, WSP(const float, WS_MOD), kp->in[7], WSP(float, WS_SSQ) + 3 * T, WSP(unsigned, CTL_PANEL), 6144 + 5120};
        g8::gemm_phase<EpiFinal>(F.lds, g, S, E); }
#undef IN
#undef SEAM
#undef WSP
}

extern "C" void kernel_launch(void* const* d_in, const int* in_sizes, int n_in, void* d_out, int out_size, void* d_ws, size_t ws_size, hipStream_t stream) {
    static int grid = 0;
    if (grid == 0) {
        if (n_in != 35 || ws_size < WS_END) { fprintf(stderr, "kernel_launch: unexpected n_in %d / ws %zu\n", n_in, ws_size); grid = -1; return; }
        int dev = 0, cus = 0, per_cu = 0;
        if (hipGetDevice(&dev) != hipSuccess || hipDeviceGetAttribute(&cus, hipDeviceAttributeMultiprocessorCount, dev) != hipSuccess) { grid = -1; return; }
        if (hipFuncSetAttribute((const void*)mk_fwd, hipFuncAttributeMaxDynamicSharedMemorySize, LDS_BYTES) != hipSuccess) { fprintf(stderr, "kernel_launch: hipFuncSetAttribute failed\n"); grid = -1; return; }
        if (hipOccupancyMaxActiveBlocksPerMultiprocessor(&per_cu, (const void*)mk_fwd, 512, LDS_BYTES) != hipSuccess || per_cu < 1) { fprintf(stderr, "kernel_launch: occupancy query says %d\n", per_cu); per_cu = 1; }
        (void)hipGetLastError();
        grid = cus;
    }
    if (grid < 0) return;
    (void)hipMemsetAsync((char*)d_ws + WS_CTL, 0, CTL_ZERO_BYTES, stream);
    Params p; memset(&p, 0, sizeof(p));
    for (int i = 0; i < 35; ++i) p.in[i] = (const float*)d_in[i];
    p.out = (float*)d_out; p.ws = (unsigned char*)d_ws;
    if (MK_LAUNCHES == 1) { p.ph_lo = 0; p.ph_hi = NPH; hipLaunchKernelGGL(mk_fwd, dim3(grid), dim3(512), LDS_BYTES, stream, p); }
    else for (int k = 0; k < NPH; ++k) { p.ph_lo = k; p.ph_hi = k + 1; hipLaunchKernelGGL(mk_fwd, dim3(grid), dim3(512), LDS_BYTES, stream, p); }
}
```

```cpp
#include <hip/hip_runtime.h>
#include <math.h>
#include <string.h>
#include <stdio.h>

#ifndef MK_DUP
#define MK_DUP 0
#endif
#ifndef MK_LAUNCHES
#define MK_LAUNCHES 1
#endif
constexpr int D = 1024, NCTX = 4096, NLAT = 8192, T = 12288, F = 2816, NPH = 11;
constexpr size_t MiB = 1u << 20;
typedef _Float16 f16h;
constexpr size_t WS_CTL = 0, CTL_ZERO_BYTES = 2 * MiB;
constexpr size_t CTL_BAR = 16384;
constexpr size_t CTL_PANEL = 32768;
constexpr size_t WS_MOD = 65536;
constexpr size_t WS_SSQ = 524288;
constexpr size_t WS_NORM = 720896;
constexpr size_t WS_BIAS2 = 786432;
constexpr size_t WS_H2 = 2 * MiB;
constexpr size_t WS_POST = 2 * MiB + 512 * 1024;
constexpr size_t WS_S5PW = 2 * MiB + 768 * 1024;
constexpr size_t WS_S5BB = 3 * MiB;
constexpr size_t WS_FILT = 4 * MiB;
constexpr size_t WS_WIN = 24 * MiB, WS_WOUT = 30 * MiB, WS_W13 = 32 * MiB  , WS_W2 = 54 * MiB  , WS_WGLU = 65 * MiB;
constexpr size_t WS_XA = 70 * MiB;
constexpr size_t WS_V2 = 94 * MiB;
constexpr size_t WS_ZT = 118 * MiB;
constexpr size_t WS_YB = 190 * MiB;
constexpr size_t WS_X16 = 214 * MiB;
constexpr size_t WS_END = 238 * MiB;
constexpr int LDS_BYTES = 135168;
constexpr int LDS_MISC = 133120;

__device__ __forceinline__ int row_ci(int row) { return row < NCTX ? 0 : 1 + ((row - NCTX) >> 10); }
__device__ __forceinline__ float siluf(float v) { return v * __builtin_amdgcn_rcpf(1.f + __expf(-v)); }
__device__ __forceinline__ float sigmf(float v) { return __builtin_amdgcn_rcpf(1.f + __expf(-v)); }
__device__ __forceinline__ unsigned pkh(float a, float b) { typedef _Float16 h2 __attribute__((ext_vector_type(2))); h2 v; v.x = (_Float16)a; v.y = (_Float16)b; return __builtin_bit_cast(unsigned, v); }

__device__ __forceinline__ void atomic_add_done(float* p, float v) { const float old = atomicAdd(p, v); asm volatile("" :: "v"(old)); }
struct Params { const float* in[35]; float* out; unsigned char* ws; int ph_lo, ph_hi; };
namespace g8 {
#define G8_LAS __attribute__((address_space(3)))
typedef _Float16 h8 __attribute__((ext_vector_type(8)));
typedef float f32x4 __attribute__((ext_vector_type(4)));
typedef unsigned u32x4 __attribute__((ext_vector_type(4)));
typedef unsigned u32x2 __attribute__((ext_vector_type(2)));
constexpr int BM = 256, BK = 64, HALF = 128, HTB = HALF * BK * 2, STAGE_BYTES = 8 * HTB, NXCD = 8, WGM = 8;
__host__ __device__ __forceinline__ int lds_byte(int r, int c) { const int st = (r >> 4) * 2 + (c >> 5), rr = r & 15, cc = c & 31, ob = rr * 64 + cc * 2; return st * 1024 + (ob ^ (((ob >> 9) & 1) << 5)); }
__host__ __device__ __forceinline__ void stage_rc(int b, int& R, int& C) { const int st = b / 1024, sb = b % 1024, swz = sb ^ (((sb >> 9) & 1) << 5); R = (st >> 1) * 16 + swz / 64; C = (st & 1) * 32 + (swz % 64) / 2; }
struct Unit { int pm, pn; };
struct Gemm { const void* A; const void* Bt; int K; unsigned a_row, a_k8; int b_tile_rows, b_half_rows; int nM, nN; int pad; };
struct StaticOrder {
    int nM, nN, nwg, G, c;
    __device__ void init(int nM_, int nN_, int G_, int c_) { nM = nM_; nN = nN_; nwg = nM * nN; G = G_; c = c_; }
    __device__ bool next(int i, Unit& u) const {
        const long L = (long)i * G + c; if (L >= nwg) return false;
        int wgid = (int)L; { const int q = nwg / NXCD, r = nwg % NXCD, xcd = wgid % NXCD, off = wgid / NXCD; wgid = (xcd < r ? xcd * (q + 1) : r * (q + 1) + (xcd - r) * q) + off; }
        const int nig = WGM * nN, gid = wgid / nig, fm = gid * WGM, gsz = (nM - fm) < WGM ? (nM - fm) : WGM;
        u.pm = fm + ((wgid % nig) % gsz); u.pn = (wgid % nig) / gsz; return true;
    }
};
template <class Epi>
__device__ __forceinline__ void gemm_phase(G8_LAS unsigned char* lds, const Gemm g, const StaticOrder& S, const Epi& E) {
    const int tid = threadIdx.x, wid = __builtin_amdgcn_readfirstlane(tid >> 6), lane = tid & 63, wr = wid >> 2, wc = wid & 3, fr = lane & 15, fq = lane >> 4;
    const int K = g.K, nt = K / BK;
    unsigned voffA[2], voffB[2];
#pragma unroll
    for (int i = 0; i < 2; ++i) { int R, C; stage_rc(tid * 16 + i * 8192, R, C);
        voffA[i] = (unsigned)R * g.a_row + (unsigned)(C >> 3) * g.a_k8; voffB[i] = (unsigned)(R * K + C) * 2u; }
    const size_t kstepA = (size_t)8 * g.a_k8, kstepB = (size_t)(BK * 2);
    const size_t hstepA = (size_t)HALF * g.a_row, tstepA = 2 * hstepA;
    const size_t hstepB = (size_t)g.b_half_rows * K * 2, tstepB = (size_t)g.b_tile_rows * K * 2;
    const unsigned ldsw = (unsigned)wid * 1024u;
    const int aoff = lds_byte(wr * 64 + fr, fq * 8), boff = lds_byte(wc * 32 + fr, fq * 8);
#define G8_SA(b, h) (((b) * 2 + (h)) * HTB)
#define G8_SB(b, h) ((4 + (b) * 2 + (h)) * HTB)
#define G8_STAGE(bufoff, gbase, voff) do { _Pragma("unroll") for (int _i = 0; _i < 2; ++_i) \
        __builtin_amdgcn_global_load_lds((const unsigned*)((const char*)(gbase) + (voff)[_i]), (G8_LAS unsigned*)(lds + (bufoff) + ldsw + _i * 8192), 16, 0, 0); } while (0)
#define G8_LDA(dst, b, h) do { _Pragma("unroll") for (int m = 0; m < 4; ++m) _Pragma("unroll") for (int k = 0; k < 2; ++k) dst[m][k] = *(const G8_LAS h8*)(lds + G8_SA(b, h) + aoff + m * 2048 + k * 1024); } while (0)
#define G8_LDB(dst, b, h) do { _Pragma("unroll") for (int n = 0; n < 2; ++n) _Pragma("unroll") for (int k = 0; k < 2; ++k) dst[n][k] = *(const G8_LAS h8*)(lds + G8_SB(b, h) + boff + n * 2048 + k * 1024); } while (0)
#define G8_MMA(ai, bj, At, Bt) do { __builtin_amdgcn_s_setprio(1); _Pragma("unroll") for (int m = 0; m < 4; ++m) _Pragma("unroll") for (int n = 0; n < 2; ++n) _Pragma("unroll") for (int k = 0; k < 2; ++k) \
        acc[ai][bj][m][n] = __builtin_amdgcn_mfma_f32_16x16x32_f16(Bt[n][k], At[m][k], acc[ai][bj][m][n], 0, 0, 0); __builtin_amdgcn_s_setprio(0); } while (0)
#define G8_WAIT_V(n) asm volatile("s_waitcnt vmcnt(" #n ")" ::: "memory")
#define G8_WAIT_L(n) asm volatile("s_waitcnt lgkmcnt(" #n ")" ::: "memory")
#define G8_BAR __builtin_amdgcn_s_barrier()
#define G8_SCHED __builtin_amdgcn_sched_barrier(0)
    Unit cur, nxt; int ui = 0;
    if (!S.next(0, cur)) return;
    f32x4 acc[2][2][4][2];
#pragma unroll
    for (int a = 0; a < 2; ++a)
#pragma unroll
        for (int b = 0; b < 2; ++b)
#pragma unroll
            for (int m = 0; m < 4; ++m)
#pragma unroll
                for (int n = 0; n < 2; ++n) acc[a][b][m][n] = (f32x4){0.f, 0.f, 0.f, 0.f};
    h8 At[4][2], B0[2][2], B1[2][2];
    const char* cA = (const char*)g.A + (size_t)cur.pm * tstepA; const char* cB = (const char*)g.Bt + (size_t)cur.pn * tstepB;
    G8_STAGE(G8_SB(0, 0), cB, voffB); G8_STAGE(G8_SB(0, 1), cB + hstepB, voffB); G8_STAGE(G8_SA(0, 0), cA, voffA); G8_STAGE(G8_SA(0, 1), cA + hstepA, voffA);
    if (wr == 1) G8_BAR;
    G8_WAIT_V(2); G8_BAR;
    G8_STAGE(G8_SB(1, 0), cB + kstepB, voffB); G8_STAGE(G8_SA(1, 0), cA + kstepA, voffA); G8_STAGE(G8_SB(1, 1), cB + hstepB + kstepB, voffB);
    G8_WAIT_V(6); G8_BAR;
    for (;;) {
        const bool has_next = S.next(ui + 1, nxt);
        const char* nA = has_next ? (const char*)g.A + (size_t)nxt.pm * tstepA : cA; const char* nB = has_next ? (const char*)g.Bt + (size_t)nxt.pn * tstepB : cB;
        for (int t = 0; t < nt; t += 2) {
            const bool last = (t == nt - 2);
            const char* a1 = cA + (size_t)(t + 1) * kstepA;
            const char* a2 = last ? nA : cA + (size_t)(t + 2) * kstepA; const char* b2 = last ? nB : cB + (size_t)(t + 2) * kstepB;
            const char* a3 = a2 + kstepA; const char* b3 = b2 + kstepB;
            G8_LDB(B0, 0, 0); G8_LDB(B1, 0, 1); G8_SCHED; G8_LDA(At, 0, 0); G8_STAGE(G8_SA(1, 1), a1 + hstepA, voffA);
            G8_WAIT_V(8); G8_WAIT_L(0); G8_BAR; G8_MMA(0, 0, At, B0); G8_MMA(0, 1, At, B1); G8_BAR; G8_SCHED;
            G8_LDA(At, 0, 1); G8_STAGE(G8_SB(0, 0), b2, voffB); G8_STAGE(G8_SB(0, 1), b2 + hstepB, voffB); G8_STAGE(G8_SA(0, 0), a2, voffA);
            G8_WAIT_V(8); G8_WAIT_L(0); G8_BAR; G8_MMA(1, 0, At, B0); G8_MMA(1, 1, At, B1); G8_BAR; G8_SCHED;
            G8_LDB(B0, 1, 0); G8_LDB(B1, 1, 1); G8_SCHED; G8_LDA(At, 1, 0); G8_STAGE(G8_SA(0, 1), a2 + hstepA, voffA);
            G8_WAIT_V(8); G8_WAIT_L(0); G8_BAR; G8_MMA(0, 0, At, B0); G8_MMA(0, 1, At, B1); G8_BAR; G8_SCHED;
            G8_LDA(At, 1, 1); G8_STAGE(G8_SB(1, 0), b3, voffB); G8_STAGE(G8_SB(1, 1), b3 + hstepB, voffB); G8_STAGE(G8_SA(1, 0), a3, voffA);
            G8_WAIT_V(8); G8_WAIT_L(0); G8_BAR; G8_MMA(1, 0, At, B0); G8_MMA(1, 1, At, B1); G8_BAR; G8_SCHED;
        }
        if (wr == 0) G8_BAR;
        E(acc, cur, wr, wc, fr, fq);
        if (!has_next) break;
#pragma unroll
        for (int a = 0; a < 2; ++a)
#pragma unroll
            for (int b = 0; b < 2; ++b)
#pragma unroll
                for (int m = 0; m < 4; ++m)
#pragma unroll
                    for (int n = 0; n < 2; ++n) acc[a][b][m][n] = (f32x4){0.f, 0.f, 0.f, 0.f};
        cur = nxt; cA = nA; cB = nB; ++ui;
        if (wr == 1) G8_BAR;
    }
    G8_WAIT_V(0);
    G8_BAR;
#undef G8_SA
#undef G8_SB
#undef G8_STAGE
#undef G8_LDA
#undef G8_LDB
#undef G8_MMA
#undef G8_WAIT_V
#undef G8_WAIT_L
#undef G8_BAR
#undef G8_SCHED
}
}
namespace cv {
#define CV_LAS __attribute__((address_space(3)))
typedef _Float16 h8 __attribute__((ext_vector_type(8)));
typedef _Float16 h4 __attribute__((ext_vector_type(4)));
typedef float f32x16 __attribute__((ext_vector_type(16)));
typedef unsigned u4 __attribute__((ext_vector_type(4)));
typedef unsigned u2 __attribute__((ext_vector_type(2)));
template <int N> struct IC { static constexpr int value = N; };
constexpr int WAVE_LDS = 16640, V_OFF = 0, ZERO_OFF = 8256, FA_OFF = 8320, FB_OFF = 12480;
constexpr float FSCALE = 64.f;
struct Args { const _Float16* zT; const _Float16* FILT; const float* conv_w; const float* conv_b; const float* fbias; _Float16* V2; };
__host__ __device__ __forceinline__ size_t filt_off(int lv, int o, int ch) { return lv ? (size_t)2 * 1024 * 512 + (size_t)(o * 1024 + ch) * 2048 : (size_t)(o * 1024 + ch) * 512; }
template <int LV> __device__ __forceinline__ void conv_unit(CV_LAS unsigned char* lds, const Args& P, int c, int bh) {
    constexpr int L = LV ? 1024 : 256, NBu = LV ? 4 : 8, T1 = L / 32, T1L = LV ? 8 : 4, NCT = T1 / T1L, PV = L * 2 + 16;
    const int tid = threadIdx.x, w = __builtin_amdgcn_readfirstlane(tid >> 6), lane = tid & 63;
    const int ch = 8 * c + w;
    const int row_base = LV ? 4096 + (4 * bh) * 1024 : (8 * bh) * 256;
    CV_LAS unsigned char* wl = lds + w * WAVE_LDS;
    auto load_row = [&](int chx, int dst) {
        const _Float16* zrow = P.zT + (size_t)chx * 12288 + row_base;
        const float w0 = P.conv_w[chx], w1 = P.conv_w[3072 + chx], w2 = P.conv_w[6144 + chx], cb = P.conv_b[chx];
        constexpr int NP = NBu * L / 8 / 64;
#pragma unroll
        for (int p0 = 0; p0 < NP; p0 += 4) {
            h8 raw[4]; float zp[4], zn[4];
#pragma unroll
            for (int q = 0; q < 4; ++q) { const int piece = lane + 64 * (p0 + q), b2 = piece / (L / 8), t0 = (piece % (L / 8)) * 8;
                raw[q] = *(const h8*)(zrow + b2 * L + t0);
                zp[q] = t0 > 0 ? (float)zrow[b2 * L + t0 - 1] : 0.f; zn[q] = t0 + 8 < L ? (float)zrow[b2 * L + t0 + 8] : 0.f; }
#pragma unroll
            for (int q = 0; q < 4; ++q) { const int piece = lane + 64 * (p0 + q), b2 = piece / (L / 8), t0 = (piece % (L / 8)) * 8;
                float z[10]; z[0] = zp[q]; z[9] = zn[q];
#pragma unroll
                for (int i = 0; i < 8; ++i) z[i + 1] = (float)raw[q][i];
                h8 o;
#pragma unroll
                for (int i = 0; i < 8; ++i) o[i] = (_Float16)(w0 * z[i] + w1 * z[i + 1] + w2 * z[i + 2] + cb);
                *(CV_LAS h8*)(wl + dst + b2 * PV + t0 * 2) = o; }
        }
    };
    load_row(ch, V_OFF);
    if (lane < 16) *(CV_LAS unsigned*)(wl + ZERO_OFF + lane * 4) = 0u;
    const int t2 = lane & 31, hi = lane >> 5, col = lane & 31, bl = col / T1L, t1l = col % T1L;
    const int abase = (t2 & 1) ? FA_OFF + 2 * ((L - 1) - t2 + 8 * hi) : FB_OFF + 2 * ((L - 1) - t2 + 8 * hi - 1);
    const int vbase = V_OFF + bl * PV + 16 * hi;
#pragma unroll 1
    for (int o = 0; o < 2; ++o) {
        {
            const u4* Fg = (const u4*)(P.FILT + filt_off(LV, o, ch));
            for (int piece = lane; piece < 2 * L / 8; piece += 64) {
                const u4 a = Fg[piece]; const unsigned e0 = piece + 1 < 2 * L / 8 ? ((const unsigned*)(Fg + piece + 1))[0] : 0u;
                u4 b; b.x = (a.x >> 16) | (a.y << 16); b.y = (a.y >> 16) | (a.z << 16); b.z = (a.z >> 16) | (a.w << 16); b.w = (a.w >> 16) | (e0 << 16);
                *(CV_LAS u4*)(wl + FA_OFF + piece * 16) = a;
                *(CV_LAS u4*)(wl + FB_OFF + piece * 16) = b;
            }
        }
        f32x16 acc[NCT];
#pragma unroll
        for (int ct = 0; ct < NCT; ++ct)
#pragma unroll
            for (int r = 0; r < 16; ++r) acc[ct][r] = 0.f;
        auto ldA = [&](int d, h8& A0, h8& A1) { const CV_LAS unsigned* ap = (const CV_LAS unsigned*)(wl + abase - 64 * d); u4 a0, a1;
            a0.x = ap[0]; a0.y = ap[1]; a0.z = ap[2]; a0.w = ap[3]; a1.x = ap[8]; a1.y = ap[9]; a1.z = ap[10]; a1.w = ap[11];
            A0 = __builtin_bit_cast(h8, a0); A1 = __builtin_bit_cast(h8, a1); };
        auto ldB = [&](int d, int ct, h8& b0, h8& b1) { const int s1 = ct * T1L - d + t1l; const bool valid = (unsigned)s1 < (unsigned)T1;
            const int off = valid ? vbase + s1 * 64 : ZERO_OFF;
            b0 = *(const CV_LAS h8*)(wl + off); b1 = *(const CV_LAS h8*)(wl + off + 32); };
        auto seg = [&](auto lo_c, auto hi_c, int dlo, int dhi) {
            constexpr int LO = decltype(lo_c)::value, HI = decltype(hi_c)::value, NL = HI - LO + 1;
            h8 A0, A1, b0[NL], b1[NL];
            ldA(dlo, A0, A1);
#pragma unroll
            for (int k = 0; k < NL; ++k) ldB(dlo, LO + k, b0[k], b1[k]);
            h8 B0_[NL], B1_[NL], C0, C1, c0[NL], c1[NL];
#pragma unroll 1
            for (int d = dlo; d <= dhi; d += 2) {
                const int d1 = d + 1 <= dhi ? d + 1 : d, d2 = d + 2 <= dhi ? d + 2 : d1;
                ldA(d1, C0, C1);
#pragma unroll
                for (int k = 0; k < NL; ++k) ldB(d1, LO + k, c0[k], c1[k]);
                __builtin_amdgcn_sched_barrier(0);
#pragma unroll
                for (int k = 0; k < NL; ++k) {
                    acc[LO + k] = __builtin_amdgcn_mfma_f32_32x32x16_f16(A0, b0[k], acc[LO + k], 0, 0, 0);
                    acc[LO + k] = __builtin_amdgcn_mfma_f32_32x32x16_f16(A1, b1[k], acc[LO + k], 0, 0, 0);
                }
                __builtin_amdgcn_sched_barrier(0);
                ldA(d2, A0, A1);
#pragma unroll
                for (int k = 0; k < NL; ++k) ldB(d2, LO + k, b0[k], b1[k]);
                __builtin_amdgcn_sched_barrier(0);
                if (d + 1 <= dhi) {
#pragma unroll
                    for (int k = 0; k < NL; ++k) {
                        acc[LO + k] = __builtin_amdgcn_mfma_f32_32x32x16_f16(C0, c0[k], acc[LO + k], 0, 0, 0);
                        acc[LO + k] = __builtin_amdgcn_mfma_f32_32x32x16_f16(C1, c1[k], acc[LO + k], 0, 0, 0);
                    }
                }
                __builtin_amdgcn_sched_barrier(0);
            }
            (void)B0_; (void)B1_;
        };
        if constexpr (NCT == 4) {
            seg(IC<0>{}, IC<0>{}, -(T1 - 1), -(T1 - 1) + T1L - 1);
            seg(IC<0>{}, IC<1>{}, -(T1 - 1) + T1L, -(T1 - 1) + 2 * T1L - 1);
            seg(IC<0>{}, IC<2>{}, -(T1 - 1) + 2 * T1L, -(T1 - 1) + 3 * T1L - 1);
            seg(IC<0>{}, IC<3>{}, -(T1 - 1) + 3 * T1L, T1L - 1);
            seg(IC<1>{}, IC<3>{}, T1L, 2 * T1L - 1);
            seg(IC<2>{}, IC<3>{}, 2 * T1L, 3 * T1L - 1);
            seg(IC<3>{}, IC<3>{}, 3 * T1L, 4 * T1L - 1);
        } else {
            seg(IC<0>{}, IC<0>{}, -(T1 - 1), -(T1 - 1) + T1L - 1);
            seg(IC<0>{}, IC<1>{}, -(T1 - 1) + T1L, T1L - 1);
            seg(IC<1>{}, IC<1>{}, T1L, 2 * T1L - 1);
        }
        {
            load_row((o + 1) * 1024 + ch, FA_OFF);
            const float fbv = P.fbias[o * 1024 + ch];
#pragma unroll
            for (int ct = 0; ct < NCT; ++ct)
#pragma unroll
                for (int g = 0; g < 4; ++g) {
                    const int t = 32 * (ct * T1L + t1l) + 8 * g + 4 * hi;
                    const h4 gt = *(const CV_LAS h4*)(wl + FA_OFF + bl * PV + t * 2);
                    CV_LAS h4* vp = (CV_LAS h4*)(wl + V_OFF + bl * PV + t * 2);
                    const h4 vin = *vp; h4 vo;
#pragma unroll
                    for (int i = 0; i < 4; ++i) vo[i] = (_Float16)((acc[ct][4 * g + i] * (1.f / FSCALE) + (float)vin[i] * fbv) * (float)gt[i]);
                    *vp = vo;
                }
        }
    }
    __syncthreads();
    for (int idx = tid; idx < NBu * L; idx += 512) {
        const int b2 = idx / L, t = idx % L; h8 o;
#pragma unroll
        for (int ww = 0; ww < 8; ++ww) o[ww] = *(const CV_LAS _Float16*)(lds + ww * WAVE_LDS + V_OFF + b2 * PV + t * 2);
        *(h8*)(P.V2 + ((size_t)c * 12288 + row_base + b2 * L + t) * 8) = o;
    }
    __syncthreads();
}
__device__ __forceinline__ void conv_phase(CV_LAS unsigned char* lds, const Args& P, int G, int bid) {
    for (int u = bid; u < 256; u += G) conv_unit<1>(lds, P, u >> 1, u & 1);
    for (int u = bid; u < 256; u += G) conv_unit<0>(lds, P, u >> 1, u & 1);
}
}
namespace s5 {
#define S5_LAS __attribute__((address_space(3)))
typedef _Float16 h8 __attribute__((ext_vector_type(8)));
typedef _Float16 h4 __attribute__((ext_vector_type(4)));
typedef _Float16 h2 __attribute__((ext_vector_type(2)));
typedef float f32x16 __attribute__((ext_vector_type(16)));
typedef float f32x4 __attribute__((ext_vector_type(4)));
constexpr int IMG_PITCH = 288, WAVE_LDS = 32 * IMG_PITCH;
constexpr int TT = 12288;
struct Args { const _Float16* UP; const float* ssq; const float* MOD; const float* PW; const _Float16* BB;
              const float* C_re; const float* C_im; const float* Dv; const float* state_in; _Float16* YB; _Float16* Y2; float* new_state; };
__device__ __forceinline__ float gelu_fast(float x) { const float u = 1.5957691216057308f * (x + 0.044715f * x * x * x); return x * __builtin_amdgcn_rcpf(1.f + __expf(-u)); }
__device__ __forceinline__ void s5_table(int ix, const float* A_re, const float* A_im, const float* log_dt, const float* B_re, const float* B_im, float* PW, _Float16* BB) {
    const double are = A_re[ix], aim = A_im[ix], dt = exp((double)log_dt[ix >> 6]);
    const double mag = exp(dt * are), ph = dt * aim, abr = mag * cos(ph), abi = mag * sin(ph);
    const double nr = abr - 1.0, ni = abi, den = are * are + aim * aim, cor = (nr * are + ni * aim) / den, coi = (ni * are - nr * aim) / den;
    double pr = abr, pi = abi;
    for (int k = 0; k < 4; ++k) { PW[(size_t)ix * 8 + 2 * k] = (float)pr; PW[(size_t)ix * 8 + 2 * k + 1] = (float)pi; const double tr = pr * abr - pi * abi; pi = pr * abi + pi * abr; pr = tr; }
    for (int h = 0; h < 16; ++h) { const double br = B_re[(size_t)ix * 16 + h], bi = B_im[(size_t)ix * 16 + h];
        BB[(size_t)ix * 32 + h] = (_Float16)(float)(cor * br - coi * bi); BB[(size_t)ix * 32 + 16 + h] = (_Float16)(float)(cor * bi + coi * br); }
}
__device__ __forceinline__ void s5_task(S5_LAS unsigned char* img, volatile S5_LAS int* myflag, volatile S5_LAS int* pflag, int epoch, const Args& P, int seq, int g, int dir) {
    const int lane = threadIdx.x & 63, n = lane & 31, hi = lane >> 5, tq = lane & 15, q4 = lane >> 4;
    const bool ctx = seq < 16;
    const int L = ctx ? 256 : 1024, base = ctx ? seq * 256 : 4096 + (seq - 16) * 1024, ci = ctx ? 0 : 1 + (seq - 16), NT = L / 32;
    const float* mod = P.MOD + (ci * 2 + 1) * 6144;
    float shO[4], dvO[4]; h8 shAh;
#pragma unroll
    for (int j = 0; j < 8; ++j) shAh[j] = (_Float16)mod[16 * g + 8 * hi + j];
#pragma unroll
    for (int j = 0; j < 4; ++j) { shO[j] = mod[16 * g + 4 * q4 + j]; dvO[j] = P.Dv[16 * g + 4 * q4 + j]; }
    const _Float16* up = P.UP + (size_t)g * TT * 16;
    _Float16* yb = P.YB + (size_t)g * TT * 16;
    float pw[2][4][2]; h8 Bf[2][2]; float cr[2], cim[2];
#pragma unroll
    for (int half = 0; half < 2; ++half) {
        const int p = n + 32 * half, ix = (dir * 64 + g) * 64 + p;
        const f32x4 q0 = *(const f32x4*)(P.PW + (size_t)ix * 8), q1 = *(const f32x4*)(P.PW + (size_t)ix * 8 + 4);
        pw[half][0][0] = q0[0]; pw[half][0][1] = q0[1]; pw[half][1][0] = q0[2]; pw[half][1][1] = q0[3]; pw[half][2][0] = q1[0]; pw[half][2][1] = q1[1]; pw[half][3][0] = q1[2]; pw[half][3][1] = q1[3];
        Bf[half][0] = *(const h8*)(P.BB + (size_t)ix * 32 + 8 * hi); Bf[half][1] = *(const h8*)(P.BB + (size_t)ix * 32 + 16 + 8 * hi);
        if (ctx) { cr[half] = 0.f; cim[half] = 0.f; }
        else { const int b = seq - 16; cr[half] = P.state_in[((b * 2 + dir) * 2 + 0) * 4096 + g * 64 + p]; cim[half] = P.state_in[((b * 2 + dir) * 2 + 1) * 4096 + g * 64 + p]; }
    }
    h8 Cf[4];
#pragma unroll
    for (int kk = 0; kk < 4; ++kk)
#pragma unroll
        for (int j = 0; j < 8; ++j) { const int k = 32 * kk + 8 * q4 + j, p = k >> 1; const size_t cx = ((size_t)(dir * 64 + g) * 16 + tq) * 64 + p;
            Cf[kk][j] = (_Float16)((k & 1) ? -P.C_im[cx] : P.C_re[cx]); }
    int rowA = base + (dir ? L - 1 - n : n);
    h8 ur = *(const h8*)(up + (size_t)rowA * 16 + 8 * hi); float sqA = P.ssq[rowA];
#pragma unroll 1
    for (int jt = 0; jt < NT; ++jt) {
        const bool second = jt >= NT / 2;
        if (jt == NT / 2) {
            asm volatile("s_waitcnt vmcnt(0)" ::: "memory");
            if (lane == 0) *myflag = epoch;
            while (*pflag < epoch) __builtin_amdgcn_s_sleep(8);
            asm volatile("" ::: "memory");
        }
        int rowO[2];
#pragma unroll
        for (int nt = 0; nt < 2; ++nt) { const int s = 32 * jt + tq + 16 * nt; rowO[nt] = base + (dir ? L - 1 - s : s); }
        const float rsA = __builtin_amdgcn_rsqf(sqA * (1.f / 1024.f) + 1e-6f);
        h8 Au; { const _Float16 rh = (_Float16)rsA; h8 rv = {rh, rh, rh, rh, rh, rh, rh, rh}; Au = ur * rv + shAh; }
        if (jt + 1 < NT) { const int s = 32 * (jt + 1) + n; rowA = base + (dir ? L - 1 - s : s); ur = *(const h8*)(up + (size_t)rowA * 16 + 8 * hi); sqA = P.ssq[rowA]; }
        const f32x16 zero = {0.f, 0.f, 0.f, 0.f, 0.f, 0.f, 0.f, 0.f, 0.f, 0.f, 0.f, 0.f, 0.f, 0.f, 0.f, 0.f};
#pragma unroll
        for (int half = 0; half < 2; ++half) {
            f32x16 xr = __builtin_amdgcn_mfma_f32_32x32x16_f16(Au, Bf[half][0], zero, 0, 0, 0);
            f32x16 xi = __builtin_amdgcn_mfma_f32_32x32x16_f16(Au, Bf[half][1], zero, 0, 0, 0);
            const float a1r = pw[half][0][0], a1i = pw[half][0][1], a4r = pw[half][3][0], a4i = pw[half][3][1];
#pragma unroll
            for (int q = 0; q < 4; ++q)
#pragma unroll
                for (int j = 1; j < 4; ++j) { const int r = 4 * q + j; const float pr = xr[r - 1], pi = xi[r - 1];
                    xr[r] = a1r * pr - a1i * pi + xr[r]; xi[r] = a1r * pi + a1i * pr + xi[r]; }
            float er[4], ei[4], per[4], pei[4];
#pragma unroll
            for (int q = 0; q < 4; ++q) { er[q] = xr[4 * q + 3]; ei[q] = xi[4 * q + 3]; per[q] = __shfl_xor(er[q], 32); pei[q] = __shfl_xor(ei[q], 32); }
            float sr = cr[half], si = cim[half], inr[4], ini[4];
#pragma unroll
            for (int i = 0; i < 8; ++i) { const int q = i >> 1; const bool own = ((i & 1) == hi);
                if ((i & 1) == 0) { inr[q] = sr; ini[q] = si; } else { inr[q] = hi ? sr : inr[q]; ini[q] = hi ? si : ini[q]; }
                const float evr = own ? er[q] : per[q], evi = own ? ei[q] : pei[q];
                const float tr = a4r * sr - a4i * si + evr; si = a4r * si + a4i * sr + evi; sr = tr; }
            cr[half] = sr; cim[half] = si;
#pragma unroll
            for (int q = 0; q < 4; ++q)
#pragma unroll
                for (int j = 0; j < 4; ++j) { const int r = 4 * q + j; const float hr = xr[r] + pw[half][j][0] * inr[q] - pw[half][j][1] * ini[q], hm = xi[r] + pw[half][j][0] * ini[q] + pw[half][j][1] * inr[q];
                    const int tau = (r & 3) + 8 * (r >> 2) + 4 * hi;
                    *(S5_LAS h2*)(img + tau * IMG_PITCH + (n + 32 * half) * 4) = __builtin_bit_cast(h2, __builtin_amdgcn_cvt_pkrtz(hr, hm)); }
        }
        h4 ybv[2]; h4 u4[2]; float sqO[2];
        if (second) {
#pragma unroll
            for (int nt = 0; nt < 2; ++nt) { ybv[nt] = *(const h4*)(yb + (size_t)rowO[nt] * 16 + 4 * q4); u4[nt] = *(const h4*)(up + (size_t)rowO[nt] * 16 + 4 * q4); sqO[nt] = P.ssq[rowO[nt]]; }
        }
#pragma unroll
        for (int nt = 0; nt < 2; ++nt) {
            f32x4 acc = {0.f, 0.f, 0.f, 0.f};
#pragma unroll
            for (int kk = 0; kk < 4; ++kk) { const h8 hb = *(const S5_LAS h8*)(img + (tq + 16 * nt) * IMG_PITCH + (32 * kk + 8 * q4) * 2);
                acc = __builtin_amdgcn_mfma_f32_16x16x32_f16(Cf[kk], hb, acc, 0, 0, 0); }
            if (!second) { h4 o; o[0] = (_Float16)acc[0]; o[1] = (_Float16)acc[1]; o[2] = (_Float16)acc[2]; o[3] = (_Float16)acc[3]; *(h4*)(yb + (size_t)rowO[nt] * 16 + 4 * q4) = o; }
            else {
                const float rs = __builtin_amdgcn_rsqf(sqO[nt] * (1.f / 1024.f) + 1e-6f);
                h4 o;
#pragma unroll
                for (int j = 0; j < 4; ++j) { const float u = rs * (float)u4[nt][j] + shO[j]; o[j] = (_Float16)gelu_fast(u * dvO[j] + acc[j] + (float)ybv[nt][j]); }
                *(h4*)(P.Y2 + ((size_t)(2 * g + (q4 >> 1)) * TT + rowO[nt]) * 8 + 4 * (q4 & 1)) = o;
            }
        }
    }
    if (ctx && hi == 0) {
#pragma unroll
        for (int half = 0; half < 2; ++half) { const int p = n + 32 * half;
            P.new_state[((seq * 2 + dir) * 2 + 0) * 4096 + g * 64 + p] = cr[half]; P.new_state[((seq * 2 + dir) * 2 + 1) * 4096 + g * 64 + p] = cim[half]; }
    }
}
__device__ __forceinline__ void s5_phase(S5_LAS unsigned char* lds, volatile S5_LAS int* flags, const Args& P, int G, int bid) {
    const int w = __builtin_amdgcn_readfirstlane(threadIdx.x >> 6), dir = w & 1;
    S5_LAS unsigned char* img = lds + w * WAVE_LDS;
    int epoch = 0;
    for (int b = bid; b < 256; b += G) {
        if (w < 4) { const int lu = 2 * b + (w >> 1); ++epoch; s5_task(img, flags + w, flags + (w ^ 1), epoch, P, 16 + (lu >> 6), lu & 63, dir); }
        else for (int r = 0; r < 2; ++r) { const int cu = 4 * b + 2 * r + ((w - 4) >> 1); ++epoch; s5_task(img, flags + w, flags + (w ^ 1), epoch, P, cu >> 6, cu & 63, dir); }
    }
}
}
#define LAS __attribute__((address_space(3)))
#define XB_TMO      128
#define XB_XCNT(j)  (256  + 64 * (j))
#define XB_XSUB(j)  (1280 + 64 * (j))
#define XB_XGEN(j)  (2304 + 64 * (j))
#define XB_TOP      3328
#define XB_TOPGEN   3392
#define XCD_BAR_WORDS 3456
#define XB_SPIN_CAP (1u << 18)
__device__ __forceinline__ unsigned xb_ld(unsigned* p)              { return __hip_atomic_load(p, __ATOMIC_RELAXED, __HIP_MEMORY_SCOPE_AGENT); }
__device__ __forceinline__ unsigned xb_add(unsigned* p, unsigned v) { return __hip_atomic_fetch_add(p, v, __ATOMIC_RELAXED, __HIP_MEMORY_SCOPE_AGENT); }
__device__ __forceinline__ unsigned xb_xcc_id() { return (unsigned)__builtin_amdgcn_s_getreg((3 << 11) | 20) & 0xFu; }
#define XB_SPIN(cond, bar) do { unsigned _sp = 0; while (cond) { __builtin_amdgcn_s_sleep(1); \
    if ((++_sp & 255u) == 0u) { if (xb_ld(&(bar)[XB_TMO])) break; if (_sp > XB_SPIN_CAP) { atomicAdd(&(bar)[XB_TMO], 1u); break; } } } } while (0)
struct XcdBarrier { unsigned* bar; unsigned x; volatile LAS unsigned* st; };
__device__ __forceinline__ XcdBarrier xcd_barrier_post(unsigned* bar, volatile LAS unsigned* st) {
    XcdBarrier b; b.bar = bar; b.x = xb_xcc_id(); b.st = st;
    if (threadIdx.x == 0) (void)xb_add(&bar[XB_XCNT(b.x)], 1u);
    return b;
}
__device__ __forceinline__ void xcd_barrier_complete(unsigned* bar, unsigned x, unsigned& nloc, unsigned& nx) {
    const unsigned G = gridDim.x * gridDim.y * gridDim.z;
    unsigned sum, cnt, mine, sp = 0u;
    for (;;) {
        sum = 0u; cnt = 0u; mine = 0u;
#pragma unroll
        for (unsigned j = 0; j < 16; ++j) { const unsigned c = xb_ld(&bar[XB_XCNT(j)]); sum += c; cnt += (c > 0u) ? 1u : 0u; mine = (j == x) ? c : mine; }
        if (sum == G) break;
        __builtin_amdgcn_s_sleep(1);
        if ((++sp & 255u) == 0u) { if (xb_ld(&bar[XB_TMO])) break; if (sp > XB_SPIN_CAP) { atomicAdd(&bar[XB_TMO], 1u); break; } }
    }
    nloc = mine > 0u ? mine : 1u; nx = cnt > 0u ? cnt : 1u;
}
__device__ __forceinline__ void xcd_barrier(const XcdBarrier& b) {
    asm volatile("s_waitcnt vmcnt(0)" ::: "memory");
    __syncthreads();
    if (threadIdx.x == 0) {
        unsigned* bar = b.bar;
        __builtin_amdgcn_s_waitcnt(0);
        unsigned nloc = b.st[0], nx = b.st[1];
        if (nloc == 0u) { xcd_barrier_complete(bar, b.x, nloc, nx); b.st[0] = nloc; b.st[1] = nx; }
        const unsigned old = xb_add(&bar[XB_XSUB(b.x)], 1u);
        const unsigned gen = old / nloc;
        if (old + 1u == (gen + 1u) * nloc) {
            __builtin_amdgcn_fence(__ATOMIC_RELEASE, "agent");
            asm volatile("s_waitcnt vmcnt(0)" ::: "memory");
            const unsigned og = xb_add(&bar[XB_TOP], 1u);
            const unsigned tg = og / nx;
            if (og + 1u == (tg + 1u) * nx) xb_add(&bar[XB_TOPGEN], 1u);
            else XB_SPIN(xb_ld(&bar[XB_TOPGEN]) == tg, bar);
            __builtin_amdgcn_fence(__ATOMIC_ACQUIRE, "agent");
            xb_add(&bar[XB_XGEN(b.x)], 1u);
            asm volatile("s_waitcnt vmcnt(0)" ::: "memory");
        } else {
            XB_SPIN(xb_ld(&bar[XB_XGEN(b.x)]) == gen, bar);
            __builtin_amdgcn_fence(__ATOMIC_ACQUIRE, "agent");
            asm volatile("s_waitcnt vmcnt(0)" ::: "memory");
        }
    }
    __syncthreads();
}

struct EpiZT { f16h* zT; const float* bias;
    __device__ __forceinline__ void operator()(const g8::f32x4 (&acc)[2][2][4][2], const g8::Unit& u, int wr, int wc, int fr, int fq) const {
        const int row0 = u.pm * 256 + wr * 64 + fr, col0 = u.pn * 256 + wc * 32 + 4 * fq;
#pragma unroll
        for (int ai = 0; ai < 2; ++ai)
#pragma unroll
            for (int m = 0; m < 4; ++m) { const int row = row0 + ai * 128 + m * 16; const float bv = bias[row];
#pragma unroll
                for (int bj = 0; bj < 2; ++bj)
#pragma unroll
                    for (int n = 0; n < 2; ++n) { const g8::f32x4 a = acc[ai][bj][m][n]; g8::u32x2 w; w.x = pkh(a[0] + bv, a[1] + bv); w.y = pkh(a[2] + bv, a[3] + bv);
                        *(g8::u32x2*)(zT + (size_t)row * 12288 + col0 + bj * 128 + n * 16) = w; } }
    } };
struct ResOut { f16h* X; const f16h* Xr; f16h* XA; const float* ng; float* ssq; const float* xp; const float* xs; const float* post; int xa_mode; int pad; };
template <bool XIN, class GV> __device__ __forceinline__ void res_group(const ResOut& R, const float* gate, const float* sc, int row0, int c, GV getval, float (&sq)[8]) {
    typedef _Float16 h4 __attribute__((ext_vector_type(4)));
    const g8::f32x4 gv = *(const g8::f32x4*)(gate + c);
    g8::f32x4 gm = {0.f, 0.f, 0.f, 0.f};
    if (R.XA) { const g8::f32x4 ng = *(const g8::f32x4*)(R.ng + c), s = *(const g8::f32x4*)(sc + c); gm = ng * (s + 1.f); }
    unsigned o0 = (unsigned)row0 * 1024u + (unsigned)c;
    asm volatile("" : "+v"(o0));
    const bool lat = XIN && row0 >= NCTX;
    g8::f32x4 x[8];
#pragma unroll
    for (int i = 0; i < 8; ++i) { const unsigned o = o0 + (unsigned)(((i >> 2) * 128 + (i & 3) * 16) * 1024);
        if (XIN) x[i] = lat ? *(const g8::f32x4*)(R.xs + (o - (unsigned)NCTX * 1024u)) : *(const g8::f32x4*)(R.xp + o);
        else { const h4 hv = *(const h4*)(R.Xr + o); x[i] = (g8::f32x4){(float)hv[0], (float)hv[1], (float)hv[2], (float)hv[3]}; } }
#pragma unroll
    for (int i = 0; i < 8; ++i) { const int row = row0 + (i >> 2) * 128 + (i & 3) * 16; const unsigned o = o0 + (unsigned)(((i >> 2) * 128 + (i & 3) * 16) * 1024); g8::f32x4 xv = x[i];
        if (lat) { const int t = (row - NCTX) & 1023; xv += *(const g8::f32x4*)(c < 512 ? R.post + (t >> 6) * 512 + c : R.post + 16 * 512 + (t & 63) * 512 + (c - 512)); }
        xv += gv * getval(i);
        { g8::u32x2 w; w.x = pkh(xv[0], xv[1]); w.y = pkh(xv[2], xv[3]); *(g8::u32x2*)(R.X + o) = w; }
        sq[i] += (xv[0] * xv[0] + xv[1] * xv[1]) + (xv[2] * xv[2] + xv[3] * xv[3]);
        if (R.XA) { g8::u32x2 w; w.x = pkh(xv[0] * gm[0], xv[1] * gm[1]); w.y = pkh(xv[2] * gm[2], xv[3] * gm[3]);
            f16h* q = R.xa_mode == 0 ? R.XA + o : R.XA + ((size_t)(c >> 4) * T + row) * 16 + (c & 15);
            *(g8::u32x2*)q = w; } }
}
__device__ __forceinline__ void res_ssq(const ResOut& R, int row0, int fq, float (&sq)[8]) {
    if (!R.ssq) return;
    float olds[8];
#pragma unroll
    for (int i = 0; i < 8; ++i) { float v = sq[i]; v += __shfl_xor(v, 16); v += __shfl_xor(v, 32); olds[i] = 0.f; if (fq == 0) olds[i] = atomicAdd(R.ssq + row0 + (i >> 2) * 128 + (i & 3) * 16, v); }
    asm volatile("" :: "v"(olds[0]), "v"(olds[1]), "v"(olds[2]), "v"(olds[3]), "v"(olds[4]), "v"(olds[5]), "v"(olds[6]), "v"(olds[7]));
}
template <bool XIN> struct EpiRes2 { ResOut R; const float* bias; const float* MOD; int gateoff, scoff;
    __device__ __forceinline__ void operator()(const g8::f32x4 (&acc)[2][2][4][2], const g8::Unit& u, int wr, int wc, int fr, int fq) const {
        const int row0 = u.pm * 256 + wr * 64 + fr, col0 = u.pn * 256 + wc * 32 + 4 * fq;
        const float* mb = MOD + (row_ci(u.pm * 256) * 2) * 6144; const float* gate = mb + gateoff; const float* sc = mb + scoff;
        float sq[8] = {0.f, 0.f, 0.f, 0.f, 0.f, 0.f, 0.f, 0.f};
#pragma unroll
        for (int bj = 0; bj < 2; ++bj)
#pragma unroll
            for (int n = 0; n < 2; ++n) { const int c = col0 + bj * 128 + n * 16; g8::f32x4 bv = {0.f, 0.f, 0.f, 0.f}; if (bias) bv = *(const g8::f32x4*)(bias + c);
                res_group<XIN>(R, gate, sc, row0, c, [&](int i) { return acc[i >> 2][bj][i & 3][n] + bv; }, sq); }
        res_ssq(R, row0, fq, sq);
    } };
struct EpiGlu2 { ResOut R; const float* bias; const float* MOD; int gateoff, scoff;
    __device__ __forceinline__ void operator()(const g8::f32x4 (&acc)[2][2][4][2], const g8::Unit& u, int wr, int wc, int fr, int fq) const {
        const int row0 = u.pm * 256 + wr * 64 + fr, col0 = u.pn * 128 + wc * 32 + 4 * fq;
        const float* mb = MOD + (row_ci(u.pm * 256) * 2) * 6144; const float* gate = mb + gateoff; const float* sc = mb + scoff;
        float sq[8] = {0.f, 0.f, 0.f, 0.f, 0.f, 0.f, 0.f, 0.f};
#pragma unroll
        for (int n = 0; n < 2; ++n) { const int c = col0 + n * 16; const g8::f32x4 ba = *(const g8::f32x4*)(bias + c), bg = *(const g8::f32x4*)(bias + 1024 + c);
            res_group<false>(R, gate, sc, row0, c, [&](int i) { const g8::f32x4 a = acc[i >> 2][0][i & 3][n] + ba, g = acc[i >> 2][1][i & 3][n] + bg; g8::f32x4 v;
#pragma unroll
                for (int j = 0; j < 4; ++j) v[j] = a[j] * sigmf(g[j]);
                return v; }, sq); }
        res_ssq(R, row0, fq, sq);
    } };

struct EpiFinal { float* out; f16h* X16; const float* MOD; const float* fg; float* ssq; unsigned* cnt; int gateoff; int pad;
    __device__ __forceinline__ void operator()(const g8::f32x4 (&acc)[2][2][4][2], const g8::Unit& u, int wr, int wc, int fr, int fq) const {
        const int row0 = u.pm * 256 + wr * 64 + fr, col0 = u.pn * 256 + wc * 32 + 4 * fq;
        const float* gate = MOD + (row_ci(u.pm * 256) * 2) * 6144 + gateoff;
        ResOut R{X16, X16, nullptr, nullptr, ssq, nullptr, nullptr, nullptr, 0, 0};
        float sq[8] = {0.f, 0.f, 0.f, 0.f, 0.f, 0.f, 0.f, 0.f};
#pragma unroll
        for (int bj = 0; bj < 2; ++bj)
#pragma unroll
            for (int n = 0; n < 2; ++n) { const int c = col0 + bj * 128 + n * 16;
                res_group<false>(R, gate, gate, row0, c, [&](int i) { return acc[i >> 2][bj][i & 3][n]; }, sq); }
        res_ssq(R, row0, fq, sq);
        asm volatile("s_waitcnt vmcnt(0)" ::: "memory");
        unsigned* c = cnt + 64 * u.pm;
        if ((threadIdx.x & 63) == 0) __hip_atomic_fetch_add(c, 1u, __ATOMIC_RELAXED, __HIP_MEMORY_SCOPE_AGENT);
        { unsigned spins = 0; while ((unsigned)__builtin_amdgcn_readfirstlane(__hip_atomic_load(c, __ATOMIC_RELAXED, __HIP_MEMORY_SCOPE_AGENT)) < 32u) { __builtin_amdgcn_s_sleep(4); if (++spins > (1u << 22)) break; } }
        asm volatile("" ::: "memory");
        float rs[8];
#pragma unroll
        for (int i = 0; i < 8; ++i) rs[i] = __hip_atomic_load(ssq + row0 + (i >> 2) * 128 + (i & 3) * 16, __ATOMIC_RELAXED, __HIP_MEMORY_SCOPE_AGENT);
#pragma unroll
        for (int i = 0; i < 8; ++i) rs[i] = __builtin_amdgcn_rsqf(rs[i] * (1.f / 1024.f) + 1e-6f);
#pragma unroll
        for (int bj = 0; bj < 2; ++bj)
#pragma unroll
            for (int n = 0; n < 2; ++n) { const int c2 = col0 + bj * 128 + n * 16; const g8::f32x4 g = *(const g8::f32x4*)(fg + c2);
                unsigned o0 = (unsigned)row0 * 1024u + (unsigned)c2; asm volatile("" : "+v"(o0));
                typedef _Float16 h4 __attribute__((ext_vector_type(4)));
                h4 x[8];
#pragma unroll
                for (int i = 0; i < 8; ++i) x[i] = *(const h4*)(X16 + o0 + (unsigned)(((i >> 2) * 128 + (i & 3) * 16) * 1024));
#pragma unroll
                for (int i = 0; i < 8; ++i) { g8::f32x4 xv; xv[0] = (float)x[i][0] * rs[i] * g[0]; xv[1] = (float)x[i][1] * rs[i] * g[1]; xv[2] = (float)x[i][2] * rs[i] * g[2]; xv[3] = (float)x[i][3] * rs[i] * g[3];
                    *(g8::f32x4*)(out + o0 + (unsigned)(((i >> 2) * 128 + (i & 3) * 16) * 1024)) = xv; } }
    } };
struct EpiSwiglu2 { f16h* hid; const float* ssq; const float* bias2;
    __device__ __forceinline__ void operator()(const g8::f32x4 (&acc)[2][2][4][2], const g8::Unit& u, int wr, int wc, int fr, int fq) const {
        const int row0 = u.pm * 256 + wr * 64 + fr, col0 = u.pn * 128 + wc * 32 + 4 * fq;
        const float* b2 = bias2 + row_ci(u.pm * 256) * 5632;
#pragma unroll
        for (int n = 0; n < 2; ++n) { const g8::f32x4 ba = *(const g8::f32x4*)(b2 + col0 + n * 16), bb = *(const g8::f32x4*)(b2 + 2816 + col0 + n * 16);
#pragma unroll
            for (int ai = 0; ai < 2; ++ai)
#pragma unroll
                for (int m = 0; m < 4; ++m) { const int row = row0 + ai * 128 + m * 16; const float rstd = 1.0f / sqrtf(ssq[row] * (1.f / 1024.f) + 1e-6f);
                    const g8::f32x4 a = acc[ai][0][m][n] * rstd + ba, b = acc[ai][1][m][n] * rstd + bb; g8::u32x2 w;
                    w.x = pkh(siluf(a[0]) * b[0], siluf(a[1]) * b[1]); w.y = pkh(siluf(a[2]) * b[2], siluf(a[3]) * b[3]);
                    *(g8::u32x2*)(hid + (size_t)row * 2816 + col0 + n * 16) = w; } }
    } };

typedef const __attribute__((address_space(4))) Params* KP;
struct Frame { LAS unsigned char* lds; int tid, lane, wave, G, bid; };
__device__ __forceinline__ float wave_sum(float v) {
#pragma unroll
    for (int o = 1; o < 64; o <<= 1) v += __shfl_xor(v, o);
    return v;
}
__device__ __forceinline__ void transpose_item(const float* W, int K, int N, f16h* WT, LAS float* scr, int item, int lane) {
    const int nblk = N / 32, kb = item / nblk, nb = item % nblk, k0 = 64 * kb, n0 = 32 * nb;
#pragma unroll 8
    for (int i = 0; i < 32; ++i) { const int kk = 2 * i + (lane >> 5); scr[kk * 33 + (lane & 31)] = W[(size_t)(k0 + kk) * N + n0 + (lane & 31)]; }
    asm volatile("s_waitcnt lgkmcnt(0)" ::: "memory");
    const int c = lane & 7;
#pragma unroll
    for (int j = 0; j < 4; ++j) { const int n = (lane >> 3) + 8 * j; const LAS float* s = scr + (8 * c) * 33 + n;
        g8::u32x4 o; o.x = pkh(s[0 * 33], s[1 * 33]); o.y = pkh(s[2 * 33], s[3 * 33]); o.z = pkh(s[4 * 33], s[5 * 33]); o.w = pkh(s[6 * 33], s[7 * 33]);
        *(g8::u32x4*)(WT + (size_t)(n0 + n) * K + k0 + 8 * c) = o; }
    asm volatile("s_waitcnt lgkmcnt(0)" ::: "memory");
}
__device__ __forceinline__ void gemv9_item(const float* W, int ldw, int col0, int kc, const LAS float* tab, float* out, int ostride, const float* bias, int lane) {
    const int col = col0 + lane; float acc[9];
#pragma unroll
    for (int ci = 0; ci < 9; ++ci) acc[ci] = 0.f;
    const float* w = W + (size_t)(kc * 64) * ldw + col;
#pragma unroll 1
    for (int c = 0; c < 4; ++c) {
        float wv[16];
#pragma unroll
        for (int k = 0; k < 16; ++k) wv[k] = w[(size_t)(16 * c + k) * ldw];
#pragma unroll
        for (int k4 = 0; k4 < 4; ++k4)
#pragma unroll
            for (int ci = 0; ci < 9; ++ci) { const g8::f32x4 s = *(const LAS g8::f32x4*)(tab + ci * 1024 + kc * 64 + 16 * c + 4 * k4); acc[ci] += s[0] * wv[4 * k4] + s[1] * wv[4 * k4 + 1] + s[2] * wv[4 * k4 + 2] + s[3] * wv[4 * k4 + 3]; }
    }
    float olds[9];
#pragma unroll
    for (int ci = 0; ci < 9; ++ci) olds[ci] = atomicAdd(out + (size_t)ci * ostride + col, acc[ci] + ((bias && kc == 0) ? bias[col] : 0.f));
    asm volatile("" :: "v"(olds[0]), "v"(olds[1]), "v"(olds[2]), "v"(olds[3]), "v"(olds[4]), "v"(olds[5]), "v"(olds[6]), "v"(olds[7]), "v"(olds[8]));
}
__device__ __forceinline__ void filt_item(const float* H2, const float* w3, float* NORM, f16h* FILT, int lv, int o, int mr, int d0, int lane, bool pass2, LAS float* hs) {
    const int L = lv ? 1024 : 256, d = d0 + lane, m0 = 32 * mr, dir = m0 >= L ? 1 : 0;
    const int extra = (!pass2 && m0 == L) ? 1 : 0;
    const int ilo = dir ? (m0 - (L - 1)) - extra : (L - 32 - m0);
    const float* h2 = H2 + (lv ? 256 : 0) * 64;
    for (int r = 0; r < 32 + extra; ++r) { const int i = ilo + r; hs[r * 64 + lane] = i < L ? h2[i * 64 + lane] : 0.f; }
    float w[64];
#pragma unroll
    for (int m = 0; m < 64; ++m) w[m] = w3[m * 4096 + o * 2048 + dir * 1024 + d];
    const double maxd = log(1e-2) / 0.3, mind = log(1e-2) / 1.5;
    const float delta = fabsf((float)(mind + (double)d * (maxd - mind) / 1023.0));
    const float tstep = (float)(1.0 / (double)(L - 1));
    float inv = 0.f; if (pass2) inv = cv::FSCALE / (NORM[(lv * 2 + o) * 1024 + d] + 1e-6f);
    float sabs = 0.f; f16h taps[32];
    asm volatile("s_waitcnt lgkmcnt(0)" ::: "memory");
#pragma unroll 1
    for (int mm = -extra; mm < 32; ++mm) {
        const int m = m0 + mm, j = (L - 1) - m, i = j < 0 ? -j : j;
        const LAS g8::f32x4* hr = (const LAS g8::f32x4*)(hs + (i - ilo) * 64);
        float a = 0.f;
#pragma unroll
        for (int q = 0; q < 16; ++q) { const g8::f32x4 h = hr[q]; a += h[0] * w[4 * q] + h[1] * w[4 * q + 1] + h[2] * w[4 * q + 2] + h[3] * w[4 * q + 3]; }
        a = i < L ? a * __expf(-(float)i * tstep * delta) : 0.f;
        sabs += fabsf(a);
        if (mm >= 0) {
#pragma unroll
            for (int q = 0; q < 32; ++q) if (q == mm) taps[q] = (f16h)(a * inv);
        }
    }
    if (!pass2) atomic_add_done(&NORM[(lv * 2 + o) * 1024 + d], sabs);
    else {
        f16h* dst = FILT + (lv ? (size_t)2 * 1024 * 512 + (size_t)(o * 1024 + d) * 2048 : (size_t)(o * 1024 + d) * 512) + m0;
#pragma unroll
        for (int q = 0; q < 4; ++q) { cv::h8 v;
#pragma unroll
            for (int e = 0; e < 8; ++e) v[e] = taps[8 * q + e];
            *(cv::h8*)(dst + 8 * q) = v; }
    }
    asm volatile("s_waitcnt lgkmcnt(0)" ::: "memory");
}
__device__ __forceinline__ void filt_items(Frame& F, KP P, int first_block, int nblocks, bool pass2) {
    const float* H2 = (const float*)(P->ws + WS_H2); float* NORM = (float*)(P->ws + WS_NORM); f16h* FILT = (f16h*)(P->ws + WS_FILT);
    if (F.bid < first_block) return;
    const int gw = (F.bid - first_block) * 8 + F.wave, NGW = nblocks * 8;
    for (int it = gw; it < 2560; it += NGW) {
        int lv, r = it; if (r < 512) lv = 0; else { lv = 1; r -= 512; }
        const int nr = lv ? 64 : 16, db = r & 15, mr = (r >> 4) % nr, o = (r >> 4) / nr;
        filt_item(H2, P->in[20], NORM, FILT, lv, o, mr, db * 64, F.lane, pass2, (LAS float*)(F.lds + F.wave * 8704));
    }
}
__device__ __forceinline__ void phase0(Frame& F, KP P, bool domods) {
    LAS float* tab = (LAS float*)F.lds;
    LAS float* scr = (LAS float*)(F.lds + 36864 + F.wave * 8448);
    for (int i = F.tid; i < 9 * 1024; i += 512) { const int ci = i >> 10, k = i & 1023; const float v = ci == 0 ? P->in[4][k] : P->in[3][(ci - 1) * 1024 + k]; tab[i] = v / (1.f + expf(-v)); }
    __syncthreads();
    const int gw = F.bid * 8 + F.wave, NGW = F.G * 8;
    float* MOD = (float*)(P->ws + WS_MOD);
    if (domods) for (int it = gw; it < 3072; it += NGW) { const int kq = it & 15, cb = (it >> 4) % 96, l = (it >> 4) / 96;
        gemv9_item(P->in[8] + (size_t)l * 1024 * 6144, 6144, cb * 64, kq, tab, MOD + l * 6144, 2 * 6144, P->in[9] + l * 6144, F.lane); }
    for (int pos = gw; pos < 1280; pos += NGW) {
        const int L = pos < 256 ? 256 : 1024, i = pos < 256 ? pos : pos - 256, lane = F.lane;
        if (lane < 33) { float z;
            if (lane == 0) z = (float)((double)i / (double)(L - 1));
            else { const int m = (lane - 1) & 15; const double band = 1e-4 + (double)m * ((15.0 - 1e-4) / 15.0), w = 2.0 * 3.14159265358979323846 * (double)i / (double)L;
                z = lane <= 16 ? (float)cos(band * w) : (float)(-sin(band * w)); }
            scr[lane] = z; }
        asm volatile("s_waitcnt lgkmcnt(0)" ::: "memory");
        float a = P->in[17][lane];
        for (int k = 0; k < 33; ++k) a += scr[k] * P->in[16][k * 64 + lane];
        scr[64 + lane] = sinf(P->in[21][lane] * a);
        asm volatile("s_waitcnt lgkmcnt(0)" ::: "memory");
        float a2 = P->in[19][lane];
        for (int k = 0; k < 64; ++k) a2 += scr[64 + k] * P->in[18][k * 64 + lane];
        ((float*)(P->ws + WS_H2))[pos * 64 + lane] = sinf(P->in[21][lane] * a2);
        asm volatile("s_waitcnt lgkmcnt(0)" ::: "memory");
    }
    { float* post = (float*)(P->ws + WS_POST);
      for (int i = F.bid * 512 + F.tid; i < 80 * 512; i += F.G * 512) { const int n = i >> 9, d = i & 511, nn = n < 16 ? n : n - 16;
          const double om = exp(-log(10000.0) * (double)(d & 255) / 256.0), ang = (double)nn * om; post[i] = (float)(d < 256 ? sin(ang) : cos(ang)); } }
    for (int ix = F.bid * 512 + F.tid; ix < 8192; ix += F.G * 512) s5::s5_table(ix, P->in[25], P->in[26], P->in[27], P->in[28], P->in[29], (float*)(P->ws + WS_S5PW), (f16h*)(P->ws + WS_S5BB));
    { constexpr int I_IN = 16 * 96, I_OUT = 16 * 32, NIT = I_IN + I_OUT;
      for (int it = gw; it < NIT; it += NGW) { int r = it;
          if (r < I_IN) { transpose_item(P->in[12], 1024, 3072, (f16h*)(P->ws + WS_WIN), scr, r, F.lane); continue; } r -= I_IN;
          transpose_item(P->in[23], 1024, 1024, (f16h*)(P->ws + WS_WOUT), scr, r, F.lane); } }
}
__device__ __forceinline__ void convert_items(Frame& F, KP P, int first, int set) {
    if (F.bid < first) return;
    LAS float* scr = (LAS float*)(F.lds + F.wave * 8448);
    const int gw = (F.bid - first) * 8 + F.wave, NGW = (F.G - first) * 8;
    constexpr int I_13 = 16 * 176, I_2 = 44 * 32, I_GLU = 16 * 64;
    const int l = set;
    const int NIT = I_13 + I_2 + (set ? I_GLU : 0);
    for (int it = gw; it < NIT; it += NGW) { int r = it;
        if (r < I_13) { transpose_item(P->in[10] + (size_t)l * 1024 * 5632, 1024, 5632, (f16h*)(P->ws + WS_W13) + (size_t)l * 5632 * 1024, scr, r, F.lane); continue; } r -= I_13;
        if (r < I_2) { transpose_item(P->in[11] + (size_t)l * 2816 * 1024, 2816, 1024, (f16h*)(P->ws + WS_W2) + (size_t)l * 1024 * 2816, scr, r, F.lane); continue; } r -= I_2;
        transpose_item(P->in[33], 1024, 2048, (f16h*)(P->ws + WS_WGLU), scr, r, F.lane); }
}
__device__ __forceinline__ void phase1(Frame& F, KP P) {
    const float* MOD = (const float*)(P->ws + WS_MOD);
    const int gw = F.bid * 8 + F.wave, NGW = F.G * 8;
    { f16h* XA = (f16h*)(P->ws + WS_XA); const float* post = (const float*)(P->ws + WS_POST); const float* ng = P->in[5];
      for (int row = gw; row < T; row += NGW) {
          const float* mb = MOD + (row_ci(row) * 2) * 6144; g8::f32x4 v[4]; float s = 0.f;
#pragma unroll
          for (int j = 0; j < 4; ++j) { const int c = 4 * F.lane + 256 * j;
              if (row < NCTX) v[j] = *(const g8::f32x4*)(P->in[0] + (size_t)row * 1024 + c);
              else { const int r = row - NCTX, t = r & 1023; v[j] = *(const g8::f32x4*)(P->in[1] + (size_t)r * 1024 + c);
                  v[j] += *(const g8::f32x4*)(c < 512 ? post + (t >> 6) * 512 + c : post + 16 * 512 + (t & 63) * 512 + (c - 512)); }
              s += (v[j][0] * v[j][0] + v[j][1] * v[j][1]) + (v[j][2] * v[j][2] + v[j][3] * v[j][3]); }
          const float rstd = 1.0f / sqrtf(wave_sum(s) * (1.f / 1024.f) + 1e-6f);
#pragma unroll
          for (int j = 0; j < 4; ++j) { const int c = 4 * F.lane + 256 * j; const g8::f32x4 g = *(const g8::f32x4*)(ng + c), sh = *(const g8::f32x4*)(mb + c), sc = *(const g8::f32x4*)(mb + 1024 + c);
              g8::u32x2 w; w.x = pkh(v[j][0] * rstd * g[0] * (1.f + sc[0]) + sh[0], v[j][1] * rstd * g[1] * (1.f + sc[1]) + sh[1]);
              w.y = pkh(v[j][2] * rstd * g[2] * (1.f + sc[2]) + sh[2], v[j][3] * rstd * g[3] * (1.f + sc[3]) + sh[3]);
              *(g8::u32x2*)(XA + (size_t)row * 1024 + c) = w; } } }
    filt_items(F, P, 0, F.G, false);
}
__device__ __forceinline__ void bias2_items(Frame& F, KP P, int first) {
    if (F.bid < first) return;
    const float* MOD = (const float*)(P->ws + WS_MOD);
    LAS float* tab = (LAS float*)F.lds;
    for (int i = F.tid; i < 2 * 9 * 1024; i += 512) { const int l = i / 9216, r = i % 9216, ci = r >> 10, k = r & 1023; tab[i] = MOD[(ci * 2 + l) * 6144 + 3072 + k]; }
    __syncthreads();
    float* BIAS2 = (float*)(P->ws + WS_BIAS2);
    const int gw = (F.bid - first) * 8 + F.wave, NGW = (F.G - first) * 8;
    for (int it = gw; it < 2816; it += NGW) { const int kq = it & 15, cb = (it >> 4) % 88, l = (it >> 4) / 88;
        gemv9_item(P->in[10] + (size_t)l * 1024 * 5632, 5632, cb * 64, kq, tab + l * 9216, BIAS2 + (size_t)l * 9 * 5632, 5632, nullptr, F.lane); }
    __syncthreads();
}
__device__ __forceinline__ void phase_final(Frame& F, KP P) {
    const float* ssq = (const float*)(P->ws + WS_SSQ) + 3 * T; const float* fg = P->in[7];
    const int gw = F.bid * 8 + F.wave, NGW = F.G * 8;
    for (int row = gw; row < T; row += NGW) { const float rstd = 1.0f / sqrtf(ssq[row] * (1.f / 1024.f) + 1e-6f); float* x = P->out + (size_t)row * 1024;
#pragma unroll
        for (int j = 0; j < 4; ++j) { const int c = 4 * F.lane + 256 * j; g8::f32x4 v = *(g8::f32x4*)(x + c); const g8::f32x4 g = *(const g8::f32x4*)(fg + c);
            v[0] *= rstd * g[0]; v[1] *= rstd * g[1]; v[2] *= rstd * g[2]; v[3] *= rstd * g[3]; *(g8::f32x4*)(x + c) = v; } }
}

#define LAUNDER(p) asm volatile("" : "+s"(p))
__global__ void __launch_bounds__(512, 2) mk_fwd(Params prm_unused) {
    extern __shared__ __attribute__((aligned(16))) unsigned char lds_raw[];
    KP kp = (KP)__builtin_amdgcn_kernarg_segment_ptr();
    Frame F; F.lds = (LAS unsigned char*)lds_raw; F.tid = threadIdx.x; F.lane = F.tid & 63; F.wave = __builtin_amdgcn_readfirstlane(F.tid >> 6); F.G = gridDim.x; F.bid = blockIdx.x;
    volatile LAS unsigned* MISC = (volatile LAS unsigned*)(F.lds + LDS_MISC);
    if (F.tid < 32) MISC[F.tid] = 0u;
    __syncthreads();
    XcdBarrier bar; bar.bar = (unsigned*)(kp->ws + CTL_BAR); bar.x = 0; bar.st = nullptr;
    if (MK_LAUNCHES == 1) bar = xcd_barrier_post((unsigned*)(kp->ws + CTL_BAR), MISC + 8);
    const int lo = kp->ph_lo, hi = kp->ph_hi;
#define IN(k) (lo <= (k) && (k) < hi)
#define SEAM(k) do { if (IN(k) && IN((k) + 1)) xcd_barrier(bar); } while (0)
#define WSP(T_, off) ((T_*)(ws + (off)))
    if (IN(0)) { LAUNDER(kp); phase0(F, kp, true); if (MK_DUP & 1) { xcd_barrier(bar); phase0(F, kp, false); } }
    SEAM(0);
    if (IN(1)) { LAUNDER(kp); phase1(F, kp); }
    SEAM(1);
    if (IN(2)) {
        LAUNDER(kp); unsigned char* ws = kp->ws;
        g8::Gemm g{ws + WS_WIN, ws + WS_XA, 1024, 2048u, 16u, 256, 128, 12, 48, 0}; g8::StaticOrder S; S.init(12, 48, F.G, F.bid);
        EpiZT E{WSP(f16h, WS_ZT), kp->in[13]}; g8::gemm_phase<EpiZT>(F.lds, g, S, E);
        filt_items(F, kp, 64, F.G - 64, true);
    }
    if (MK_DUP & (1 << 2)) { xcd_barrier(bar); if (IN(2)) {
        LAUNDER(kp); unsigned char* ws = kp->ws;
        g8::Gemm g{ws + WS_WIN, ws + WS_XA, 1024, 2048u, 16u, 256, 128, 12, 48, 0}; g8::StaticOrder S; S.init(12, 48, F.G, F.bid);
        EpiZT E{WSP(f16h, WS_ZT), kp->in[13]}; g8::gemm_phase<EpiZT>(F.lds, g, S, E);
        filt_items(F, kp, 64, F.G - 64, true);
    } }
    SEAM(2);
    if (IN(3)) { LAUNDER(kp); unsigned char* ws = kp->ws; cv::Args A{WSP(f16h, WS_ZT), WSP(const f16h, WS_FILT), kp->in[14], kp->in[15], kp->in[22], WSP(f16h, WS_V2)}; cv::conv_phase(F.lds, A, F.G, F.bid); }
    if (MK_DUP & (1 << 3)) { xcd_barrier(bar); if (IN(3)) { LAUNDER(kp); unsigned char* ws = kp->ws; cv::Args A{WSP(f16h, WS_ZT), WSP(const f16h, WS_FILT), kp->in[14], kp->in[15], kp->in[22], WSP(f16h, WS_V2)}; cv::conv_phase(F.lds, A, F.G, F.bid); } }
    SEAM(3);
    if (IN(4) && (MK_DUP & (1 << 4))) {
        LAUNDER(kp); unsigned char* ws = kp->ws;
        g8::Gemm g{ws + WS_V2, ws + WS_WOUT, 1024, 16u, 16u * 12288u, 256, 128, 48, 4, 0}; g8::StaticOrder S; S.init(48, 4, F.G, F.bid);
        EpiRes2<true> E{ResOut{WSP(f16h, WS_YB), WSP(const f16h, WS_X16), nullptr, kp->in[6], nullptr, kp->in[0], kp->in[1], WSP(const float, WS_POST), 0, 0}, kp->in[24], WSP(const float, WS_MOD), 2048, 4096};
        g8::gemm_phase<EpiRes2<true>>(F.lds, g, S, E);
    }
    if (IN(4) && (MK_DUP & (1 << 4))) xcd_barrier(bar);
    if (IN(4)) {
        LAUNDER(kp); unsigned char* ws = kp->ws;
        g8::Gemm g{ws + WS_V2, ws + WS_WOUT, 1024, 16u, 16u * 12288u, 256, 128, 48, 4, 0}; g8::StaticOrder S; S.init(48, 4, F.G, F.bid);
        EpiRes2<true> E{ResOut{WSP(f16h, WS_X16), WSP(const f16h, WS_X16), WSP(f16h, WS_XA), kp->in[6], WSP(float, WS_SSQ), kp->in[0], kp->in[1], WSP(const float, WS_POST), 0, 0}, kp->in[24], WSP(const float, WS_MOD), 2048, 4096};
        g8::gemm_phase<EpiRes2<true>>(F.lds, g, S, E);
        convert_items(F, kp, 192, 0); __syncthreads(); bias2_items(F, kp, 192);
    }
    SEAM(4);
    if (IN(5)) { LAUNDER(kp); unsigned char* ws = kp->ws;
        g8::Gemm g{ws + WS_XA, ws + WS_W13, 1024, 2048u, 16u, 128, 2816, 48, 22, 0}; g8::StaticOrder S; S.init(48, 22, F.G, F.bid);
        EpiSwiglu2 E{WSP(f16h, WS_ZT), WSP(const float, WS_SSQ), WSP(const float, WS_BIAS2)}; g8::gemm_phase<EpiSwiglu2>(F.lds, g, S, E); }
    if (MK_DUP & (1 << 5)) { xcd_barrier(bar); if (IN(5)) { LAUNDER(kp); unsigned char* ws = kp->ws;
        g8::Gemm g{ws + WS_XA, ws + WS_W13, 1024, 2048u, 16u, 128, 2816, 48, 22, 0}; g8::StaticOrder S; S.init(48, 22, F.G, F.bid);
        EpiSwiglu2 E{WSP(f16h, WS_ZT), WSP(const float, WS_SSQ), WSP(const float, WS_BIAS2)}; g8::gemm_phase<EpiSwiglu2>(F.lds, g, S, E); } }
    SEAM(5);
    if (IN(6) && (MK_DUP & (1 << 6))) { LAUNDER(kp); unsigned char* ws = kp->ws;
        g8::Gemm g{ws + WS_ZT, ws + WS_W2, 2816, 5632u, 16u, 256, 128, 48, 4, 0}; g8::StaticOrder S; S.init(48, 4, F.G, F.bid);
        EpiRes2<false> E{ResOut{WSP(f16h, WS_YB), WSP(const f16h, WS_X16), nullptr, kp->in[5] + D, nullptr, nullptr, nullptr, nullptr, 1, 0}, nullptr, WSP(const float, WS_MOD), 5120, 6144 + 1024};
        g8::gemm_phase<EpiRes2<false>>(F.lds, g, S, E); }
    if (IN(6) && (MK_DUP & (1 << 6))) xcd_barrier(bar);
    if (IN(6)) { LAUNDER(kp); unsigned char* ws = kp->ws;
        g8::Gemm g{ws + WS_ZT, ws + WS_W2, 2816, 5632u, 16u, 256, 128, 48, 4, 0}; g8::StaticOrder S; S.init(48, 4, F.G, F.bid);
        EpiRes2<false> E{ResOut{WSP(f16h, WS_X16), WSP(const f16h, WS_X16), WSP(f16h, WS_XA), kp->in[5] + D, WSP(float, WS_SSQ) + T, nullptr, nullptr, nullptr, 1, 0}, nullptr, WSP(const float, WS_MOD), 5120, 6144 + 1024};
        g8::gemm_phase<EpiRes2<false>>(F.lds, g, S, E); convert_items(F, kp, 192, 1); }
    SEAM(6);
    if (IN(7)) { LAUNDER(kp); unsigned char* ws = kp->ws;
        s5::Args A{WSP(const f16h, WS_XA), WSP(const float, WS_SSQ) + T, WSP(const float, WS_MOD), WSP(const float, WS_S5PW), WSP(const f16h, WS_S5BB), kp->in[30], kp->in[31], kp->in[32], kp->in[2], WSP(f16h, WS_YB), WSP(f16h, WS_V2), kp->out + (size_t)T * D};
        if (F.tid < 8) MISC[16 + F.tid] = 0u; __syncthreads(); s5::s5_phase(F.lds, (volatile LAS int*)(MISC + 16), A, F.G, F.bid); }
    if (MK_DUP & (1 << 7)) { xcd_barrier(bar); if (IN(7)) { LAUNDER(kp); unsigned char* ws = kp->ws;
        s5::Args A{WSP(const f16h, WS_XA), WSP(const float, WS_SSQ) + T, WSP(const float, WS_MOD), WSP(const float, WS_S5PW), WSP(const f16h, WS_S5BB), kp->in[30], kp->in[31], kp->in[32], kp->in[2], WSP(f16h, WS_YB), WSP(f16h, WS_V2), kp->out + (size_t)T * D};
        if (F.tid < 8) MISC[16 + F.tid] = 0u; __syncthreads(); s5::s5_phase(F.lds, (volatile LAS int*)(MISC + 16), A, F.G, F.bid); } }
    SEAM(7);
    if (IN(8) && (MK_DUP & (1 << 8))) { LAUNDER(kp); unsigned char* ws = kp->ws;
        g8::Gemm g{ws + WS_V2, ws + WS_WGLU, 1024, 16u, 16u * 12288u, 128, 1024, 48, 8, 0}; g8::StaticOrder S; S.init(48, 8, F.G, F.bid);
        EpiGlu2 E{ResOut{WSP(f16h, WS_YB), WSP(const f16h, WS_X16), nullptr, kp->in[6] + D, nullptr, nullptr, nullptr, nullptr, 0, 0}, kp->in[34], WSP(const float, WS_MOD), 6144 + 2048, 6144 + 4096};
        g8::gemm_phase<EpiGlu2>(F.lds, g, S, E); }
    if (IN(8) && (MK_DUP & (1 << 8))) xcd_barrier(bar);
    if (IN(8)) { LAUNDER(kp); unsigned char* ws = kp->ws;
        g8::Gemm g{ws + WS_V2, ws + WS_WGLU, 1024, 16u, 16u * 12288u, 128, 1024, 48, 8, 0}; g8::StaticOrder S; S.init(48, 8, F.G, F.bid);
        EpiGlu2 E{ResOut{WSP(f16h, WS_X16), WSP(const f16h, WS_X16), WSP(f16h, WS_XA), kp->in[6] + D, WSP(float, WS_SSQ) + 2 * T, nullptr, nullptr, nullptr, 0, 0}, kp->in[34], WSP(const float, WS_MOD), 6144 + 2048, 6144 + 4096};
        g8::gemm_phase<EpiGlu2>(F.lds, g, S, E); }
    SEAM(8);
    if (IN(9)) { LAUNDER(kp); unsigned char* ws = kp->ws;
        g8::Gemm g{ws + WS_XA, ws + WS_W13 + (size_t)5632 * 1024 * 2, 1024, 2048u, 16u, 128, 2816, 48, 22, 0}; g8::StaticOrder S; S.init(48, 22, F.G, F.bid);
        EpiSwiglu2 E{WSP(f16h, WS_ZT), WSP(const float, WS_SSQ) + 2 * T, WSP(const float, WS_BIAS2) + 9 * 5632}; g8::gemm_phase<EpiSwiglu2>(F.lds, g, S, E); }
    SEAM(9);
    if (IN(10) && (MK_DUP & (1 << 10))) { LAUNDER(kp); unsigned char* ws = kp->ws;
        g8::Gemm g{ws + WS_ZT, ws + WS_W2 + (size_t)1024 * 2816 * 2, 2816, 5632u, 16u, 256, 128, 48, 4, 0}; g8::StaticOrder S; S.init(48, 4, F.G, F.bid);
        EpiRes2<false> E{ResOut{WSP(f16h, WS_YB), WSP(const f16h, WS_X16), nullptr, nullptr, nullptr, nullptr, nullptr, nullptr, 0, 0}, nullptr, WSP(const float, WS_MOD), 6144 + 5120, 0};
        g8::gemm_phase<EpiRes2<false>>(F.lds, g, S, E); }
    if (IN(10) && (MK_DUP & (1 << 10))) xcd_barrier(bar);
    if (IN(10)) { LAUNDER(kp); unsigned char* ws = kp->ws;
        g8::Gemm g{ws + WS_ZT, ws + WS_W2 + (size_t)1024 * 2816 * 2, 2816, 5632u, 16u, 256, 128, 48, 4, 0}; g8::StaticOrder S; S.init(48, 4, F.G, F.bid);
        EpiFinal E{kp->out, WSP(f16h, WS_X16), WSP(const float, WS_MOD), kp->in[7], WSP(float, WS_SSQ) + 3 * T, WSP(unsigned, CTL_PANEL), 6144 + 5120, 0};
        g8::gemm_phase<EpiFinal>(F.lds, g, S, E); }
#undef IN
#undef SEAM
#undef WSP
}

extern "C" void kernel_launch(void* const* d_in, const int* in_sizes, int n_in, void* d_out, int out_size, void* d_ws, size_t ws_size, hipStream_t stream) {
    static int grid = 0;
    if (grid == 0) {
        if (n_in != 35 || ws_size < WS_END) { fprintf(stderr, "kernel_launch: unexpected n_in %d / ws %zu\n", n_in, ws_size); grid = -1; return; }
        int dev = 0, cus = 0, per_cu = 0;
        if (hipGetDevice(&dev) != hipSuccess || hipDeviceGetAttribute(&cus, hipDeviceAttributeMultiprocessorCount, dev) != hipSuccess) { grid = -1; return; }
        if (hipFuncSetAttribute((const void*)mk_fwd, hipFuncAttributeMaxDynamicSharedMemorySize, LDS_BYTES) != hipSuccess) { fprintf(stderr, "kernel_launch: hipFuncSetAttribute failed\n"); grid = -1; return; }
        if (hipOccupancyMaxActiveBlocksPerMultiprocessor(&per_cu, (const void*)mk_fwd, 512, LDS_BYTES) != hipSuccess || per_cu < 1) { fprintf(stderr, "kernel_launch: occupancy query says %d\n", per_cu); per_cu = 1; }
        (void)hipGetLastError();
        grid = cus;
    }
    if (grid < 0) return;
    (void)hipMemsetAsync((char*)d_ws + WS_CTL, 0, CTL_ZERO_BYTES, stream);
    Params p; memset(&p, 0, sizeof(p));
    for (int i = 0; i < 35; ++i) p.in[i] = (const float*)d_in[i];
    p.out = (float*)d_out; p.ws = (unsigned char*)d_ws;
    if (MK_LAUNCHES == 1) { p.ph_lo = 0; p.ph_hi = NPH; hipLaunchKernelGGL(mk_fwd, dim3(grid), dim3(512), LDS_BYTES, stream, p); }
    else for (int k = 0; k < NPH; ++k) { p.ph_lo = k; p.ph_hi = k + 1; hipLaunchKernelGGL(mk_fwd, dim3(grid), dim3(512), LDS_BYTES, stream, p); }
}
```
